# Optimizing an MI355X kernel written in HIP

```python
import math
import jax, jax.numpy as jnp
from jax import lax
import numpy as np

D_MODEL = 1024
BATCH = 16
SEQ = 2048
DEPTH = 2
DEC_BATCH = 128
DEC_SEQ = 1
PAST_LEN = 16384
PAGE_SIZE = 128

WINDOW = 128
HA_Q = 16
HA_KV = 4
HD_A = D_MODEL // HA_Q
NUM_BUCKETS = 32
MAX_DISTANCE = WINDOW
HB = 8
DK_B = (D_MODEL // 2) // HB
DV_B = D_MODEL // HB
RET_CHUNK = 128
D_INNER_C = D_MODEL
HD_C = 64
HC = D_INNER_C // HD_C
N_C = 128
G_C = 2
CONV_W = 4
CONV_DIM = D_INNER_C + 2 * G_C * N_C
SSD_CHUNK = 128
D_FF = 4 * D_MODEL
EPS = 1e-6
SPLIT_SIZES = (HA_Q * HD_A, HA_KV * HD_A, HA_KV * HD_A,
               HB * DK_B, HB * DK_B, HB * DV_B, HB * DV_B,
               D_INNER_C, CONV_DIM, HC, 3 * D_MODEL)
D_IN = sum(SPLIT_SIZES)

kernel_name = "hybrid_swa_retention_ssd_decoder_step"

F32 = jnp.float32


def _rmsnorm(x, w):
    xf = x.astype(F32)
    y = xf * lax.rsqrt(jnp.mean(xf * xf, axis=-1, keepdims=True) + EPS)
    return (y * w.astype(F32)).astype(x.dtype)


def _rms(x):
    xf = x.astype(F32)
    return xf * lax.rsqrt(jnp.mean(xf * xf, axis=-1, keepdims=True) + EPS)


def _split_proj(z):
    out = []
    start = 0
    for s in SPLIT_SIZES:
        out.append(z[..., start:start + s])
        start += s
    return out


def _t5_bucket(dist):
    max_exact = NUM_BUCKETS // 2
    n = jnp.maximum(dist, 0)
    nf = jnp.maximum(n, 1).astype(F32)
    large = max_exact + (jnp.log(nf / max_exact) / math.log(MAX_DISTANCE / max_exact)
                         * (NUM_BUCKETS - max_exact)).astype(jnp.int32)
    large = jnp.minimum(large, NUM_BUCKETS - 1)
    return jnp.where(n < max_exact, n, large)


def _window_attn(q, k, v, dist, valid, sinks, rel_table):
    G = HA_Q // HA_KV
    qg = q.reshape(q.shape[:-2] + (HA_KV, G, HD_A)).astype(F32)
    s = jnp.einsum('...qkgd,...skd->...kgqs', qg, k.astype(F32)) * (HD_A ** -0.5)
    bias = rel_table.astype(F32)[_t5_bucket(dist)]
    bias = jnp.moveaxis(bias, -1, -3)
    bias = bias.reshape((HA_KV, G) + bias.shape[-2:])
    s = jnp.where(valid[..., None, None, :, :], s + bias, -jnp.inf)
    sink = sinks.astype(F32).reshape(HA_KV, G, 1, 1)
    m = jnp.maximum(jnp.max(s, axis=-1, keepdims=True), sink)
    p = jnp.exp(s - m)
    p = p / (jnp.sum(p, axis=-1, keepdims=True) + jnp.exp(sink - m))
    o = jnp.einsum('...kgqs,...skd->...qkgd', p, v.astype(F32))
    return o.reshape(o.shape[:-3] + (HA_Q * HD_A,))


def _attn_prompt(q, k, v, sinks, rel_table):
    B, T = q.shape[0], q.shape[1]
    nb = T // WINDOW
    qb = q.reshape(B, nb, WINDOW, HA_Q, HD_A)
    pad = jnp.zeros((B, WINDOW, HA_KV, HD_A), k.dtype)
    kb = jnp.concatenate([pad, k], axis=1).reshape(B, nb + 1, WINDOW, HA_KV, HD_A)
    vb = jnp.concatenate([pad.astype(v.dtype), v], axis=1).reshape(B, nb + 1, WINDOW, HA_KV, HD_A)
    kk = jnp.concatenate([kb[:, :-1], kb[:, 1:]], axis=2)
    vv = jnp.concatenate([vb[:, :-1], vb[:, 1:]], axis=2)
    qi = jnp.arange(WINDOW)
    kj = jnp.arange(2 * WINDOW) - WINDOW
    dist = qi[:, None] - kj[None, :]
    kpos = jnp.arange(nb)[:, None] * WINDOW + kj[None, :]
    valid = (dist >= 0) & (dist < WINDOW) & (kpos[:, None, :] >= 0)
    o = _window_attn(qb, kk, vv, dist, valid, sinks, rel_table)
    return o.reshape(B, T, HA_Q * HD_A)


def _attn_sample(q, k_new, v_new, k_buf, v_buf, sinks, rel_table):
    Wb = k_buf.shape[1]
    T = q.shape[1]
    kk = jnp.concatenate([k_buf.astype(k_new.dtype), k_new], axis=1)
    vv = jnp.concatenate([v_buf.astype(v_new.dtype), v_new], axis=1)
    qpos = PAST_LEN + jnp.arange(T)
    kpos = PAST_LEN - Wb + jnp.arange(Wb + T)
    dist = qpos[:, None] - kpos[None, :]
    valid = (dist >= 0) & (dist < WINDOW)
    o = _window_attn(q, kk, vv, dist, valid, sinks, rel_table)
    return o, kk[:, T:], vv[:, T:]


def _xpos_rotate(x, pos):
    d = x.shape[-1]
    theta = 1.0 / (10000.0 ** jnp.linspace(0.0, 1.0, d // 2, dtype=F32))
    ang = pos.astype(F32)[:, None] * theta[None, :]
    sin = jnp.sin(ang)[:, None, :]
    cos = jnp.cos(ang)[:, None, :]
    x1, x2 = x[..., 0::2], x[..., 1::2]
    return jnp.stack([x1 * cos - x2 * sin, x1 * sin + x2 * cos], axis=-1).reshape(x.shape)


def _retention_chunk(S, q, k, v, log_gamma):
    L = q.shape[1]
    i = jnp.arange(L, dtype=F32)
    diff = i[:, None] - i[None, :]
    decay = jnp.where(diff >= 0, jnp.exp(log_gamma[:, None, None] * jnp.maximum(diff, 0.0)), 0.0)
    inner = jnp.einsum('blhd,bmhd->bhlm', q, k) * decay
    o = jnp.einsum('bhlm,bmhe->blhe', inner, v)
    q_dec = jnp.exp(log_gamma[None, :] * (i[:, None] + 1.0))
    o = o + jnp.einsum('blhd,bhde->blhe', q * q_dec[None, :, :, None], S)
    k_dec = jnp.exp(log_gamma[None, :] * (L - 1.0 - i[:, None]))
    S_new = (jnp.exp(log_gamma * L)[None, :, None, None] * S
             + jnp.einsum('blhd,blhe->bhde', k * k_dec[None, :, :, None], v))
    return S_new, o


def _ssd_chunk(h, x, dt, Bm, Cm, A):
    L = x.shape[1]
    acum = jnp.cumsum(dt * A, axis=1)
    seg = acum[:, :, None, :] - acum[:, None, :, :]
    causal = (jnp.arange(L)[:, None] >= jnp.arange(L)[None, :])[None, :, :, None]
    Lmat = jnp.where(causal, jnp.exp(jnp.where(causal, seg, 0.0)), 0.0)
    Bh = jnp.repeat(Bm, HC // G_C, axis=2)
    Ch = jnp.repeat(Cm, HC // G_C, axis=2)
    cb = jnp.einsum('bihn,bjhn->bijh', Ch, Bh)
    y = jnp.einsum('bijh,bjh,bjhp->bihp', cb * Lmat, dt, x)
    y = y + jnp.einsum('bihn,bhpn->bihp', Ch * jnp.exp(acum)[..., None], h)
    w = jnp.exp(acum[:, -1:, :] - acum) * dt
    h_new = (jnp.exp(acum[:, -1, :])[:, :, None, None] * h
             + jnp.einsum('bjh,bjhp,bjhn->bhpn', w, x, Bh))
    return h_new, y


def _scan_chunks(step, carry, xs, chunk):
    B, T = xs[0].shape[0], xs[0].shape[1]
    nc = T // chunk
    xs_c = tuple(jnp.moveaxis(a.reshape((B, nc, chunk) + a.shape[2:]), 1, 0) for a in xs)
    carry, ys = lax.scan(lambda c, xx: step(c, *xx), carry, xs_c)
    ys = jnp.moveaxis(ys, 0, 1)
    return carry, ys.reshape((B, T) + ys.shape[3:])


def _dwconv(xpad, w, b):
    T = xpad.shape[1] - (CONV_W - 1)
    out = b
    for i in range(CONV_W):
        out = out + xpad[:, i:i + T] * w[i]
    return out


def _layer(x, c, p, rel_table, state, is_prompt):
    (sinks, n1, n2, aw, ab, w_in, cw, cbias, dtb, alog, dsk, snw, w_out, w_up, w_down) = p
    B_, T = x.shape[0], x.shape[1]
    xdt = x.dtype
    mod = jnp.dot(jax.nn.silu(c), aw) + ab
    sh1, sc1, g1, sh2, sc2, g2 = jnp.split(mod[:, None, :], 6, axis=-1)
    h = _rmsnorm(x, n1) * (1 + sc1) + sh1
    aq, ak, av, bq, bk, bv, bg, cz, cxbc, cdt, gts = _split_proj(jnp.dot(h, w_in))

    aq = aq.reshape(B_, T, HA_Q, HD_A)
    ak = ak.reshape(B_, T, HA_KV, HD_A)
    av = av.reshape(B_, T, HA_KV, HD_A)
    if is_prompt:
        oa = _attn_prompt(aq, ak, av, sinks, rel_table)
        kbuf, vbuf = ak[:, T - WINDOW:], av[:, T - WINDOW:]
    else:
        oa, kbuf, vbuf = _attn_sample(aq, ak, av, state[0], state[1], sinks, rel_table)

    pos = (0 if is_prompt else PAST_LEN) + jnp.arange(T)
    log_gamma = jnp.log(1.0 - 2.0 ** (-5.0 - jnp.arange(HB, dtype=F32)))
    qb = _xpos_rotate(bq.reshape(B_, T, HB, DK_B).astype(F32), pos)
    kb = _xpos_rotate(bk.reshape(B_, T, HB, DK_B).astype(F32) * (DK_B ** -0.5), pos)
    vb = bv.reshape(B_, T, HB, DV_B).astype(F32)
    ret_step = lambda S, q, k, v: _retention_chunk(S, q, k, v, log_gamma)
    if is_prompt:
        S_ret, ob = _scan_chunks(ret_step, jnp.zeros((B_, HB, DK_B, DV_B), F32), (qb, kb, vb), RET_CHUNK)
    else:
        S_ret, ob = ret_step(state[2].astype(F32), qb, kb, vb)
    ob = jax.nn.silu(bg.astype(F32)) * _rms(ob).reshape(B_, T, HB * DV_B)

    if is_prompt:
        hist = jnp.zeros((B_, CONV_W - 1, CONV_DIM), cxbc.dtype)
    else:
        hist = state[4].astype(cxbc.dtype)
    xpad = jnp.concatenate([hist, cxbc], axis=1)
    conv_new = xpad[:, T:]
    xbc = jax.nn.silu(_dwconv(xpad, cw, cbias).astype(F32))
    xc = xbc[..., :D_INNER_C].reshape(B_, T, HC, HD_C)
    Bc = xbc[..., D_INNER_C:D_INNER_C + G_C * N_C].reshape(B_, T, G_C, N_C)
    Cc = xbc[..., D_INNER_C + G_C * N_C:].reshape(B_, T, G_C, N_C)
    dtc = jax.nn.softplus(cdt.astype(F32) + dtb.astype(F32))
    A = -jnp.exp(alog.astype(F32))
    ssd_step = lambda hs, xx, dd, bb, cc: _ssd_chunk(hs, xx, dd, bb, cc, A)
    if is_prompt:
        h_ssm, yc = _scan_chunks(ssd_step, jnp.zeros((B_, HC, HD_C, N_C), F32), (xc, dtc, Bc, Cc), SSD_CHUNK)
    else:
        h_ssm, yc = ssd_step(state[3].astype(F32), xc, dtc, Bc, Cc)
    yc = yc + dsk.astype(F32)[:, None] * xc
    yc = yc.reshape(B_, T, D_INNER_C) * jax.nn.silu(cz.astype(F32))
    oc = _rms(yc.reshape(B_, T, G_C, D_INNER_C // G_C)).reshape(B_, T, D_INNER_C) * snw.astype(F32)

    ga, gb, gc = jnp.split(jax.nn.sigmoid(gts.astype(F32)), 3, axis=-1)
    mix = (ga * oa + gb * ob + gc * oc).astype(xdt)
    x = x + g1 * jnp.dot(mix, w_out)

    h2 = _rmsnorm(x, n2) * (1 + sc2) + sh2
    x = x + g2 * jnp.dot(jnp.square(jax.nn.relu(jnp.dot(h2, w_up))), w_down)

    if is_prompt:
        dts = (xdt, xdt, xdt, xdt, xdt)
    else:
        dts = tuple(s.dtype for s in state)
    new_state = (kbuf.astype(dts[0]), vbuf.astype(dts[1]), S_ret.astype(dts[2]),
                 h_ssm.astype(dts[3]), conv_new.astype(dts[4]))
    return x, new_state


def setup_inputs(seed: int = 0) -> dict:
    key = jax.random.key(seed)
    ks = jax.random.split(key, 32)
    nrm = lambda k, shape, s: jax.random.normal(k, shape, F32) * s
    win_buf = min(WINDOW, PAST_LEN)
    dt0 = jnp.exp(jax.random.uniform(ks[20], (DEPTH, HC), F32, math.log(1e-3), math.log(1e-1)))
    return {
        "x_prompt": nrm(ks[0], (BATCH, SEQ, D_MODEL), 1.0),
        "x_sample": nrm(ks[1], (DEC_BATCH, DEC_SEQ, D_MODEL), 1.0),
        "cache_win_k": nrm(ks[2], (DEPTH, DEC_BATCH, win_buf, HA_KV, HD_A), 1.0),
        "cache_win_v": nrm(ks[3], (DEPTH, DEC_BATCH, win_buf, HA_KV, HD_A), 1.0),
        "state_ret": nrm(ks[4], (DEPTH, DEC_BATCH, HB, DK_B, DV_B), 0.1),
        "state_ssm": nrm(ks[5], (DEPTH, DEC_BATCH, HC, HD_C, N_C), 0.1),
        "state_conv": nrm(ks[6], (DEPTH, DEC_BATCH, CONV_W - 1, CONV_DIM), 1.0),
        "c_prompt": nrm(ks[7], (BATCH, D_MODEL), 1.0),
        "c_sample": nrm(ks[8], (DEC_BATCH, D_MODEL), 1.0),
        "rel_bias_table": nrm(ks[9], (NUM_BUCKETS, HA_Q), 0.5),
        "attn_sinks": nrm(ks[10], (DEPTH, HA_Q), 1.0),
        "norm1_w": 1.0 + nrm(ks[11], (DEPTH, D_MODEL), 0.01),
        "norm2_w": 1.0 + nrm(ks[12], (DEPTH, D_MODEL), 0.01),
        "ada_w": nrm(ks[13], (DEPTH, D_MODEL, 6 * D_MODEL), 0.5 * D_MODEL ** -0.5),
        "ada_b": nrm(ks[14], (DEPTH, 6 * D_MODEL), 0.02),
        "w_in": nrm(ks[15], (DEPTH, D_MODEL, D_IN), D_MODEL ** -0.5),
        "conv_w": nrm(ks[16], (DEPTH, CONV_W, CONV_DIM), CONV_W ** -0.5),
        "conv_b": nrm(ks[17], (DEPTH, CONV_DIM), 0.02),
        "dt_bias": dt0 + jnp.log(-jnp.expm1(-dt0)),
        "A_log": jnp.log(jax.random.uniform(ks[18], (DEPTH, HC), F32, 1.0, 16.0)),
        "D_skip": 1.0 + nrm(ks[19], (DEPTH, HC), 0.1),
        "ssm_norm_w": 1.0 + nrm(ks[21], (DEPTH, D_INNER_C), 0.01),
        "w_out": nrm(ks[22], (DEPTH, D_MODEL, D_MODEL), D_MODEL ** -0.5),
        "w_up": nrm(ks[23], (DEPTH, D_MODEL, D_FF), D_MODEL ** -0.5),
        "w_down": nrm(ks[24], (DEPTH, D_FF, D_MODEL), D_FF ** -0.5),
        "final_norm_w": 1.0 + nrm(ks[25], (D_MODEL,), 0.01),
    }


def reference(x_prompt, x_sample, cache_win_k, cache_win_v, state_ret, state_ssm, state_conv,
              c_prompt, c_sample, rel_bias_table, attn_sinks, norm1_w, norm2_w, ada_w, ada_b,
              w_in, conv_w, conv_b, dt_bias, A_log, D_skip, ssm_norm_w, w_out, w_up, w_down,
              final_norm_w):
    xp, xs = x_prompt, x_sample
    sp, ss = [], []
    for l in range(DEPTH):
        p = (attn_sinks[l], norm1_w[l], norm2_w[l], ada_w[l], ada_b[l], w_in[l], conv_w[l], conv_b[l],
             dt_bias[l], A_log[l], D_skip[l], ssm_norm_w[l], w_out[l], w_up[l], w_down[l])
        xp, st_p = _layer(xp, c_prompt, p, rel_bias_table, None, True)
        xs, st_s = _layer(xs, c_sample, p, rel_bias_table,
                          (cache_win_k[l], cache_win_v[l], state_ret[l], state_ssm[l], state_conv[l]), False)
        sp.append(st_p)
        ss.append(st_s)
    stk = lambda sts, i: jnp.stack([s[i] for s in sts], axis=0)
    y_prompt = _rmsnorm(xp, final_norm_w)
    y_sample = _rmsnorm(xs, final_norm_w)
    return (y_prompt, y_sample,
            stk(sp, 0), stk(sp, 1), stk(sp, 2), stk(sp, 3), stk(sp, 4),
            stk(ss, 0), stk(ss, 1), stk(ss, 2), stk(ss, 3), stk(ss, 4))
```

```cpp
#include <hip/hip_runtime.h>
#include <hip/hip_bf16.h>
#include <hip/hip_cooperative_groups.h>
#include <cstdio>
namespace cg = cooperative_groups;

#ifndef FUSED
#define FUSED 1
#endif

typedef unsigned short u16;
using bf16 = __hip_bfloat16;
using bf16x8 = __attribute__((ext_vector_type(8))) short;
using s16x4  = __attribute__((ext_vector_type(4))) short;
using f32x4  = __attribute__((ext_vector_type(4))) float;
using f32x16 = __attribute__((ext_vector_type(16))) float;
using u32x4  = __attribute__((ext_vector_type(4))) unsigned;
using u32x2  = __attribute__((ext_vector_type(2))) unsigned;
#define DI __device__ __forceinline__

constexpr int D = 1024, DIN = 10256, ZS = 10496, DFF = 4096;
constexpr int MPROMPT = 32768, MVALID = 32896;
constexpr int HALF_ROWS = 16384, ZROWS = 16640;
constexpr int C_AQ = 0, C_AK = 1024, C_AV = 1280, C_BQ = 1536, C_BK = 2048, C_BV = 2560, C_BG = 3584, C_CZ = 4608,
              C_CX = 5632, C_DT = 7168, C_GA = 7184, C_GB = 8208, C_GC = 9232;
constexpr int MODS = 12288;
constexpr float EPS = 1e-6f;
constexpr int NT = 512;

constexpr size_t O_YP = 0, O_YS = O_YP + 33554432, O_WKP = O_YS + 131072, O_WVP = O_WKP + 1048576, O_RETP = O_WVP + 1048576,
                 O_SSMP = O_RETP + 2097152, O_CONVP = O_SSMP + 4194304, O_WKS = O_CONVP + 147456, O_WVS = O_WKS + 8388608,
                 O_RETS = O_WVS + 8388608, O_SSMS = O_RETS + 16777216, O_CONVS = O_SSMS + 33554432;
constexpr size_t WS_CTR = 0, WS_BT = 256, WS_SC = 16384, WS_MOD = WS_SC + 524288, WS_AWT = WS_MOD + 7077888,
                 WS_WIN = WS_AWT + 25165824, WS_WOUT = WS_WIN + 42991616, WS_WUP = WS_WOUT + 4194304, WS_WDN = WS_WUP + 16777216,
                 WS_H = WS_WDN + 16777216, WS_YC = WS_H + 34078720, WS_Z = WS_YC + 34078720, WS_XBC = WS_Z + 349306880,
                 WS_DT = WS_XBC + 51118080, WS_SS1 = WS_DT + 1064960, WS_SS2 = WS_SS1 + 66560, WS_C1 = WS_SS2 + 66560,
                 WS_C2 = WS_C1 + 6045696, WS_SHB = WS_C2 + 4718592, WS_END = WS_SHB + 1572864;
constexpr int LDS_BYTES = 147456;

struct Params {
  const float *x_prompt, *x_sample, *cache_k, *cache_v, *state_ret, *state_ssm, *state_conv, *c_prompt, *c_sample, *rel, *sinks,
      *n1, *n2, *ada_w, *ada_b, *w_in, *conv_w, *conv_b, *dt_bias, *A_log, *D_skip, *snw, *w_out, *w_up, *w_down, *fnw;
  float* out; unsigned char* ws; int ph_lo, ph_hi;
};

typedef float f32x2v __attribute__((ext_vector_type(2)));
typedef __bf16 bf16x2v __attribute__((ext_vector_type(2)));
DI unsigned pack2(float a, float b) { f32x2v v = {a, b}; return __builtin_bit_cast(unsigned, __builtin_convertvector(v, bf16x2v)); }
DI u16 f2bf(float x) { return (u16)(pack2(x, 0.f) & 0xffffu); }
DI float bf2f(u16 h) { return __uint_as_float(((unsigned)h) << 16); }
DI float bfs(short h) { return __uint_as_float(((unsigned)(u16)h) << 16); }
DI bf16x8 ld8(const u16* p) { return *reinterpret_cast<const bf16x8*>(p); }
DI void st8(u16* p, bf16x8 v) { *reinterpret_cast<bf16x8*>(p) = v; }
DI bf16x8 cat4(s16x4 lo, s16x4 hi) { return __builtin_shufflevector(lo, hi, 0, 1, 2, 3, 4, 5, 6, 7); }
DI f32x16 zero16() { f32x16 v; _Pragma("unroll") for (int i = 0; i < 16; ++i) v[i] = 0.f; return v; }
DI int crow(int i, int h) { return (i & 3) + 8 * (i >> 2) + 4 * h; }
#define MFMA32(a, b, c) __builtin_amdgcn_mfma_f32_32x32x16_bf16((a), (b), (c), 0, 0, 0)
template <int S> DI bf16x8 packP(const f32x16& x) {
  u32x4 p; p[0] = pack2(x[8 * S], x[8 * S + 1]); p[1] = pack2(x[8 * S + 2], x[8 * S + 3]);
  p[2] = pack2(x[8 * S + 4], x[8 * S + 5]); p[3] = pack2(x[8 * S + 6], x[8 * S + 7]);
  return __builtin_bit_cast(bf16x8, p);
}
DI bf16x8 pack8(const float* v) {
  u32x4 p; p[0] = pack2(v[0], v[1]); p[1] = pack2(v[2], v[3]); p[2] = pack2(v[4], v[5]); p[3] = pack2(v[6], v[7]);
  return __builtin_bit_cast(bf16x8, p);
}
DI void st4bf(u16* p, float a, float b, float c, float d) { u32x2 v; v[0] = pack2(a, b); v[1] = pack2(c, d); *reinterpret_cast<u32x2*>(p) = v; }
DI float siluf(float x) { return x / (1.f + __expf(-x)); }
DI float sigmf(float x) { return 1.f / (1.f + __expf(-x)); }
DI float softplusf(float x) { return x > 20.f ? x : log1pf(expf(x)); }
DI int otid() { int t = threadIdx.x; asm volatile("" : "+v"(t)); return t; }
template <class T> DI T* optr(T* p) { asm volatile("" : "+s"(p)); return p; }
DI int modrow(int r) { return r < MPROMPT ? (r >> 11) : 16 + (r - MPROMPT); }
DI void sincos_rev(float ang, float& s, float& c) {
  float k = rintf(ang * 0.15915494309189535f);
  float red = fmaf(-k, 6.28318548202514648f, ang);
  red = fmaf(-k, -1.7484555e-7f, red);
  float fr = red * 0.15915494309189535f;
  s = __builtin_amdgcn_sinf(fr); c = __builtin_amdgcn_cosf(fr);
}

constexpr int BM = 256, BK = 64, HALFT = 128, HT = HALFT * BK;
DI int lds_byte(int r, int c) { int st = (r >> 4) * 2 + (c >> 5), rr = r & 15, cc = c & 31, ob = rr * 64 + cc * 2; return st * 1024 + (ob ^ (((ob >> 9) & 1) << 5)); }
DI void stage_rc(int b, int& R, int& C) { int st = b / 1024, sb = b % 1024, swz = sb ^ (((sb >> 9) & 1) << 5); R = (st >> 1) * 16 + swz / 64; C = (st & 1) * 32 + (swz % 64) / 2; }

struct Epi {
  int kind;
  u16* c16; int ldc;
  int rb, nv;
  const float* res_p; const float* res_s;
  float* xout;
  const float* mod; int goff;
  float* modout; const float* ada_b;
  u16* shb;
  float* cout;
  int fuse;
  const float* fw; int fsc; u16* fa; float* fss;
  int cons;
  const float* css; const float* cc; int ccld;
};

#define LAS __attribute__((address_space(3)))
constexpr int HTB = HALFT * BK * 2;
DI void epilogue(const f32x4 (&acc)[2][2][4][2], const Epi& E, int brow, int bcol, int wr, int wc, int fr, int fq, int at) {
  const int col0 = bcol + wc * 32 + fq * 4;
  const int row0 = brow + wr * 64 + fr;
  const bool ptile = (E.rb + brow + 255) < MPROMPT;
  const int pb = (E.rb + brow) >> 11;
#define ECOL(j) (col0 + ((j) >> 1) * HALFT + ((j) & 1) * 16)
#define EROW(g) (row0 + ((g) >> 2) * HALFT + ((g) & 3) * 16)
#define EACC(g, j) acc[(g) >> 2][(j) >> 1][(g) & 3][(j) & 1]
  if (E.kind <= 1) {
    float ssv[8]; f32x4 cv[4];
    if (E.cons) {
      _Pragma("unroll") for (int g = 0; g < 8; ++g) ssv[g] = E.css[EROW(g)];
      if (ptile) { _Pragma("unroll") for (int j = 0; j < 4; ++j) cv[j] = *reinterpret_cast<const f32x4*>(E.cc + (size_t)pb * E.ccld + ECOL(j)); }
    }
    _Pragma("unroll") for (int g = 0; g < 8; ++g) {
      const int row = EROW(g);
      float rsv = 1.f;
      if (E.cons) {
        rsv = rsqrtf(ssv[g] * (1.f / D) + EPS);
        if (!ptile) { const int mrc = min(modrow(E.rb + row), 143);
          _Pragma("unroll") for (int j = 0; j < 4; ++j) cv[j] = *reinterpret_cast<const f32x4*>(E.cc + (size_t)mrc * E.ccld + ECOL(j)); }
      }
      _Pragma("unroll") for (int j = 0; j < 4; ++j) {
        f32x4 v = EACC(g, j);
        if (E.cons) v = v * rsv + cv[j];
        if (E.kind == 1) { _Pragma("unroll") for (int q = 0; q < 4; ++q) { const float a = fmaxf(v[q], 0.f); v[q] = a * a; } }
        st4bf(E.c16 + (size_t)row * E.ldc + ECOL(j), v[0], v[1], v[2], v[3]);
      }
    }
  } else if (E.kind == 2) {
    if (at) {
      _Pragma("unroll") for (int g = 0; g < 8; ++g) {
        const int row = EROW(g);
        if (row < E.nv) {
          const int r = E.rb + row;
          _Pragma("unroll") for (int j = 0; j < 4; ++j) {
            const f32x4 gg = *reinterpret_cast<const f32x4*>(E.mod + (size_t)modrow(r) * MODS + E.goff + ECOL(j));
            const f32x4 v = EACC(g, j);
            float* xp = E.xout + (size_t)r * D + ECOL(j);
            _Pragma("unroll") for (int q = 0; q < 4; ++q) unsafeAtomicAdd(xp + q, gg[q] * v[q]);
          }
        }
      }
    } else {
      f32x4 g4[4], w4[4], s4[4], xc[4], xq[4];
      const float* mrow0 = E.mod + (size_t)pb * MODS;
      if (ptile) { _Pragma("unroll") for (int j = 0; j < 4; ++j) { g4[j] = *reinterpret_cast<const f32x4*>(mrow0 + E.goff + ECOL(j));
          if (E.fuse) s4[j] = *reinterpret_cast<const f32x4*>(mrow0 + E.fsc + ECOL(j)); } }
      if (E.fuse) { _Pragma("unroll") for (int j = 0; j < 4; ++j) w4[j] = *reinterpret_cast<const f32x4*>(E.fw + ECOL(j)); }
#define LOADX(g, dst) do { const int _row = EROW(g); const int _r = E.rb + _row; \
        const float* _rs = (_r < MPROMPT) ? (E.res_p + (size_t)_r * D) : (E.res_s + (size_t)(_r - MPROMPT) * D); \
        _Pragma("unroll") for (int j = 0; j < 4; ++j) dst[j] = (_row < E.nv) ? *reinterpret_cast<const f32x4*>(_rs + ECOL(j)) : (f32x4){0.f, 0.f, 0.f, 0.f}; } while (0)
      LOADX(0, xc);
      _Pragma("unroll") for (int g = 0; g < 8; ++g) {
        const int row = EROW(g); const int r = E.rb + row; const bool ok = row < E.nv;
        if (g + 1 < 8) LOADX(g + 1, xq);
        if (!ptile && ok) { const float* mr = E.mod + (size_t)modrow(r) * MODS;
          _Pragma("unroll") for (int j = 0; j < 4; ++j) { g4[j] = *reinterpret_cast<const f32x4*>(mr + E.goff + ECOL(j)); if (E.fuse) s4[j] = *reinterpret_cast<const f32x4*>(mr + E.fsc + ECOL(j)); } }
        float ssq = 0.f;
        if (ok) {
          _Pragma("unroll") for (int j = 0; j < 4; ++j) {
            const f32x4 xn = xc[j] + g4[j] * EACC(g, j);
            *reinterpret_cast<f32x4*>(E.xout + (size_t)r * D + ECOL(j)) = xn;
            if (E.fuse) {
              const f32x4 a = xn * w4[j] * (s4[j] + 1.f);
              st4bf(E.fa + (size_t)row * D + ECOL(j), a[0], a[1], a[2], a[3]);
              ssq += xn[0] * xn[0] + xn[1] * xn[1] + xn[2] * xn[2] + xn[3] * xn[3];
            }
          }
        }
        if (E.fuse) {
          ssq += __shfl_xor(ssq, 16); ssq += __shfl_xor(ssq, 32);
          if (fq == 0 && ok) unsafeAtomicAdd(E.fss + row, ssq);
        }
        _Pragma("unroll") for (int j = 0; j < 4; ++j) xc[j] = xq[j];
      }
#undef LOADX
    }
  } else if (E.kind == 3) {
    _Pragma("unroll") for (int g = 0; g < 8; ++g) {
      const int row = EROW(g);
      if (row < 144) {
        _Pragma("unroll") for (int j = 0; j < 4; ++j) {
          const int col = ECOL(j);
          const f32x4 bb = *reinterpret_cast<const f32x4*>(E.ada_b + col);
          const f32x4 o = EACC(g, j) + bb;
          *reinterpret_cast<f32x4*>(E.modout + (size_t)row * MODS + col) = o;
          const int ch = col >> 10;
          const int sl = (ch == 6) ? 0 : (ch == 3) ? 1 : (ch == 9) ? 2 : -1;
          if (sl >= 0) st4bf(E.shb + ((size_t)sl * 256 + row) * D + (col & 1023), o[0], o[1], o[2], o[3]);
        }
      }
    }
  } else {
    _Pragma("unroll") for (int g = 0; g < 8; ++g) {
      const int row = EROW(g);
      if (row < 144) { _Pragma("unroll") for (int j = 0; j < 4; ++j) *reinterpret_cast<f32x4*>(E.cout + (size_t)row * E.ldc + ECOL(j)) = EACC(g, j); }
    }
  }
#undef ECOL
#undef EROW
#undef EACC
}

DI void tile_of(int tile, int ntm, int ntn, int& pm, int& pn) {
  const int nig = 8 * ntn, gid = tile / nig, fm = gid * 8, gsz = min(ntm - fm, 8);
  pm = fm + ((tile % nig) % gsz); pn = (tile % nig) / gsz;
}

DI void gemm_phase(char* shm_, const bf16* __restrict__ Ag, const bf16* __restrict__ Btg, int K, int ntm, int ntn, const Epi& E, int split, int toff) {
  LAS unsigned char* lds = (LAS unsigned char*)shm_;
  const int tid = otid(), wid = __builtin_amdgcn_readfirstlane(tid >> 6), lane = tid & 63, wr = wid >> 2, wc = wid & 3, fr = lane & 15, fq = lane >> 4;
  const int ntk = K / BK;
  const int ntmf = split ? ntm - 1 : ntm, nfull = ntmf * ntn;
  const int G = gridDim.x, ntiles = nfull + (split ? ntn * (K / 256) : 0);
  const int bxr = (G % 8 == 0) ? (int)((blockIdx.x % 8) * (G / 8) + blockIdx.x / 8) : (int)blockIdx.x;
  unsigned voffA[2];
  _Pragma("unroll") for (int i = 0; i < 2; ++i) { int R, C; stage_rc(tid * 16 + i * 8192, R, C); voffA[i] = (unsigned)(R * K + C) * 2u; }
  const size_t kstep = (size_t)(BK * 2), hstep = (size_t)HALFT * K * 2, tstep = 2 * hstep;
  const unsigned ldsw = (unsigned)wid * 1024u;
  const int aoff = lds_byte(wr * 64 + fr, fq * 8), boff = lds_byte(wc * 32 + fr, fq * 8);
#define PSA(b, h) (((b) * 2 + (h)) * HTB)
#define PSB(b, h) ((4 + (b) * 2 + (h)) * HTB)
#define PSTAGE(bufoff, gbase) do { _Pragma("unroll") for (int _i = 0; _i < 2; ++_i) \
    __builtin_amdgcn_global_load_lds((const unsigned*)((const char*)(gbase) + voffA[_i]), (LAS unsigned*)(lds + (bufoff) + ldsw + _i * 8192), 16, 0, 0); } while (0)
#define PLDA(dst, b, h) do { _Pragma("unroll") for (int m = 0; m < 4; ++m) _Pragma("unroll") for (int k = 0; k < 2; ++k) dst[m][k] = *(const LAS bf16x8*)(lds + PSA(b, h) + aoff + m * 2048 + k * 1024); } while (0)
#define PLDB(dst, b, h) do { _Pragma("unroll") for (int n = 0; n < 2; ++n) _Pragma("unroll") for (int k = 0; k < 2; ++k) dst[n][k] = *(const LAS bf16x8*)(lds + PSB(b, h) + boff + n * 2048 + k * 1024); } while (0)
#define PMMA(ai, bj, At, Bq) do { __builtin_amdgcn_s_setprio(1); _Pragma("unroll") for (int m = 0; m < 4; ++m) _Pragma("unroll") for (int n = 0; n < 2; ++n) _Pragma("unroll") for (int k = 0; k < 2; ++k) \
    acc[ai][bj][m][n] = __builtin_amdgcn_mfma_f32_16x16x32_bf16(Bq[n][k], At[m][k], acc[ai][bj][m][n], 0, 0, 0); __builtin_amdgcn_s_setprio(0); } while (0)
#define WAIT_V(n) asm volatile("s_waitcnt vmcnt(" #n ")" ::: "memory")
#define WAIT_L(n) asm volatile("s_waitcnt lgkmcnt(" #n ")" ::: "memory")
#define BAR __builtin_amdgcn_s_barrier()
#define SCHED __builtin_amdgcn_sched_barrier(0)
  int tile = bxr - toff;
  if (tile < 0 || tile >= ntiles) return;
#define UNIT_OF(u, PM, PN, K0, NTU, AT) do { if ((u) < nfull) { tile_of((u), ntmf, ntn, PM, PN); K0 = 0; NTU = ntk; AT = 0; } \
    else { const int _s = (u) - nfull; PN = _s % ntn; PM = ntmf; K0 = (_s / ntn) * 256; NTU = 4; AT = 1; } } while (0)
  int pm, pn, k0, nt, at; UNIT_OF(tile, pm, pn, k0, nt, at);
  f32x4 acc[2][2][4][2];
  _Pragma("unroll") for (int a = 0; a < 2; ++a) _Pragma("unroll") for (int b = 0; b < 2; ++b) _Pragma("unroll") for (int m = 0; m < 4; ++m) _Pragma("unroll") for (int n = 0; n < 2; ++n) acc[a][b][m][n] = (f32x4){0.f, 0.f, 0.f, 0.f};
  bf16x8 At[4][2], B0[2][2], B1[2][2];
  const char* cA = (const char*)Ag + (size_t)pm * tstep + (size_t)k0 * 2; const char* cB = (const char*)Btg + (size_t)pn * tstep + (size_t)k0 * 2;
  PSTAGE(PSB(0, 0), cB); PSTAGE(PSA(0, 0), cA); PSTAGE(PSB(0, 1), cB + hstep); PSTAGE(PSA(0, 1), cA + hstep);
  if (wr == 1) BAR;
  WAIT_V(4); BAR;
  PSTAGE(PSB(1, 0), cB + kstep); PSTAGE(PSA(1, 0), cA + kstep); PSTAGE(PSB(1, 1), cB + hstep + kstep);
  WAIT_V(6); BAR;
  for (;;) {
    const int ntile = tile + G;
    const bool has_next = ntile < ntiles;
    int npm = pm, npn = pn, nk0 = k0, nnt = nt, nat = at; if (has_next) UNIT_OF(ntile, npm, npn, nk0, nnt, nat);
    const char* nA = has_next ? (const char*)Ag + (size_t)npm * tstep + (size_t)nk0 * 2 : cA; const char* nB = has_next ? (const char*)Btg + (size_t)npn * tstep + (size_t)nk0 * 2 : cB;
    for (int t = 0; t < nt; t += 2) {
      const bool last = (t == nt - 2);
      const char* a1 = cA + (size_t)(t + 1) * kstep;
      const char* a2 = last ? nA : cA + (size_t)(t + 2) * kstep; const char* b2 = last ? nB : cB + (size_t)(t + 2) * kstep;
      const char* a3 = a2 + kstep; const char* b3 = b2 + kstep;
      PLDB(B0, 0, 0); SCHED; PLDA(At, 0, 0); PSTAGE(PSA(1, 1), a1 + hstep);
      WAIT_L(8); BAR; WAIT_L(0); PMMA(0, 0, At, B0); BAR; SCHED;
      PLDB(B1, 0, 1); PSTAGE(PSB(0, 0), b2);
      BAR; WAIT_L(0); PMMA(0, 1, At, B1); BAR;
      PLDA(At, 0, 1); PSTAGE(PSA(0, 0), a2);
      BAR; WAIT_L(0); PMMA(1, 0, At, B0); BAR; SCHED;
      PSTAGE(PSB(0, 1), b2 + hstep);
      WAIT_V(6); BAR; PMMA(1, 1, At, B1); BAR;
      PLDB(B0, 1, 0); SCHED; PLDA(At, 1, 0); PSTAGE(PSA(0, 1), a2 + hstep);
      WAIT_L(8); BAR; WAIT_L(0); PMMA(0, 0, At, B0); BAR; SCHED;
      PLDB(B1, 1, 1); PSTAGE(PSB(1, 0), b3);
      BAR; WAIT_L(0); PMMA(0, 1, At, B1); BAR;
      PLDA(At, 1, 1); PSTAGE(PSA(1, 0), a3);
      BAR; WAIT_L(0); PMMA(1, 0, At, B0); BAR; SCHED;
      PSTAGE(PSB(1, 1), b3 + hstep);
      WAIT_V(6); BAR; PMMA(1, 1, At, B1); BAR;
    }
    epilogue(acc, E, pm * BM, pn * BM, wr, wc, fr, fq, at);
    if (!has_next) break;
    _Pragma("unroll") for (int a = 0; a < 2; ++a) _Pragma("unroll") for (int b = 0; b < 2; ++b) _Pragma("unroll") for (int m = 0; m < 4; ++m) _Pragma("unroll") for (int n = 0; n < 2; ++n) acc[a][b][m][n] = (f32x4){0.f, 0.f, 0.f, 0.f};
    tile = ntile; pm = npm; pn = npn; k0 = nk0; nt = nnt; at = nat; cA = nA; cB = nB;
  }
  WAIT_V(0);
  if (wr == 0) BAR;
  BAR;
}

struct TJob { const float* src; u16* dst; int K, N, tk, tn; };
DI TJob tjob_of(const Params& P, unsigned char* ws, int job) {
  TJob J; const int l = job / 6464; int j = job % 6464;
  if (j < 2624) { J.src = P.w_in + (size_t)l * D * DIN; J.dst = (u16*)(ws + WS_WIN) + (size_t)l * ZS * D; J.K = D; J.N = DIN; J.tk = j / 164; J.tn = j % 164; }
  else if ((j -= 2624) < 256) { J.src = P.w_out + (size_t)l * D * D; J.dst = (u16*)(ws + WS_WOUT) + (size_t)l * D * D; J.K = D; J.N = D; J.tk = j / 16; J.tn = j % 16; }
  else if ((j -= 256) < 1024) { J.src = P.w_up + (size_t)l * D * DFF; J.dst = (u16*)(ws + WS_WUP) + (size_t)l * DFF * D; J.K = D; J.N = DFF; J.tk = j / 64; J.tn = j % 64; }
  else if ((j -= 1024) < 1024) { J.src = P.w_down + (size_t)l * DFF * D; J.dst = (u16*)(ws + WS_WDN) + (size_t)l * D * DFF; J.K = DFF; J.N = D; J.tk = j / 16; J.tn = j % 16; }
  else { j -= 1024; J.src = P.ada_w + (size_t)l * D * 6144; J.dst = (u16*)(ws + WS_AWT) + (size_t)l * 6144 * D; J.K = D; J.N = 6144; J.tk = j / 96; J.tn = j % 96; }
  return J;
}
DI void tjob_load(const TJob& J, int tid, f32x4 (&v)[2]) {
  const int nn = (tid & 15) * 4, n = J.tn * 64 + nn;
  _Pragma("unroll") for (int i = 0; i < 2; ++i) { const int kk = (tid >> 4) + 32 * i;
    v[i] = (n < J.N) ? *reinterpret_cast<const f32x4*>(J.src + (size_t)(J.tk * 64 + kk) * J.N + n) : (f32x4){0.f, 0.f, 0.f, 0.f}; }
}

DI void prep_phase(char* shm, const Params& P) {
  float* tl = (float*)shm;
  unsigned char* ws = optr(P.ws);
  int bx_ = blockIdx.x; asm volatile("" : "+s"(bx_));
  int G_ = gridDim.x; asm volatile("" : "+s"(G_));
  const int G = G_, bx = bx_, tid = otid();
  const int njobs = 2 * 6464;
  if (bx < njobs) {
    f32x4 v[2];
    { const TJob J0 = tjob_of(P, ws, bx); tjob_load(J0, tid, v); }
    _Pragma("unroll 1") for (int job = bx; job < njobs; job += G) {
      __syncthreads();
      { const int nn = (tid & 15) * 4; _Pragma("unroll") for (int i = 0; i < 2; ++i) { const int kk = (tid >> 4) + 32 * i;
          _Pragma("unroll") for (int q = 0; q < 4; ++q) tl[kk * 65 + nn + q] = v[i][q]; } }
      if (job + G < njobs) { const TJob Jn = tjob_of(P, ws, job + G); tjob_load(Jn, tid, v); }
      __syncthreads();
      { const TJob Jc = tjob_of(P, ws, job);
        const int nn = tid >> 3, kp = tid & 7; float o[8]; _Pragma("unroll") for (int j = 0; j < 8; ++j) o[j] = tl[(kp * 8 + j) * 65 + nn];
        st8(Jc.dst + (size_t)(Jc.tn * 64 + nn) * Jc.K + Jc.tk * 64 + kp * 8, pack8(o)); }
    }
  }
  { unsigned* shb = (unsigned*)(ws + WS_SHB); _Pragma("unroll 1") for (int e = bx * NT + tid; e < 3 * 256 * 1024 / 2; e += G * NT) shb[e] = 0u; }
  u16* sc = (u16*)(ws + WS_SC);
  _Pragma("unroll 1") for (int e = bx * NT + tid; e < 256 * 1024; e += G * NT) {
    int row = e >> 10, c = e & 1023; float v = 0.f;
    if (row < 16) v = siluf(P.c_prompt[row * D + c]); else if (row < 144) v = siluf(P.c_sample[(row - 16) * D + c]);
    sc[e] = f2bf(v);
  }
  if (bx == 0) {
    float* bt = (float*)(ws + WS_BT);
    for (int e = tid; e < 128 * 16; e += NT) {
      int n = e >> 4, hd = e & 15; int bk;
      if (n < 16) bk = n; else { float nf = (float)n; int lg = 16 + (int)(logf(nf / 16.f) / 2.0794415416798357f * 16.f); bk = lg < 31 ? lg : 31; }
      bt[e] = P.rel[bk * 16 + hd];
    }
  }
}

DI void norm_phase(const Params& P, int l, int hf, int which  , bool from_input) {
  const int RB = hf * HALF_ROWS, NV = hf ? 16512 : 16384, NR = hf ? 16640 : 16384;
  const int tid = otid(); const int w = tid >> 6, lane = tid & 63;
  u16* H = (u16*)(optr(P.ws) + WS_H);
  const float* mod = (const float*)(optr(P.ws) + WS_MOD);
  const float* nw = (which ? P.n2 : P.n1) + l * D;
  const int stride = gridDim.x * 8;
  f32x4 nx[4];
#define NORM_SRC(lrow) (from_input ? ((RB + (lrow)) < MPROMPT ? P.x_prompt + (size_t)(RB + (lrow)) * D : P.x_sample + (size_t)(RB + (lrow) - MPROMPT) * D) : P.out + (size_t)(RB + (lrow)) * D)
  f32x4 nsh[4], nsc[4], nw4[4];
  _Pragma("unroll") for (int k = 0; k < 4; ++k) nw4[k] = *reinterpret_cast<const f32x4*>(nw + lane * 4 + 256 * k);
#define NORM_LOAD(lrow) do { const float* _xr = NORM_SRC(lrow); const float* _mr = mod + (size_t)modrow(RB + (lrow)) * MODS + l * 6144 + which * 3072; \
    _Pragma("unroll") for (int k = 0; k < 4; ++k) { nx[k] = *reinterpret_cast<const f32x4*>(_xr + lane * 4 + 256 * k); nsh[k] = *reinterpret_cast<const f32x4*>(_mr + lane * 4 + 256 * k); nsc[k] = *reinterpret_cast<const f32x4*>(_mr + 1024 + lane * 4 + 256 * k); } } while (0)
  int lr = blockIdx.x * 8 + w;
  if (lr < NV) NORM_LOAD(lr);
  _Pragma("unroll 1") for (; lr < NR; lr += stride) {
    u16* hrow = H + (size_t)lr * D;
    if (lr >= NV) { _Pragma("unroll") for (int k = 0; k < 4; ++k) st4bf(hrow + lane * 4 + 256 * k, 0.f, 0.f, 0.f, 0.f); continue; }
    const int r = RB + lr;
    f32x4 x[4], csh[4], csc[4]; float ss = 0.f;
    _Pragma("unroll") for (int k = 0; k < 4; ++k) { x[k] = nx[k]; csh[k] = nsh[k]; csc[k] = nsc[k]; ss += x[k][0] * x[k][0] + x[k][1] * x[k][1] + x[k][2] * x[k][2] + x[k][3] * x[k][3]; }
    if (lr + stride < NV) NORM_LOAD(lr + stride);
    for (int o = 32; o >= 1; o >>= 1) ss += __shfl_xor(ss, o);
    const float rs = rsqrtf(ss * (1.f / D) + EPS);
    if (from_input && r >= MPROMPT) { _Pragma("unroll") for (int k = 0; k < 4; ++k) *reinterpret_cast<f32x4*>(P.out + (size_t)r * D + lane * 4 + 256 * k) = x[k]; }
    _Pragma("unroll") for (int k = 0; k < 4; ++k) {
      const int c = lane * 4 + 256 * k;
      f32x4 y = x[k] * rs * nw4[k] * (csc[k] + 1.f) + csh[k];
      st4bf(hrow + c, y[0], y[1], y[2], y[3]);
    }
  }
}

DI void final_norm_phase(const Params& P) {
  const int tid = otid(); const int w = tid >> 6, lane = tid & 63;
  const int stride = gridDim.x * 8;
  f32x4 nx[4], fw4[4];
  _Pragma("unroll") for (int k = 0; k < 4; ++k) fw4[k] = *reinterpret_cast<const f32x4*>(P.fnw + lane * 4 + 256 * k);
  int r = blockIdx.x * 8 + w;
  if (r < MVALID) { _Pragma("unroll") for (int k = 0; k < 4; ++k) nx[k] = *reinterpret_cast<const f32x4*>(P.out + (size_t)r * D + lane * 4 + 256 * k); }
  _Pragma("unroll 1") for (; r < MVALID; r += stride) {
    float* xr = P.out + (size_t)r * D;
    f32x4 x[4]; float ss = 0.f;
    _Pragma("unroll") for (int k = 0; k < 4; ++k) { x[k] = nx[k]; ss += x[k][0] * x[k][0] + x[k][1] * x[k][1] + x[k][2] * x[k][2] + x[k][3] * x[k][3]; }
    if (r + stride < MVALID) { _Pragma("unroll") for (int k = 0; k < 4; ++k) nx[k] = *reinterpret_cast<const f32x4*>(P.out + (size_t)(r + stride) * D + lane * 4 + 256 * k); }
    for (int o = 32; o >= 1; o >>= 1) ss += __shfl_xor(ss, o);
    const float rs = rsqrtf(ss * (1.f / D) + EPS);
    _Pragma("unroll") for (int k = 0; k < 4; ++k) { const int c = lane * 4 + 256 * k; *reinterpret_cast<f32x4*>(xr + c) = x[k] * rs * fw4[k]; }
  }
}

DI void conv_phase(const Params& P, int l, int hf) {
  const int tid = otid();
  const u16* Z = (const u16*)(optr(P.ws) + WS_Z);
  u16* XBC = (u16*)(optr(P.ws) + WS_XBC);
  float* DT = (float*)(optr(P.ws) + WS_DT);
  const float* cw = P.conv_w + (size_t)l * 4 * 1536;
  const float* cb = P.conv_b + (size_t)l * 1536;
  const int nstrips = 16384 / 32;
  for (int sp = blockIdx.x * 2; sp < nstrips; sp += gridDim.x * 2) {
    if (tid < 384) {
      const int part = tid % 192, strip = sp + tid / 192, ch0 = part * 8;
      const int lr0 = strip * 32;
      float w[4][8], bias[8];
      _Pragma("unroll") for (int i = 0; i < 4; ++i) { const f32x4 a = *reinterpret_cast<const f32x4*>(cw + i * 1536 + ch0), b = *reinterpret_cast<const f32x4*>(cw + i * 1536 + ch0 + 4);
        _Pragma("unroll") for (int j = 0; j < 4; ++j) { w[i][j] = a[j]; w[i][4 + j] = b[j]; } }
      { const f32x4 a = *reinterpret_cast<const f32x4*>(cb + ch0), b = *reinterpret_cast<const f32x4*>(cb + ch0 + 4);
        _Pragma("unroll") for (int j = 0; j < 4; ++j) { bias[j] = a[j]; bias[4 + j] = b[j]; } }
      bf16x8 h0, h1, h2;
      const u16* zp = Z + (size_t)lr0 * ZS + C_CX + ch0;
      if ((lr0 & 2047) == 0) { _Pragma("unroll") for (int j = 0; j < 8; ++j) { h0[j] = 0; h1[j] = 0; h2[j] = 0; } }
      else { h0 = ld8(zp - 3 * (size_t)ZS); h1 = ld8(zp - 2 * (size_t)ZS); h2 = ld8(zp - (size_t)ZS); }
      u16* xo = XBC + (size_t)lr0 * 1536 + ch0;
      _Pragma("unroll 1") for (int rb = 0; rb < 32; rb += 8) {
        bf16x8 cur[8];
        _Pragma("unroll") for (int k = 0; k < 8; ++k) cur[k] = ld8(zp + (size_t)(rb + k) * ZS);
        _Pragma("unroll") for (int k = 0; k < 8; ++k) {
          float a[8];
          _Pragma("unroll") for (int j = 0; j < 8; ++j) a[j] = siluf(bias[j] + w[0][j] * bfs(h0[j]) + w[1][j] * bfs(h1[j]) + w[2][j] * bfs(h2[j]) + w[3][j] * bfs(cur[k][j]));
          st8(xo + (size_t)(rb + k) * 1536, pack8(a));
          h0 = h1; h1 = h2; h2 = cur[k];
        }
      }
    } else {
      const int t = tid - 384;
      u16 zv[8];
      _Pragma("unroll") for (int k = 0; k < 8; ++k) { const int u = t + 128 * k; zv[k] = Z[(size_t)(sp * 32 + (u >> 4)) * ZS + C_DT + (u & 15)]; }
      const float dtb = P.dt_bias[l * 16 + (t & 15)];
      _Pragma("unroll") for (int k = 0; k < 8; ++k) { const int u = t + 128 * k; DT[(size_t)(sp * 32 + (u >> 4)) * 16 + (u & 15)] = softplusf(bf2f(zv[k]) + dtb); }
    }
  }
}

DI void mix_phase(const Params& P, int l, int hf) {
  const int NV = hf ? 16512 : 16384, NR = hf ? 16640 : 16384;
  const int tid = otid(); const int w = tid >> 6, lane = tid & 63;
  u16* H = (u16*)(optr(P.ws) + WS_H);
  const u16* Z = (const u16*)(optr(P.ws) + WS_Z);
  const u16* YC = (const u16*)(optr(P.ws) + WS_YC);
  const float* snw = P.snw + l * D;
  bf16x8 nob[2], ny[2], ncz[2], noa[2], nbg[2], nga[2], ngb[2], ngc[2];
#define MIX_LOAD(row) do { const u16* zr = Z + (size_t)(row) * ZS + lane * 8; const u16* yr = YC + (size_t)(row) * D + lane * 8; \
    _Pragma("unroll") for (int k = 0; k < 2; ++k) { \
      nob[k] = ld8(zr + C_BV + 512 * k); ny[k] = ld8(yr + 512 * k); ncz[k] = ld8(zr + C_CZ + 512 * k); noa[k] = ld8(zr + C_AQ + 512 * k); \
      nbg[k] = ld8(zr + C_BG + 512 * k); nga[k] = ld8(zr + C_GA + 512 * k); ngb[k] = ld8(zr + C_GB + 512 * k); ngc[k] = ld8(zr + C_GC + 512 * k); } } while (0)
  const int stride = gridDim.x * 8;
  f32x4 snv[2][2];
  _Pragma("unroll") for (int k = 0; k < 2; ++k) { snv[k][0] = *reinterpret_cast<const f32x4*>(snw + lane * 8 + 512 * k); snv[k][1] = *reinterpret_cast<const f32x4*>(snw + lane * 8 + 512 * k + 4); }
  int lr = blockIdx.x * 8 + w;
  if (lr < NV) MIX_LOAD(lr);
  float* SS1 = (float*)(optr(P.ws) + WS_SS1); float* SS2 = (float*)(optr(P.ws) + WS_SS2);
  _Pragma("unroll 1") for (; lr < NR; lr += stride) {
    u16* hrow = H + (size_t)lr * D + lane * 8;
    if (lane == 0) { SS1[lr] = 0.f; SS2[lr] = 0.f; }
    if (lr >= NV) { _Pragma("unroll") for (int k = 0; k < 2; ++k) { st4bf(hrow + 512 * k, 0.f, 0.f, 0.f, 0.f); st4bf(hrow + 512 * k + 4, 0.f, 0.f, 0.f, 0.f); } continue; }
    bf16x8 vob[2], vy[2], vcz[2], voa[2], vbg[2], vga[2], vgb[2], vgc[2];
    _Pragma("unroll") for (int k = 0; k < 2; ++k) { vob[k] = nob[k]; vy[k] = ny[k]; vcz[k] = ncz[k]; voa[k] = noa[k]; vbg[k] = nbg[k]; vga[k] = nga[k]; vgb[k] = ngb[k]; vgc[k] = ngc[k]; }
    if (lr + stride < NV) MIX_LOAD(lr + stride);
    _Pragma("unroll") for (int k = 0; k < 2; ++k) {
      float ob[8], yg[8], so = 0.f, sy = 0.f;
      _Pragma("unroll") for (int j = 0; j < 8; ++j) { float o = bfs(vob[k][j]); ob[j] = o; so += o * o; float t = bfs(vy[k][j]) * siluf(bfs(vcz[k][j])); yg[j] = t; sy += t * t; }
      so += __shfl_xor(so, 1); so += __shfl_xor(so, 2); so += __shfl_xor(so, 4); so += __shfl_xor(so, 8);
      for (int o = 32; o >= 1; o >>= 1) sy += __shfl_xor(sy, o);
      const float ro = rsqrtf(so * (1.f / 128.f) + EPS), ry = rsqrtf(sy * (1.f / 512.f) + EPS);
      float m[8];
      const f32x4 s0 = snv[k][0], s1 = snv[k][1];
      _Pragma("unroll") for (int j = 0; j < 8; ++j) {
        const float obn = ob[j] * ro * siluf(bfs(vbg[k][j]));
        const float ocn = yg[j] * ry * (j < 4 ? s0[j & 3] : s1[j & 3]);
        m[j] = sigmf(bfs(vga[k][j])) * bfs(voa[k][j]) + sigmf(bfs(vgb[k][j])) * obn + sigmf(bfs(vgc[k][j])) * ocn;
      }
      st8(hrow + 512 * k, pack8(m));
    }
  }
}

DI void att_prompt_item(char* shm, const Params& P, int l, int hf, int b, int blk, int kvh) {
  u16* Ks = (u16*)shm;
  u16* Vt = Ks + 256 * 72;
  float* bias = (float*)(Vt + 64 * 268);
  u16* Z = (u16*)(optr(P.ws) + WS_Z);
  const float* bt = (const float*)(optr(P.ws) + WS_BT);
  const int tid = otid(), lane = tid & 63, w = tid >> 6;
  const int lr0 = b * 2048 + blk * 128 - hf * HALF_ROWS;
  const int g = w >> 1, qh = kvh * 4 + g, r = lane & 31, h = lane >> 5;
  bf16x8 qall[2][4];
  _Pragma("unroll") for (int qq = 0; qq < 2; ++qq) { const u16* qp = Z + (size_t)(lr0 + ((w & 1) * 2 + qq) * 32 + r) * ZS + C_AQ + qh * 64;
    _Pragma("unroll") for (int s = 0; s < 4; ++s) qall[qq][s] = ld8(qp + 16 * s + 8 * h); }
  const float sink = P.sinks[l * 16 + qh];
  const float btv = bt[(tid & 127) * 16 + kvh * 4 + (tid >> 7)];
  __syncthreads();
  {
    bf16x8 kr[4], vr[4];
    _Pragma("unroll") for (int it = 0; it < 4; ++it) { const int c = tid + it * NT, key = c >> 3, part = c & 7;
      if (blk > 0 || key >= 128) { const u16* src = Z + (size_t)(lr0 - 128 + key) * ZS; kr[it] = ld8(src + C_AK + kvh * 64 + part * 8); vr[it] = ld8(src + C_AV + kvh * 64 + part * 8); }
      else { _Pragma("unroll") for (int j = 0; j < 8; ++j) { kr[it][j] = 0; vr[it][j] = 0; } } }
    _Pragma("unroll") for (int it = 0; it < 4; ++it) { const int c = tid + it * NT, key = c >> 3, part = c & 7;
      st8(Ks + key * 72 + part * 8, kr[it]);
      _Pragma("unroll") for (int jj = 0; jj < 8; ++jj) Vt[(part * 8 + jj) * 268 + key] = (u16)vr[it][jj]; }
  }
  { const int g3 = tid >> 7, dist = tid & 127; bias[g3 * 192 + 32 + dist] = btv * 1.4426950408889634f;
    if (tid < 256) { const int g2 = tid >> 6, k = tid & 63; bias[g2 * 192 + (k < 32 ? k : 128 + k)] = 0.f; } }
  __syncthreads();
  _Pragma("unroll") for (int qq = 0; qq < 2; ++qq) {
    const int qt = (w & 1) * 2 + qq, qi = qt * 32 + r;
    u16* qrow = Z + (size_t)(lr0 + qi) * ZS + C_AQ + qh * 64;
    bf16x8 qf[4];
    _Pragma("unroll") for (int s = 0; s < 4; ++s) qf[s] = qall[qq][s];
    f32x16 O0 = zero16(), O1 = zero16();
    float m = sink * 1.4426950408889634f, lsum = 1.f;
    const int kt0 = (blk == 0) ? 4 : qt;
    _Pragma("unroll 1") for (int kt = kt0; kt <= qt + 4; ++kt) {
      f32x16 S = zero16();
      _Pragma("unroll") for (int s = 0; s < 4; ++s) { const bf16x8 kf = ld8(Ks + (kt * 32 + r) * 72 + 16 * s + 8 * h); S = MFMA32(kf, qf[s], S); }
      const float* bp = bias + g * 192 + 32 + (qi - 32 * kt + 128 - 4 * h);
      float mloc = -INFINITY;
      _Pragma("unroll") for (int i = 0; i < 16; ++i) S[i] = fmaf(S[i], 0.125f * 1.4426950408889634f, bp[-((i & 3) + 8 * (i >> 2))]);
      if (kt == qt) { _Pragma("unroll") for (int i = 0; i < 16; ++i) S[i] = (crow(i, h) > r) ? S[i] : -INFINITY; }
      if (kt == qt + 4) { _Pragma("unroll") for (int i = 0; i < 16; ++i) S[i] = (crow(i, h) <= r) ? S[i] : -INFINITY; }
      _Pragma("unroll") for (int i = 0; i < 16; ++i) mloc = fmaxf(mloc, S[i]);
      mloc = fmaxf(mloc, __shfl_xor(mloc, 32));
      const float mnew = fmaxf(m, mloc), alpha = __builtin_amdgcn_exp2f(m - mnew);
      float ps = 0.f;
      _Pragma("unroll") for (int i = 0; i < 16; ++i) { const float p = __builtin_amdgcn_exp2f(S[i] - mnew); S[i] = p; ps += p; }
      ps += __shfl_xor(ps, 32);
      lsum = lsum * alpha + ps; m = mnew;
      _Pragma("unroll") for (int i = 0; i < 16; ++i) { O0[i] *= alpha; O1[i] *= alpha; }
      const bf16x8 p0 = packP<0>(S), p1 = packP<1>(S);
      { const u16* vp = Vt + (r) * 268 + kt * 32 + 4 * h;
        O0 = MFMA32(cat4(*(const s16x4*)vp, *(const s16x4*)(vp + 8)), p0, O0);
        O0 = MFMA32(cat4(*(const s16x4*)(vp + 16), *(const s16x4*)(vp + 24)), p1, O0); }
      { const u16* vp = Vt + (32 + r) * 268 + kt * 32 + 4 * h;
        O1 = MFMA32(cat4(*(const s16x4*)vp, *(const s16x4*)(vp + 8)), p0, O1);
        O1 = MFMA32(cat4(*(const s16x4*)(vp + 16), *(const s16x4*)(vp + 24)), p1, O1); }
    }
    const float inv = 1.f / lsum;
    _Pragma("unroll") for (int gq = 0; gq < 4; ++gq) {
      st4bf(qrow + 8 * gq + 4 * h, O0[4 * gq] * inv, O0[4 * gq + 1] * inv, O0[4 * gq + 2] * inv, O0[4 * gq + 3] * inv);
      st4bf(qrow + 32 + 8 * gq + 4 * h, O1[4 * gq] * inv, O1[4 * gq + 1] * inv, O1[4 * gq + 2] * inv, O1[4 * gq + 3] * inv);
    }
  }
  if (blk == 15) {
    float* wk = P.out + O_WKP + (size_t)(l * 16 + b) * 128 * 256 + kvh * 64;
    float* wv = P.out + O_WVP + (size_t)(l * 16 + b) * 128 * 256 + kvh * 64;
    for (int idx = tid; idx < 128 * 64; idx += NT) { const int j = idx >> 6, d = idx & 63; wk[j * 256 + d] = bf2f(Ks[(128 + j) * 72 + d]); wv[j * 256 + d] = bf2f(Vt[d * 268 + 128 + j]); }
  }
}

DI void ret_prompt_item(char* shm, const Params& P, int l, int hf, int b, int hd) {
  u16* QQ = (u16*)shm;
  u16* KK = QQ + 128 * 72;
  u16* KKt = KK + 128 * 72;
  u16* Vt = KKt + 64 * 136;
  u16* St = Vt + 128 * 136;
  float* th = (float*)(St + 128 * 72);
  u16* Z = (u16*)(optr(P.ws) + WS_Z);
  const int tid = otid(), lane = tid & 63, w = tid >> 6, r = lane & 31, hh = lane >> 5;
  const float log2g = log2f(1.f - exp2f(-5.f - (float)hd));
  const float g128 = exp2f(log2g * 128.f);
  __syncthreads();
  for (int e = tid; e < 128 * 72; e += NT) St[e] = 0;
  if (tid < 32) th[tid] = 1.f / powf(10000.f, (float)tid / 31.f);
  f32x16 Sacc = zero16();
  const int lt = w & 3, eh = w >> 2;
  bf16x8 qv[2], kv[2], vv[4];
#define RET_ISSUE(cc) do { const int _lr = b * 2048 + (cc) * 128 - hf * HALF_ROWS; \
    _Pragma("unroll") for (int it = 0; it < 2; ++it) { const int idx = tid + it * NT, row = idx & 127, part = idx >> 7; \
      const u16* zr = Z + (size_t)(_lr + row) * ZS; qv[it] = ld8(zr + C_BQ + hd * 64 + part * 8); kv[it] = ld8(zr + C_BK + hd * 64 + part * 8); } \
    _Pragma("unroll") for (int it = 0; it < 4; ++it) { const int idx = tid + it * NT, row = idx & 127, part = idx >> 7; \
      vv[it] = ld8(Z + (size_t)(_lr + row) * ZS + C_BV + hd * 128 + part * 8); } } while (0)
  RET_ISSUE(0);
  _Pragma("unroll 1") for (int c = 0; c < 16; ++c) {
    const int tok0 = c * 128;
    const int lrow0 = b * 2048 + tok0 - hf * HALF_ROWS;
    __syncthreads();
    {
      _Pragma("unroll") for (int it = 0; it < 2; ++it) {
        const int idx = tid + it * NT, row = idx & 127, part = idx >> 7;
        const float pos = (float)(tok0 + row);
        const float gq = exp2f(log2g * (float)(row + 1)), gk = 0.125f * exp2f(-log2g * (float)(row + 1));
        float qo[8], ko[8];
        _Pragma("unroll") for (int pr = 0; pr < 4; ++pr) {
          float sn, cs; sincos_rev(pos * th[part * 4 + pr], sn, cs);
          const float q1 = bfs(qv[it][2 * pr]), q2 = bfs(qv[it][2 * pr + 1]), k1 = bfs(kv[it][2 * pr]), k2 = bfs(kv[it][2 * pr + 1]);
          qo[2 * pr] = (q1 * cs - q2 * sn) * gq; qo[2 * pr + 1] = (q1 * sn + q2 * cs) * gq;
          ko[2 * pr] = (k1 * cs - k2 * sn) * gk; ko[2 * pr + 1] = (k1 * sn + k2 * cs) * gk;
        }
        st8(QQ + row * 72 + part * 8, pack8(qo));
        st8(KK + row * 72 + part * 8, pack8(ko));
        _Pragma("unroll") for (int jj = 0; jj < 8; ++jj) KKt[(part * 8 + jj) * 136 + row] = f2bf(ko[jj]);
      }
      _Pragma("unroll") for (int it = 0; it < 4; ++it) { const int idx = tid + it * NT, row = idx & 127, part = idx >> 7;
        _Pragma("unroll") for (int jj = 0; jj < 8; ++jj) Vt[(part * 8 + jj) * 136 + row] = (u16)vv[it][jj]; }
    }
    if (c + 1 < 16) RET_ISSUE(c + 1);
    __syncthreads();
    bf16x8 qf[4];
    _Pragma("unroll") for (int s = 0; s < 4; ++s) qf[s] = ld8(QQ + (lt * 32 + r) * 72 + 16 * s + 8 * hh);
    f32x16 O0 = zero16(), O1 = zero16();
    _Pragma("unroll") for (int s = 0; s < 4; ++s) {
      O0 = MFMA32(ld8(St + ((2 * eh) * 32 + r) * 72 + 16 * s + 8 * hh), qf[s], O0);
      O1 = MFMA32(ld8(St + ((2 * eh + 1) * 32 + r) * 72 + 16 * s + 8 * hh), qf[s], O1);
    }
    _Pragma("unroll 1") for (int mk = 0; mk <= lt; ++mk) {
      f32x16 Aa = zero16();
      _Pragma("unroll") for (int s = 0; s < 4; ++s) Aa = MFMA32(ld8(KK + (mk * 32 + r) * 72 + 16 * s + 8 * hh), qf[s], Aa);
      if (mk == lt) _Pragma("unroll") for (int i = 0; i < 16; ++i) if (crow(i, hh) > r) Aa[i] = 0.f;
      const bf16x8 p0 = packP<0>(Aa), p1 = packP<1>(Aa);
      { const u16* vp = Vt + ((2 * eh) * 32 + r) * 136 + mk * 32 + 4 * hh;
        O0 = MFMA32(cat4(*(const s16x4*)vp, *(const s16x4*)(vp + 8)), p0, O0);
        O0 = MFMA32(cat4(*(const s16x4*)(vp + 16), *(const s16x4*)(vp + 24)), p1, O0); }
      { const u16* vp = Vt + ((2 * eh + 1) * 32 + r) * 136 + mk * 32 + 4 * hh;
        O1 = MFMA32(cat4(*(const s16x4*)vp, *(const s16x4*)(vp + 8)), p0, O1);
        O1 = MFMA32(cat4(*(const s16x4*)(vp + 16), *(const s16x4*)(vp + 24)), p1, O1); }
    }
    { u16* orow = Z + (size_t)(lrow0 + lt * 32 + r) * ZS + C_BV + hd * 128 + (2 * eh) * 32;
      _Pragma("unroll") for (int gq = 0; gq < 4; ++gq) {
        st4bf(orow + 8 * gq + 4 * hh, O0[4 * gq], O0[4 * gq + 1], O0[4 * gq + 2], O0[4 * gq + 3]);
        st4bf(orow + 32 + 8 * gq + 4 * hh, O1[4 * gq], O1[4 * gq + 1], O1[4 * gq + 2], O1[4 * gq + 3]);
      } }
    _Pragma("unroll") for (int s = 0; s < 8; ++s)
      Sacc = MFMA32(ld8(Vt + (lt * 32 + r) * 136 + 16 * s + 8 * hh), ld8(KKt + (eh * 32 + r) * 136 + 16 * s + 8 * hh), Sacc);
    _Pragma("unroll") for (int i = 0; i < 16; ++i) Sacc[i] *= g128;
    __syncthreads();
    _Pragma("unroll") for (int i = 0; i < 16; ++i) St[(lt * 32 + crow(i, hh)) * 72 + eh * 32 + r] = f2bf(Sacc[i]);
  }
  float* so = P.out + O_RETP + (size_t)((l * 16 + b) * 8 + hd) * 8192 + (size_t)(eh * 32 + r) * 128 + lt * 32;
  _Pragma("unroll") for (int gq = 0; gq < 4; ++gq) *reinterpret_cast<f32x4*>(so + 8 * gq + 4 * hh) = (f32x4){Sacc[4 * gq], Sacc[4 * gq + 1], Sacc[4 * gq + 2], Sacc[4 * gq + 3]};
}

DI void ssd_prompt_item(char* shm, const Params& P, int l, int hf, int b, int hc) {
  u16* Bm = (u16*)shm;
  u16* Cm = Bm + 128 * 136;
  u16* Xs = Cm + 128 * 136;
  u16* XwT = Xs + 64 * 136;
  u16* Hs = XwT + 64 * 136;
  float* acum = (float*)(Hs + 64 * 136);
  float* dtv = acum + 128;
  float* tot = dtv + 128;
  const u16* Z = (const u16*)(optr(P.ws) + WS_Z);
  u16* YC = (u16*)(optr(P.ws) + WS_YC);
  const u16* XBC = (const u16*)(optr(P.ws) + WS_XBC);
  const float* DT = (const float*)(optr(P.ws) + WS_DT);
  const int tid = otid(), lane = tid & 63, w = tid >> 6, r = lane & 31, hh = lane >> 5;
  const int g = hc >> 3;
  const float Aneg = -expf(P.A_log[l * 16 + hc]), dtb = P.dt_bias[l * 16 + hc], dsk = P.D_skip[l * 16 + hc];
  const float* cw = P.conv_w + (size_t)l * 4 * 1536;
  const float* cb = P.conv_b + (size_t)l * 1536;
  const int lrowb = b * 2048 - hf * HALF_ROWS;
  __syncthreads();
  for (int e = tid; e < 64 * 136; e += NT) Hs[e] = 0;
  f32x16 Hacc = zero16();
  const int pt = w >> 2, it = w & 3;
  bf16x8 pB[4], pC[4], pX[2]; float pdt = 0.f;
#define SSD_ISSUE(cc) do { const int _t0 = (cc) * 128; \
    _Pragma("unroll") for (int itr = 0; itr < 4; ++itr) { const int idx = tid + itr * NT, row = idx >> 4, part = idx & 15; \
      const u16* _p = XBC + (size_t)(lrowb + _t0 + row) * 1536 + g * 128 + part * 8; pB[itr] = ld8(_p + 1024); pC[itr] = ld8(_p + 1280); } \
    _Pragma("unroll") for (int itr = 0; itr < 2; ++itr) { const int idx = tid + itr * NT, row = idx & 127, part = idx >> 7; \
      pX[itr] = ld8(XBC + (size_t)(lrowb + _t0 + row) * 1536 + hc * 64 + part * 8); } \
    if (tid < 128) pdt = DT[(size_t)(lrowb + _t0 + tid) * 16 + hc]; } while (0)
  SSD_ISSUE(0);
  _Pragma("unroll 1") for (int c = 0; c < 16; ++c) {
    const int tok0 = c * 128;
    bf16x8 xr[2]; xr[0] = pX[0]; xr[1] = pX[1];
    if (tid < 128) {
      const float dt = pdt;
      float v = dt * Aneg;
      for (int o = 1; o < 64; o <<= 1) { const float t = __shfl_up(v, o); if (lane >= o) v += t; }
      dtv[tid] = dt; acum[tid] = v;
      if (tid == 63) tot[0] = v;
    }
    _Pragma("unroll") for (int itr = 0; itr < 4; ++itr) { const int idx = tid + itr * NT, row = idx >> 4, part = idx & 15;
      st8(Bm + row * 136 + part * 8, pB[itr]); st8(Cm + row * 136 + part * 8, pC[itr]); }
    __syncthreads();
    if (tid >= 64 && tid < 128) acum[tid] += tot[0];
    __syncthreads();
    const float alast = acum[127];
    _Pragma("unroll") for (int itr = 0; itr < 2; ++itr) {
      const int idx = tid + itr * NT, row = idx & 127, part = idx >> 7;
      const float wj = __expf(alast - acum[row]) * dtv[row];
      _Pragma("unroll") for (int j = 0; j < 8; ++j) { const float xs = bfs(xr[itr][j]); Xs[(part * 8 + j) * 136 + row] = (u16)xr[itr][j]; XwT[(part * 8 + j) * 136 + row] = f2bf(xs * wj); }
    }
    if (c + 1 < 16) SSD_ISSUE(c + 1);
    __syncthreads();
    const u16* cfp = Cm + (it * 32 + r) * 136 + 8 * hh;
    f32x16 Y = zero16();
    _Pragma("unroll") for (int s = 0; s < 8; ++s) Y = MFMA32(ld8(Hs + (pt * 32 + r) * 136 + 16 * s + 8 * hh), ld8(cfp + 16 * s), Y);
    const float ai = acum[it * 32 + r];
    { const float ea = __expf(ai); _Pragma("unroll") for (int i = 0; i < 16; ++i) Y[i] *= ea; }
    _Pragma("unroll 1") for (int jt = 0; jt <= it; ++jt) {
      f32x16 Gm = zero16();
      _Pragma("unroll") for (int s = 0; s < 8; ++s) Gm = MFMA32(ld8(Bm + (jt * 32 + r) * 136 + 16 * s + 8 * hh), ld8(cfp + 16 * s), Gm);
      _Pragma("unroll") for (int i = 0; i < 16; ++i) {
        const int jl = crow(i, hh), j = jt * 32 + jl;
        const float v = Gm[i] * __expf(ai - acum[j]) * dtv[j];
        Gm[i] = (jt == it && jl > r) ? 0.f : v;
      }
      const bf16x8 p0 = packP<0>(Gm), p1 = packP<1>(Gm);
      const u16* xp = Xs + (pt * 32 + r) * 136 + jt * 32 + 4 * hh;
      Y = MFMA32(cat4(*(const s16x4*)xp, *(const s16x4*)(xp + 8)), p0, Y);
      Y = MFMA32(cat4(*(const s16x4*)(xp + 16), *(const s16x4*)(xp + 24)), p1, Y);
    }
    _Pragma("unroll") for (int i = 0; i < 16; ++i) Y[i] += dsk * bf2f(Xs[(pt * 32 + crow(i, hh)) * 136 + it * 32 + r]);
    { u16* yrow = YC + (size_t)(lrowb + tok0 + it * 32 + r) * D + hc * 64 + pt * 32;
      _Pragma("unroll") for (int gq = 0; gq < 4; ++gq) st4bf(yrow + 8 * gq + 4 * hh, Y[4 * gq], Y[4 * gq + 1], Y[4 * gq + 2], Y[4 * gq + 3]); }
    { const float dl = __expf(alast); _Pragma("unroll") for (int i = 0; i < 16; ++i) Hacc[i] *= dl; }
    _Pragma("unroll") for (int s = 0; s < 8; ++s) {
      const bf16x8 xf = ld8(XwT + (pt * 32 + r) * 136 + 16 * s + 8 * hh);
      const u16* bp = Bm + (16 * s + 8 * hh) * 136 + it * 32 + r;
      u32x4 pb;
      _Pragma("unroll") for (int q = 0; q < 4; ++q) pb[q] = (unsigned)bp[(2 * q) * 136] | ((unsigned)bp[(2 * q + 1) * 136] << 16);
      Hacc = MFMA32(xf, __builtin_bit_cast(bf16x8, pb), Hacc);
    }
    __syncthreads();
    _Pragma("unroll") for (int i = 0; i < 16; ++i) Hs[(pt * 32 + crow(i, hh)) * 136 + it * 32 + r] = f2bf(Hacc[i]);
  }
  { float* ho = P.out + O_SSMP + (size_t)((l * 16 + b) * 16 + hc) * 8192;
    _Pragma("unroll") for (int i = 0; i < 16; ++i) ho[(pt * 32 + crow(i, hh)) * 128 + it * 32 + r] = Hacc[i]; }
  { float* co = P.out + O_CONVP + (size_t)(l * 16 + b) * 3 * 1536;
    for (int e = tid; e < 3 * 64; e += NT) { const int i = e >> 6, ch = hc * 64 + (e & 63); co[i * 1536 + ch] = bf2f(Z[(size_t)(lrowb + 2045 + i) * ZS + C_CX + ch]); }
    if ((hc & 7) == 0) for (int e = tid; e < 3 * 256; e += NT) { const int i = e >> 8, q = e & 255; const int ch = (q < 128 ? 1024 : 1280 - 128) + g * 128 + q; co[i * 1536 + ch] = bf2f(Z[(size_t)(lrowb + 2045 + i) * ZS + C_CX + ch]); } }
}

DI void ssd_sample_item(char* shm, const Params& P, int l, int s, int g) {
  float* xs = (float*)shm;
  float* Bs = xs + 512;
  float* Cs = Bs + 128;
  float* dts = Cs + 128;
  const int tid = otid(), lane = tid & 63, w = tid >> 6;
  const int lr = MPROMPT + s - HALF_ROWS;
  const u16* zr = (const u16*)(optr(P.ws) + WS_Z) + (size_t)lr * ZS;
  u16* YC = (u16*)(optr(P.ws) + WS_YC) + (size_t)lr * D;
  const float* cw = P.conv_w + (size_t)l * 4 * 1536;
  const float* cb = P.conv_b + (size_t)l * 1536;
  const float* hist = P.state_conv + (size_t)(l * 128 + s) * 3 * 1536;
  float* cso = P.out + O_CONVS + (size_t)(l * 128 + s) * 3 * 1536;
  __syncthreads();
  for (int u = tid; u < 768; u += NT) {
    int ch; float* dst;
    if (u < 512) { ch = g * 512 + u; dst = xs + u; } else if (u < 640) { ch = 1024 + g * 128 + (u - 512); dst = Bs + (u - 512); } else { ch = 1280 + g * 128 + (u - 640); dst = Cs + (u - 640); }
    const float h0 = hist[ch], h1 = hist[1536 + ch], h2 = hist[2 * 1536 + ch], nw = bf2f(zr[C_CX + ch]);
    const float a = cb[ch] + cw[ch] * h0 + cw[1536 + ch] * h1 + cw[2 * 1536 + ch] * h2 + cw[3 * 1536 + ch] * nw;
    *dst = siluf(a);
    cso[ch] = h1; cso[1536 + ch] = h2; cso[2 * 1536 + ch] = nw;
  }
  if (tid < 8) { const int hc = g * 8 + tid; const float dt = softplusf(bf2f(zr[C_DT + hc]) + P.dt_bias[l * 16 + hc]); dts[tid] = dt; dts[8 + tid] = expf(dt * -expf(P.A_log[l * 16 + hc])); }
  __syncthreads();
  const int hc = g * 8 + w;
  const float dt = dts[w], dA = dts[8 + w], dsk = P.D_skip[l * 16 + hc];
  const float* hin = P.state_ssm + (size_t)((l * 128 + s) * 16 + hc) * 8192;
  float* hout = P.out + O_SSMS + (size_t)((l * 128 + s) * 16 + hc) * 8192;
  const int n4 = (lane & 31) * 4, psub = lane >> 5;
  const f32x4 Bv = *reinterpret_cast<const f32x4*>(Bs + n4), Cv = *reinterpret_cast<const f32x4*>(Cs + n4);
  {
    const int ib = 0;
    f32x4 hv[32];
    _Pragma("unroll") for (int k = 0; k < 32; ++k) hv[k] = __builtin_nontemporal_load(reinterpret_cast<const f32x4*>(hin + (k * 2 + psub) * 128 + n4));
    _Pragma("unroll") for (int k = 0; k < 32; ++k) {
      const int p = (ib * 16 + k) * 2 + psub;
      const float xv = xs[w * 64 + p];
      const f32x4 hn = hv[k] * dA + Bv * (dt * xv);
      __builtin_nontemporal_store(hn, reinterpret_cast<f32x4*>(hout + p * 128 + n4));
      float y = hn[0] * Cv[0] + hn[1] * Cv[1] + hn[2] * Cv[2] + hn[3] * Cv[3];
      for (int o = 16; o >= 1; o >>= 1) y += __shfl_xor(y, o);
      if ((lane & 31) == 0) YC[hc * 64 + p] = f2bf(y + dsk * xv);
    }
  }
}

DI void ret_sample_item(char* shm, const Params& P, int l, int s) {
  float* qk = (float*)shm;
  const int tid = otid(), lane = tid & 63, w = tid >> 6;
  const int lr = MPROMPT + s - HALF_ROWS;
  u16* zr = (u16*)(optr(P.ws) + WS_Z) + (size_t)lr * ZS;
  __syncthreads();
  const float gamma = 1.f - exp2f(-5.f - (float)w);
  if (lane < 32) {
    const float th = 1.f / powf(10000.f, (float)lane / 31.f);
    float sn, cs; sincos_rev(16384.f * th, sn, cs);
    const float q1 = bf2f(zr[C_BQ + w * 64 + 2 * lane]), q2 = bf2f(zr[C_BQ + w * 64 + 2 * lane + 1]);
    const float k1 = bf2f(zr[C_BK + w * 64 + 2 * lane]) * 0.125f, k2 = bf2f(zr[C_BK + w * 64 + 2 * lane + 1]) * 0.125f;
    qk[w * 128 + 2 * lane] = q1 * cs - q2 * sn; qk[w * 128 + 2 * lane + 1] = q1 * sn + q2 * cs;
    qk[w * 128 + 64 + 2 * lane] = k1 * cs - k2 * sn; qk[w * 128 + 64 + 2 * lane + 1] = k1 * sn + k2 * cs;
  }
  const int e4 = (lane & 31) * 4, dsub = lane >> 5;
  f32x4 v4;
  _Pragma("unroll") for (int j = 0; j < 4; ++j) v4[j] = bf2f(zr[C_BV + w * 128 + e4 + j]);
  __syncthreads();
  const float* Sin = P.state_ret + (size_t)((l * 128 + s) * 8 + w) * 8192;
  float* Sout = P.out + O_RETS + (size_t)((l * 128 + s) * 8 + w) * 8192;
  f32x4 o4 = (f32x4){0.f, 0.f, 0.f, 0.f};
  {
    const int ib = 0;
    f32x4 sv[32];
    _Pragma("unroll") for (int k = 0; k < 32; ++k) sv[k] = __builtin_nontemporal_load(reinterpret_cast<const f32x4*>(Sin + (k * 2 + dsub) * 128 + e4));
    _Pragma("unroll") for (int k = 0; k < 32; ++k) {
      const int d = (ib * 16 + k) * 2 + dsub;
      const f32x4 sn = sv[k] * gamma + v4 * qk[w * 128 + 64 + d];
      __builtin_nontemporal_store(sn, reinterpret_cast<f32x4*>(Sout + d * 128 + e4));
      o4 += sn * qk[w * 128 + d];
    }
  }
  _Pragma("unroll") for (int j = 0; j < 4; ++j) o4[j] += __shfl_xor(o4[j], 32);
  if (dsub == 0) st4bf(zr + C_BV + w * 128 + e4, o4[0], o4[1], o4[2], o4[3]);
}

DI void att_sample_item(char* shm, const Params& P, int l, int s) {
  float* Kc = (float*)shm;
  float* Vc = Kc + 129 * 65;
  float* qv = Vc + 129 * 65;
  float* sc = qv + 256;
  float* red = sc + 512;
  const int tid = otid(), lane = tid & 63, w = tid >> 6;
  const int lr = MPROMPT + s - HALF_ROWS;
  u16* zr = (u16*)(optr(P.ws) + WS_Z) + (size_t)lr * ZS;
  const float* bt = (const float*)(optr(P.ws) + WS_BT);
  const float* ck = P.cache_k + (size_t)(l * 128 + s) * 128 * 256;
  const float* cv = P.cache_v + (size_t)(l * 128 + s) * 128 * 256;
  float* ok = P.out + O_WKS + (size_t)(l * 128 + s) * 128 * 256;
  float* ov = P.out + O_WVS + (size_t)(l * 128 + s) * 128 * 256;
  _Pragma("unroll 1") for (int kvh = 0; kvh < 4; ++kvh) {
    __syncthreads();
    {
      const int d4 = (tid & 15) * 4;
      f32x4 kk[4], vv[4];
      _Pragma("unroll") for (int itr = 0; itr < 4; ++itr) { const int j = (tid >> 4) + 32 * itr;
        kk[itr] = __builtin_nontemporal_load(reinterpret_cast<const f32x4*>(ck + j * 256 + kvh * 64 + d4)); vv[itr] = __builtin_nontemporal_load(reinterpret_cast<const f32x4*>(cv + j * 256 + kvh * 64 + d4)); }
      _Pragma("unroll") for (int itr = 0; itr < 4; ++itr) { const int j = (tid >> 4) + 32 * itr;
        _Pragma("unroll") for (int q = 0; q < 4; ++q) { Kc[j * 65 + d4 + q] = kk[itr][q]; Vc[j * 65 + d4 + q] = vv[itr][q]; }
        if (j >= 1) { __builtin_nontemporal_store(kk[itr], reinterpret_cast<f32x4*>(ok + (j - 1) * 256 + kvh * 64 + d4)); __builtin_nontemporal_store(vv[itr], reinterpret_cast<f32x4*>(ov + (j - 1) * 256 + kvh * 64 + d4)); } }
    }
    if (tid < 64) { const float kn = bf2f(zr[C_AK + kvh * 64 + tid]), vn = bf2f(zr[C_AV + kvh * 64 + tid]); Kc[128 * 65 + tid] = kn; Vc[128 * 65 + tid] = vn; ok[127 * 256 + kvh * 64 + tid] = kn; ov[127 * 256 + kvh * 64 + tid] = vn; }
    if (tid < 256) qv[tid] = bf2f(zr[C_AQ + kvh * 256 + tid]);
    __syncthreads();
    const int g = tid >> 7, c = 1 + (tid & 127), qh = kvh * 4 + g;
    float dot = 0.f;
    _Pragma("unroll 1") for (int d = 0; d < 64; ++d) dot += qv[g * 64 + d] * Kc[c * 65 + d];
    const float score = dot * 0.125f + bt[(128 - c) * 16 + qh];
    float mx = score;
    for (int o = 32; o >= 1; o >>= 1) mx = fmaxf(mx, __shfl_xor(mx, o));
    if (lane == 0) red[w] = mx;
    __syncthreads();
    const float sink = P.sinks[l * 16 + qh];
    const float m = fmaxf(fmaxf(red[2 * g], red[2 * g + 1]), sink);
    const float e = __expf(score - m);
    float sm = e;
    for (int o = 32; o >= 1; o >>= 1) sm += __shfl_xor(sm, o);
    if (lane == 0) red[8 + w] = sm;
    __syncthreads();
    const float den = red[8 + 2 * g] + red[8 + 2 * g + 1] + __expf(sink - m);
    sc[g * 128 + (c - 1)] = e / den;
    __syncthreads();
    if (tid < 256) {
      const int g2 = tid >> 6, d = tid & 63; float o = 0.f;
      for (int cc = 1; cc <= 128; ++cc) o += sc[g2 * 128 + cc - 1] * Vc[cc * 65 + d];
      zr[C_AQ + (kvh * 4 + g2) * 64 + d] = f2bf(o);
    }
  }
}

DI void mixer_phase(char* shm, const Params& P, int l, int hf, int ph) {
  __shared__ int s_item;
  unsigned* ctr = (unsigned*)(optr(P.ws) + WS_CTR) + ph;
  const int nitems = 128 + 64 + 512 + (hf ? 512 : 0);
  __syncthreads();
  if (threadIdx.x == 0) s_item = (int)atomicAdd(ctr, 1u);
  __syncthreads();
  int it0 = s_item;
  while (it0 < nitems) {
    const bool small = it0 >= 192;
    int nxt = 0;
    if (small && threadIdx.x == 0) nxt = (int)atomicAdd(ctr, 1u);
    int it = it0;
    if (it < 128) { ssd_prompt_item(shm, P, l, hf, hf * 8 + (it >> 4), it & 15); }
    else if ((it -= 128) < 64) { ret_prompt_item(shm, P, l, hf, hf * 8 + (it >> 3), it & 7); }
    else if ((it -= 64) < 512) { att_prompt_item(shm, P, l, hf, hf * 8 + (it >> 6), (it >> 2) & 15, it & 3); }
    else if ((it -= 512) < 256) { ssd_sample_item(shm, P, l, it >> 1, it & 1); }
    else if ((it -= 256) < 128) { ret_sample_item(shm, P, l, it); }
    else { it -= 128; att_sample_item(shm, P, l, it); }
    __syncthreads();
    if (threadIdx.x == 0) s_item = small ? nxt : (int)atomicAdd(ctr, 1u);
    __syncthreads();
    it0 = s_item;
  }
}

#define SEQ0 0x87543210ull
#define LEN0 8
#define SEQ1 0x8754321ull
#define LEN1 7
constexpr int PH_G0 = 3;
constexpr int N_PHASES = PH_G0 + 2 * (LEN0 + LEN1) + 1;
#ifndef MAXPH
#define MAXPH N_PHASES
#endif
__global__ void __launch_bounds__(NT) fwd_kernel(Params P) {
  extern __shared__ __attribute__((aligned(16))) unsigned char lds[];
  char* shm = (char*)lds;
  cg::grid_group grid = cg::this_grid();
  unsigned char* ws = P.ws;
  const float* mod = (const float*)(ws + WS_MOD);
  for (int ph = P.ph_lo; ph < P.ph_hi; ++ph) {
    if (ph > P.ph_lo) grid.sync();
    if (ph == 0) { prep_phase(shm, P); continue; }
    if (ph == N_PHASES - 1) { final_norm_phase(P); continue; }
    const int q = (ph < PH_G0) ? 0 : ph - PH_G0, hf = q / (LEN0 + LEN1), qq = q % (LEN0 + LEN1), l = (qq >= LEN0) ? 1 : 0;
    const int sub = (ph == 1) ? 9 : (ph == 2) ? 10 : l ? (int)((SEQ1 >> (4 * (qq - LEN0))) & 15ull) : (int)((SEQ0 >> (4 * qq)) & 15ull);
    const int ntm = hf ? 65 : 64, RB = hf * HALF_ROWS, NV = hf ? 16512 : 16384;
    if (sub == 0) { norm_phase(P, l, hf, 0, l == 0); continue; }
    if (sub == 2) { conv_phase(P, l, hf); continue; }
    if (sub == 3) { mixer_phase(shm, P, l, hf, ph); continue; }
    if (sub == 4) { mix_phase(P, l, hf); continue; }
    Epi E{};
    const int Gd = gridDim.x;
    const int bxr = (Gd % 8 == 0) ? (int)((blockIdx.x % 8) * (Gd / 8) + blockIdx.x / 8) : (int)blockIdx.x;
    const int cw = (bxr < 41) ? 0 : (bxr < 57) ? 1 : 2;
    const bool first_res = (sub == 5 && l == 0);
    E.kind = (sub == 9) ? 3 : (sub == 10) ? 6 : (sub == 1) ? 0 : (sub == 7) ? 1 : 2;
    E.c16 = (u16*)(ws + WS_Z); E.ldc = (sub == 1) ? ZS : (sub == 10) ? (cw == 0 ? ZS : DFF) : DFF;
    E.rb = RB; E.nv = NV; E.xout = P.out; E.mod = mod; E.goff = l * 6144 + ((sub == 5) ? 2048 : 5120);
    E.res_p = first_res ? P.x_prompt : (const float*)P.out;
    E.res_s = first_res ? P.x_sample : (const float*)(P.out + (size_t)MPROMPT * D);
    E.modout = (float*)(ws + WS_MOD); E.ada_b = P.ada_b; E.shb = (u16*)(ws + WS_SHB);
    E.cout = (float*)(ws + ((cw == 0) ? WS_C1 : WS_C2 + (size_t)(cw - 1) * 144 * DFF * 4));
    E.fuse = (sub == 5 || (sub == 8 && l == 0)) ? 1 : 0;
    E.fw = (sub == 5) ? P.n2 + l * D : P.n1 + D;
    E.fsc = (sub == 5) ? l * 6144 + 4096 : 6144 + 1024;
    E.fa = (u16*)(ws + ((sub == 5) ? WS_XBC : WS_H));
    E.fss = (float*)(ws + ((sub == 5) ? WS_SS2 : WS_SS1));
    E.cons = (sub == 7 || (sub == 1 && l == 1)) ? 1 : 0;
    E.css = (const float*)(ws + ((sub == 7) ? WS_SS2 : WS_SS1));
    E.cc = (const float*)(ws + ((sub == 7) ? WS_C2 + (size_t)l * 144 * DFF * 4 : WS_C1));
    E.ccld = (sub == 7) ? DFF : ZS;
    const bf16* A = (const bf16*)(ws + ((sub == 9) ? WS_SC : (sub == 10) ? WS_SHB + (size_t)cw * 256 * D * 2 : (sub == 8) ? WS_Z : (sub == 7) ? WS_XBC : WS_H));
    const size_t boff = (sub == 9) ? WS_AWT : (sub == 10) ? (cw == 0 ? WS_WIN + (size_t)ZS * D * 2 : WS_WUP + (size_t)(cw - 1) * DFF * D * 2)
                      : (sub == 1) ? WS_WIN + (size_t)l * ZS * D * 2 : (sub == 5) ? WS_WOUT + (size_t)l * D * D * 2
                      : (sub == 7) ? WS_WUP + (size_t)l * DFF * D * 2 : WS_WDN + (size_t)l * D * DFF * 2;
    const bf16* Bt = (const bf16*)(ws + boff);
    const int K = (sub == 8) ? DFF : D;
    const int tm = (sub == 9 || sub == 10) ? 1 : ntm;
    const int tn = (sub == 9) ? 48 : (sub == 10) ? (cw == 0 ? 41 : 16) : (sub == 1) ? 41 : (sub == 7) ? 16 : 4;
    const int toff = (sub == 10) ? (cw == 0 ? 0 : cw == 1 ? 41 : 57) : 0;
    asm volatile("" : "+s"(E.xout), "+s"(E.res_p), "+s"(E.res_s), "+s"(E.mod), "+s"(A), "+s"(Bt), "+s"(E.fa), "+s"(E.fss), "+s"(E.css), "+s"(E.cc), "+s"(E.cout));
    gemm_phase(shm, A, Bt, K, tm, tn, E, (hf == 1 && sub == 8 && l == 1) ? 1 : 0, toff);
  }
}

extern "C" void kernel_launch(void* const* d_in, const int* in_sizes, int n_in, void* d_out, int out_size, void* d_ws, size_t ws_size, hipStream_t stream) {
  static int grid = 0;
  if (grid == 0) {
    if (n_in != 26 || ws_size < WS_END) { fprintf(stderr, "kernel_launch: bad inputs n_in=%d ws=%zu need %zu\n", n_in, ws_size, (size_t)WS_END); grid = -1; return; }
    int dev = 0, cus = 0, per_cu = 0;
    (void)hipGetDevice(&dev);
    (void)hipDeviceGetAttribute(&cus, hipDeviceAttributeMultiprocessorCount, dev);
    if (hipFuncSetAttribute((const void*)fwd_kernel, hipFuncAttributeMaxDynamicSharedMemorySize, LDS_BYTES) != hipSuccess) { fprintf(stderr, "hipFuncSetAttribute failed\n"); grid = -1; return; }
    (void)hipOccupancyMaxActiveBlocksPerMultiprocessor(&per_cu, (const void*)fwd_kernel, NT, LDS_BYTES);
    if (per_cu < 1) { fprintf(stderr, "occupancy query returned %d\n", per_cu); per_cu = 1; }
    (void)hipGetLastError();
    grid = cus * per_cu;
  }
  if (grid < 0) return;
  (void)hipMemsetAsync((char*)d_ws + WS_CTR, 0, 256, stream);
  Params p{};
  const float** pp = (const float**)&p;
  _Pragma("unroll") for (int i = 0; i < 26; ++i) pp[i] = (const float*)d_in[i];
  p.out = (float*)d_out; p.ws = (unsigned char*)d_ws;
#if FUSED
  p.ph_lo = 0; p.ph_hi = MAXPH;
  void* args[] = {&p};
  hipError_t e = hipLaunchCooperativeKernel((const void*)fwd_kernel, dim3(grid), dim3(NT), args, LDS_BYTES, stream);
  if (e != hipSuccess) fprintf(stderr, "cooperative launch failed: %s (grid %d)\n", hipGetErrorString(e), grid);
#else
  for (int ph = 0; ph < MAXPH; ++ph) {
    p.ph_lo = ph; p.ph_hi = ph + 1;
    hipLaunchKernelGGL(fwd_kernel, dim3(grid), dim3(NT), LDS_BYTES, stream, p);
  }
#endif
}
```

```cpp
#include <hip/hip_runtime.h>
#include <hip/hip_bf16.h>
#include <hip/hip_cooperative_groups.h>
#include <cstdio>
namespace cg = cooperative_groups;

#ifndef FUSED
#define FUSED 1
#endif

typedef unsigned short u16;
using bf16 = __hip_bfloat16;
using bf16x8 = __attribute__((ext_vector_type(8))) short;
using s16x4  = __attribute__((ext_vector_type(4))) short;
using f32x4  = __attribute__((ext_vector_type(4))) float;
using f32x16 = __attribute__((ext_vector_type(16))) float;
using u32x4  = __attribute__((ext_vector_type(4))) unsigned;
using u32x2  = __attribute__((ext_vector_type(2))) unsigned;
#define DI __device__ __forceinline__

constexpr int D = 1024, DIN = 10256, ZS = 10496, DFF = 4096;
constexpr int MPROMPT = 32768, MVALID = 32896;
constexpr int HALF_ROWS = 16384, ZROWS = 16640;
constexpr int C_AQ = 0, C_AK = 1024, C_AV = 1280, C_BQ = 1536, C_BK = 2048, C_BV = 2560, C_BG = 3584, C_CZ = 4608,
              C_CX = 5632, C_DT = 7168, C_GA = 7184, C_GB = 8208, C_GC = 9232;
constexpr int MODS = 12288;
constexpr float EPS = 1e-6f;
constexpr int NT = 512;

constexpr size_t O_YP = 0, O_YS = O_YP + 33554432, O_WKP = O_YS + 131072, O_WVP = O_WKP + 1048576, O_RETP = O_WVP + 1048576,
                 O_SSMP = O_RETP + 2097152, O_CONVP = O_SSMP + 4194304, O_WKS = O_CONVP + 147456, O_WVS = O_WKS + 8388608,
                 O_RETS = O_WVS + 8388608, O_SSMS = O_RETS + 16777216, O_CONVS = O_SSMS + 33554432;
constexpr size_t WS_CTR = 0, WS_BT = 256, WS_SC = 16384, WS_MOD = WS_SC + 524288, WS_AWT = WS_MOD + 7077888,
                 WS_WIN = WS_AWT + 25165824, WS_WOUT = WS_WIN + 42991616, WS_WUP = WS_WOUT + 4194304, WS_WDN = WS_WUP + 16777216,
                 WS_H = WS_WDN + 16777216, WS_YC = WS_H + 34078720, WS_Z = WS_YC + 34078720, WS_XBC = WS_Z + 349306880,
                 WS_DT = WS_XBC + 51118080, WS_SS1 = WS_DT + 1064960, WS_SS2 = WS_SS1 + 66560, WS_C1 = WS_SS2 + 66560,
                 WS_C2 = WS_C1 + 6045696, WS_SHB = WS_C2 + 4718592, WS_END = WS_SHB + 1572864;
constexpr int LDS_BYTES = 147456;

struct Params {
  const float *x_prompt, *x_sample, *cache_k, *cache_v, *state_ret, *state_ssm, *state_conv, *c_prompt, *c_sample, *rel, *sinks,
      *n1, *n2, *ada_w, *ada_b, *w_in, *conv_w, *conv_b, *dt_bias, *A_log, *D_skip, *snw, *w_out, *w_up, *w_down, *fnw;
  float* out; unsigned char* ws; int ph_lo, ph_hi;
};

typedef float f32x2v __attribute__((ext_vector_type(2)));
typedef __bf16 bf16x2v __attribute__((ext_vector_type(2)));
DI unsigned pack2(float a, float b) { f32x2v v = {a, b}; return __builtin_bit_cast(unsigned, __builtin_convertvector(v, bf16x2v)); }
DI u16 f2bf(float x) { return (u16)(pack2(x, 0.f) & 0xffffu); }
DI float bf2f(u16 h) { return __uint_as_float(((unsigned)h) << 16); }
DI float bfs(short h) { return __uint_as_float(((unsigned)(u16)h) << 16); }
DI bf16x8 ld8(const u16* p) { return *reinterpret_cast<const bf16x8*>(p); }
DI void st8(u16* p, bf16x8 v) { *reinterpret_cast<bf16x8*>(p) = v; }
DI bf16x8 cat4(s16x4 lo, s16x4 hi) { return __builtin_shufflevector(lo, hi, 0, 1, 2, 3, 4, 5, 6, 7); }
DI f32x16 zero16() { f32x16 v; _Pragma("unroll") for (int i = 0; i < 16; ++i) v[i] = 0.f; return v; }
DI int crow(int i, int h) { return (i & 3) + 8 * (i >> 2) + 4 * h; }
#define MFMA32(a, b, c) __builtin_amdgcn_mfma_f32_32x32x16_bf16((a), (b), (c), 0, 0, 0)
template <int S> DI bf16x8 packP(const f32x16& x) {
  u32x4 p; p[0] = pack2(x[8 * S], x[8 * S + 1]); p[1] = pack2(x[8 * S + 2], x[8 * S + 3]);
  p[2] = pack2(x[8 * S + 4], x[8 * S + 5]); p[3] = pack2(x[8 * S + 6], x[8 * S + 7]);
  return __builtin_bit_cast(bf16x8, p);
}
DI bf16x8 pack8(const float* v) {
  u32x4 p; p[0] = pack2(v[0], v[1]); p[1] = pack2(v[2], v[3]); p[2] = pack2(v[4], v[5]); p[3] = pack2(v[6], v[7]);
  return __builtin_bit_cast(bf16x8, p);
}
DI void st4bf(u16* p, float a, float b, float c, float d) { u32x2 v; v[0] = pack2(a, b); v[1] = pack2(c, d); *reinterpret_cast<u32x2*>(p) = v; }
DI float siluf(float x) { return x / (1.f + __expf(-x)); }
DI float sigmf(float x) { return 1.f / (1.f + __expf(-x)); }
DI float softplusf(float x) { return x > 20.f ? x : log1pf(expf(x)); }
DI int otid() { int t = threadIdx.x; asm volatile("" : "+v"(t)); return t; }
template <class T> DI T* optr(T* p) { asm volatile("" : "+s"(p)); return p; }
DI float shx(float v, int m, int lane) { return __int_as_float(__builtin_amdgcn_ds_bpermute((lane ^ m) << 2, __float_as_int(v))); }
DI float shup(float v, int o, int lane) { return __int_as_float(__builtin_amdgcn_ds_bpermute((lane - o) << 2, __float_as_int(v))); }
DI int modrow(int r) { return r < MPROMPT ? (r >> 11) : 16 + (r - MPROMPT); }
DI void sincos_rev(float ang, float& s, float& c) {
  float k = rintf(ang * 0.15915494309189535f);
  float red = fmaf(-k, 6.28318548202514648f, ang);
  red = fmaf(-k, -1.7484555e-7f, red);
  float fr = red * 0.15915494309189535f;
  s = __builtin_amdgcn_sinf(fr); c = __builtin_amdgcn_cosf(fr);
}

constexpr int BM = 256, BK = 64, HALFT = 128, HT = HALFT * BK;
DI int lds_byte(int r, int c) { int st = (r >> 4) * 2 + (c >> 5), rr = r & 15, cc = c & 31, ob = rr * 64 + cc * 2; return st * 1024 + (ob ^ (((ob >> 9) & 1) << 5)); }
DI void stage_rc(int b, int& R, int& C) { int st = b / 1024, sb = b % 1024, swz = sb ^ (((sb >> 9) & 1) << 5); R = (st >> 1) * 16 + swz / 64; C = (st & 1) * 32 + (swz % 64) / 2; }

struct Epi {
  int kind;
  u16* c16; int ldc;
  int rb, nv;
  const float* res_p; const float* res_s;
  float* xout;
  const float* mod; int goff;
  float* modout; const float* ada_b;
  u16* shb;
  float* cout;
  int fuse;
  const float* fw; int fsc; u16* fa; float* fss;
  int cons;
  const float* css; const float* cc; int ccld;
};

#define LAS __attribute__((address_space(3)))
constexpr int HTB = HALFT * BK * 2;
DI void epilogue(const f32x4 (&acc)[2][2][4][2], const Epi& E, int brow, int bcol, int wr, int wc, int fr, int fq, int at) {
  const int col0 = bcol + wc * 32 + fq * 8;
  const int row0 = brow + wr * 64 + fr;
  const int lane = (fq << 4) | fr;
  const bool ptile = (E.rb + brow + 255) < MPROMPT;
  const int pb = (E.rb + brow) >> 11;
#define ECOL(j) (col0 + ((j) >> 1) * HALFT + ((j) & 1) * 4)
#define EROW(g) (row0 + ((g) >> 2) * HALFT + ((g) & 3) * 16)
#define EACC(g, j) acc[(g) >> 2][(j) >> 1][(g) & 3][(j) & 1]
  if (E.kind <= 1) {
    float ssv[8]; f32x4 cv[4];
    if (E.cons) {
      _Pragma("unroll") for (int g = 0; g < 8; ++g) ssv[g] = E.css[EROW(g)];
      if (ptile) { _Pragma("unroll") for (int j = 0; j < 4; ++j) cv[j] = *reinterpret_cast<const f32x4*>(E.cc + (size_t)pb * E.ccld + ECOL(j)); }
    }
    _Pragma("unroll") for (int g = 0; g < 8; ++g) {
      const int row = EROW(g);
      float rsv = 1.f;
      if (E.cons) {
        rsv = rsqrtf(ssv[g] * (1.f / D) + EPS);
        if (!ptile) { const int mrc = min(modrow(E.rb + row), 143);
          _Pragma("unroll") for (int j = 0; j < 4; ++j) cv[j] = *reinterpret_cast<const f32x4*>(E.cc + (size_t)mrc * E.ccld + ECOL(j)); }
      }
      _Pragma("unroll") for (int jb = 0; jb < 2; ++jb) {
        float o[8];
        _Pragma("unroll") for (int n = 0; n < 2; ++n) {
          f32x4 v = EACC(g, 2 * jb + n);
          if (E.cons) v = v * rsv + cv[2 * jb + n];
          if (E.kind == 1) { _Pragma("unroll") for (int q = 0; q < 4; ++q) { const float a = fmaxf(v[q], 0.f); v[q] = a * a; } }
          _Pragma("unroll") for (int q = 0; q < 4; ++q) o[4 * n + q] = v[q];
        }
        st8(E.c16 + (size_t)row * E.ldc + ECOL(2 * jb), pack8(o));
      }
    }
  } else if (E.kind == 2) {
    if (at) {
      _Pragma("unroll") for (int g = 0; g < 8; ++g) {
        const int row = EROW(g);
        if (row < E.nv) {
          const int r = E.rb + row;
          _Pragma("unroll") for (int j = 0; j < 4; ++j) {
            const f32x4 gg = *reinterpret_cast<const f32x4*>(E.mod + (size_t)modrow(r) * MODS + E.goff + ECOL(j));
            const f32x4 v = EACC(g, j);
            float* xp = E.xout + (size_t)r * D + ECOL(j);
            _Pragma("unroll") for (int q = 0; q < 4; ++q) unsafeAtomicAdd(xp + q, gg[q] * v[q]);
          }
        }
      }
    } else {
      f32x4 g4[4], w4[4], s4[4], xc[4], xq[4];
      const float* mrow0 = E.mod + (size_t)pb * MODS;
      if (ptile) { _Pragma("unroll") for (int j = 0; j < 4; ++j) { g4[j] = *reinterpret_cast<const f32x4*>(mrow0 + E.goff + ECOL(j));
          if (E.fuse) s4[j] = *reinterpret_cast<const f32x4*>(mrow0 + E.fsc + ECOL(j)); } }
      if (E.fuse) { _Pragma("unroll") for (int j = 0; j < 4; ++j) w4[j] = *reinterpret_cast<const f32x4*>(E.fw + ECOL(j)); }
#define LOADX(g, dst) do { const int _row = EROW(g); const int _r = E.rb + _row; \
        const float* _rs = (_r < MPROMPT) ? (E.res_p + (size_t)_r * D) : (E.res_s + (size_t)(_r - MPROMPT) * D); \
        _Pragma("unroll") for (int j = 0; j < 4; ++j) dst[j] = (_row < E.nv) ? *reinterpret_cast<const f32x4*>(_rs + ECOL(j)) : (f32x4){0.f, 0.f, 0.f, 0.f}; } while (0)
      LOADX(0, xc);
      _Pragma("unroll") for (int g = 0; g < 8; ++g) {
        const int row = EROW(g); const int r = E.rb + row; const bool ok = row < E.nv;
        if (g + 1 < 8) LOADX(g + 1, xq);
        if (!ptile && ok) { const float* mr = E.mod + (size_t)modrow(r) * MODS;
          _Pragma("unroll") for (int j = 0; j < 4; ++j) { g4[j] = *reinterpret_cast<const f32x4*>(mr + E.goff + ECOL(j)); if (E.fuse) s4[j] = *reinterpret_cast<const f32x4*>(mr + E.fsc + ECOL(j)); } }
        float ssq = 0.f;
        if (ok) {
          _Pragma("unroll") for (int j = 0; j < 4; ++j) {
            const f32x4 xn = xc[j] + g4[j] * EACC(g, j);
            *reinterpret_cast<f32x4*>(E.xout + (size_t)r * D + ECOL(j)) = xn;
            if (E.fuse) {
              const f32x4 a = xn * w4[j] * (s4[j] + 1.f);
              st4bf(E.fa + (size_t)row * D + ECOL(j), a[0], a[1], a[2], a[3]);
              ssq += xn[0] * xn[0] + xn[1] * xn[1] + xn[2] * xn[2] + xn[3] * xn[3];
            }
          }
        }
        if (E.fuse) {
          ssq += shx(ssq, 16, lane); ssq += shx(ssq, 32, lane);
          if (fq == 0 && ok) unsafeAtomicAdd(E.fss + row, ssq);
        }
        _Pragma("unroll") for (int j = 0; j < 4; ++j) xc[j] = xq[j];
      }
#undef LOADX
    }
  } else if (E.kind == 3) {
    _Pragma("unroll") for (int g = 0; g < 8; ++g) {
      const int row = EROW(g);
      if (row < 144) {
        _Pragma("unroll") for (int j = 0; j < 4; ++j) {
          const int col = ECOL(j);
          const f32x4 bb = *reinterpret_cast<const f32x4*>(E.ada_b + col);
          const f32x4 o = EACC(g, j) + bb;
          *reinterpret_cast<f32x4*>(E.modout + (size_t)row * MODS + col) = o;
          const int ch = col >> 10;
          const int sl = (ch == 6) ? 0 : (ch == 3) ? 1 : (ch == 9) ? 2 : -1;
          if (sl >= 0) st4bf(E.shb + ((size_t)sl * 256 + row) * D + (col & 1023), o[0], o[1], o[2], o[3]);
        }
      }
    }
  } else {
    _Pragma("unroll") for (int g = 0; g < 8; ++g) {
      const int row = EROW(g);
      if (row < 144) { _Pragma("unroll") for (int j = 0; j < 4; ++j) *reinterpret_cast<f32x4*>(E.cout + (size_t)row * E.ldc + ECOL(j)) = EACC(g, j); }
    }
  }
#undef ECOL
#undef EROW
#undef EACC
}

DI int perm32(int rho) { const int n = rho >> 4, i = rho & 15; return 8 * (i >> 2) + 4 * n + (i & 3); }
DI void tile_of(int tile, int ntm, int ntn, int& pm, int& pn) {
  const int nig = 8 * ntn, gid = tile / nig, fm = gid * 8, gsz = min(ntm - fm, 8);
  pm = fm + ((tile % nig) % gsz); pn = (tile % nig) / gsz;
}

DI void gemm_phase(char* shm_, const bf16* __restrict__ Ag, const bf16* __restrict__ Btg, int K, int ntm, int ntn, const Epi& E, int split, int toff) {
  LAS unsigned char* lds = (LAS unsigned char*)shm_;
  const int tid = otid(), wid = __builtin_amdgcn_readfirstlane(tid >> 6), lane = tid & 63, wr = wid >> 2, wc = wid & 3, fr = lane & 15, fq = lane >> 4;
  const int ntk = K / BK;
  const int ntmf = split ? ntm - 1 : ntm, nfull = ntmf * ntn;
  const int G = gridDim.x, ntiles = nfull + (split ? ntn * (K / 256) : 0);
  const int bxr = (G % 8 == 0) ? (int)((blockIdx.x % 8) * (G / 8) + blockIdx.x / 8) : (int)blockIdx.x;
  unsigned voffA[2];
  _Pragma("unroll") for (int i = 0; i < 2; ++i) { int R, C; stage_rc(tid * 16 + i * 8192, R, C); voffA[i] = (unsigned)(R * K + C) * 2u; }
  const size_t kstep = (size_t)(BK * 2), hstep = (size_t)HALFT * K * 2, tstep = 2 * hstep;
  const unsigned ldsw = (unsigned)wid * 1024u;
  const int aoff = lds_byte(wr * 64 + fr, fq * 8), boff = lds_byte(wc * 32 + fr, fq * 8);
#define PSA(b, h) (((b) * 2 + (h)) * HTB)
#define PSB(b, h) ((4 + (b) * 2 + (h)) * HTB)
#define PSTAGE(bufoff, gbase) PSTAGEX(bufoff, gbase, voffA)
#define PSTAGEB(bufoff, gbase) PSTAGEX(bufoff, gbase, voffA)
#define PSTAGEX(bufoff, gbase, VO) do { _Pragma("unroll") for (int _i = 0; _i < 2; ++_i) \
    __builtin_amdgcn_global_load_lds((const unsigned*)((const char*)(gbase) + VO[_i]), (LAS unsigned*)(lds + (bufoff) + ldsw + _i * 8192), 16, 0, 0); } while (0)
#define PLDA(dst, b, h) do { _Pragma("unroll") for (int m = 0; m < 4; ++m) _Pragma("unroll") for (int k = 0; k < 2; ++k) dst[m][k] = *(const LAS bf16x8*)(lds + PSA(b, h) + aoff + m * 2048 + k * 1024); } while (0)
#define PLDB(dst, b, h) do { _Pragma("unroll") for (int n = 0; n < 2; ++n) _Pragma("unroll") for (int k = 0; k < 2; ++k) dst[n][k] = *(const LAS bf16x8*)(lds + PSB(b, h) + boff + n * 2048 + k * 1024); } while (0)
#define PMMA(ai, bj, At, Bq) do { __builtin_amdgcn_s_setprio(1); _Pragma("unroll") for (int m = 0; m < 4; ++m) _Pragma("unroll") for (int n = 0; n < 2; ++n) _Pragma("unroll") for (int k = 0; k < 2; ++k) \
    acc[ai][bj][m][n] = __builtin_amdgcn_mfma_f32_16x16x32_bf16(Bq[n][k], At[m][k], acc[ai][bj][m][n], 0, 0, 0); __builtin_amdgcn_s_setprio(0); } while (0)
#define WAIT_V(n) asm volatile("s_waitcnt vmcnt(" #n ")" ::: "memory")
#define WAIT_L(n) asm volatile("s_waitcnt lgkmcnt(" #n ")" ::: "memory")
#define BAR __builtin_amdgcn_s_barrier()
#define SCHED __builtin_amdgcn_sched_barrier(0)
  int tile = bxr - toff;
  if (tile < 0 || tile >= ntiles) return;
#define UNIT_OF(u, PM, PN, K0, NTU, AT) do { if ((u) < nfull) { tile_of((u), ntmf, ntn, PM, PN); K0 = 0; NTU = ntk; AT = 0; } \
    else { const int _s = (u) - nfull; PN = _s % ntn; PM = ntmf; K0 = (_s / ntn) * 256; NTU = 4; AT = 1; } } while (0)
  int pm, pn, k0, nt, at; UNIT_OF(tile, pm, pn, k0, nt, at);
  f32x4 acc[2][2][4][2];
  _Pragma("unroll") for (int a = 0; a < 2; ++a) _Pragma("unroll") for (int b = 0; b < 2; ++b) _Pragma("unroll") for (int m = 0; m < 4; ++m) _Pragma("unroll") for (int n = 0; n < 2; ++n) acc[a][b][m][n] = (f32x4){0.f, 0.f, 0.f, 0.f};
  bf16x8 At[4][2], B0[2][2], B1[2][2];
  const char* cA = (const char*)Ag + (size_t)pm * tstep + (size_t)k0 * 2; const char* cB = (const char*)Btg + (size_t)pn * tstep + (size_t)k0 * 2;
  PSTAGEB(PSB(0, 0), cB); PSTAGE(PSA(0, 0), cA); PSTAGEB(PSB(0, 1), cB + hstep); PSTAGE(PSA(0, 1), cA + hstep);
  if (wr == 1) BAR;
  WAIT_V(4); BAR;
  PSTAGEB(PSB(1, 0), cB + kstep); PSTAGE(PSA(1, 0), cA + kstep); PSTAGEB(PSB(1, 1), cB + hstep + kstep);
  WAIT_V(6); BAR;
  for (;;) {
    const int ntile = tile + G;
    const bool has_next = ntile < ntiles;
    int npm = pm, npn = pn, nk0 = k0, nnt = nt, nat = at; if (has_next) UNIT_OF(ntile, npm, npn, nk0, nnt, nat);
    const char* nA = has_next ? (const char*)Ag + (size_t)npm * tstep + (size_t)nk0 * 2 : cA; const char* nB = has_next ? (const char*)Btg + (size_t)npn * tstep + (size_t)nk0 * 2 : cB;
    for (int t = 0; t < nt; t += 2) {
      const bool last = (t == nt - 2);
      const char* a1 = cA + (size_t)(t + 1) * kstep;
      const char* a2 = last ? nA : cA + (size_t)(t + 2) * kstep; const char* b2 = last ? nB : cB + (size_t)(t + 2) * kstep;
      const char* a3 = a2 + kstep; const char* b3 = b2 + kstep;
      PLDB(B0, 0, 0); SCHED; PLDA(At, 0, 0); PSTAGE(PSA(1, 1), a1 + hstep);
      WAIT_L(8); BAR; WAIT_L(0); PMMA(0, 0, At, B0); BAR; SCHED;
      PLDB(B1, 0, 1); PSTAGEB(PSB(0, 0), b2);
      BAR; WAIT_L(0); PMMA(0, 1, At, B1); BAR;
      PLDA(At, 0, 1); PSTAGE(PSA(0, 0), a2);
      BAR; WAIT_L(0); PMMA(1, 0, At, B0); BAR; SCHED;
      PSTAGEB(PSB(0, 1), b2 + hstep);
      WAIT_V(6); BAR; PMMA(1, 1, At, B1); BAR;
      PLDB(B0, 1, 0); SCHED; PLDA(At, 1, 0); PSTAGE(PSA(0, 1), a2 + hstep);
      WAIT_L(8); BAR; WAIT_L(0); PMMA(0, 0, At, B0); BAR; SCHED;
      PLDB(B1, 1, 1); PSTAGEB(PSB(1, 0), b3);
      BAR; WAIT_L(0); PMMA(0, 1, At, B1); BAR;
      PLDA(At, 1, 1); PSTAGE(PSA(1, 0), a3);
      BAR; WAIT_L(0); PMMA(1, 0, At, B0); BAR; SCHED;
      PSTAGEB(PSB(1, 1), b3 + hstep);
      WAIT_V(6); BAR; PMMA(1, 1, At, B1); BAR;
    }
    epilogue(acc, E, pm * BM, pn * BM, wr, wc, fr, fq, at);
    if (!has_next) break;
    _Pragma("unroll") for (int a = 0; a < 2; ++a) _Pragma("unroll") for (int b = 0; b < 2; ++b) _Pragma("unroll") for (int m = 0; m < 4; ++m) _Pragma("unroll") for (int n = 0; n < 2; ++n) acc[a][b][m][n] = (f32x4){0.f, 0.f, 0.f, 0.f};
    tile = ntile; pm = npm; pn = npn; k0 = nk0; nt = nnt; at = nat; cA = nA; cB = nB;
  }
  WAIT_V(0);
  if (wr == 0) BAR;
  BAR;
}

struct TJob { const float* src; u16* dst; int K, N, tk, tn; };
DI TJob tjob_of(const Params& P, unsigned char* ws, int job) {
  TJob J; const int l = job / 6464; int j = job % 6464;
  if (j < 2624) { J.src = P.w_in + (size_t)l * D * DIN; J.dst = (u16*)(ws + WS_WIN) + (size_t)l * ZS * D; J.K = D; J.N = DIN; J.tk = j / 164; J.tn = j % 164; }
  else if ((j -= 2624) < 256) { J.src = P.w_out + (size_t)l * D * D; J.dst = (u16*)(ws + WS_WOUT) + (size_t)l * D * D; J.K = D; J.N = D; J.tk = j / 16; J.tn = j % 16; }
  else if ((j -= 256) < 1024) { J.src = P.w_up + (size_t)l * D * DFF; J.dst = (u16*)(ws + WS_WUP) + (size_t)l * DFF * D; J.K = D; J.N = DFF; J.tk = j / 64; J.tn = j % 64; }
  else if ((j -= 1024) < 1024) { J.src = P.w_down + (size_t)l * DFF * D; J.dst = (u16*)(ws + WS_WDN) + (size_t)l * D * DFF; J.K = DFF; J.N = D; J.tk = j / 16; J.tn = j % 16; }
  else { j -= 1024; J.src = P.ada_w + (size_t)l * D * 6144; J.dst = (u16*)(ws + WS_AWT) + (size_t)l * 6144 * D; J.K = D; J.N = 6144; J.tk = j / 96; J.tn = j % 96; }
  return J;
}
DI void tjob_load(const TJob& J, int tid, f32x4 (&v)[2]) {
  const int nn = (tid & 15) * 4, n = J.tn * 64 + nn;
  _Pragma("unroll") for (int i = 0; i < 2; ++i) { const int kk = (tid >> 4) + 32 * i;
    v[i] = (n < J.N) ? *reinterpret_cast<const f32x4*>(J.src + (size_t)(J.tk * 64 + kk) * J.N + n) : (f32x4){0.f, 0.f, 0.f, 0.f}; }
}

DI void prep_phase(char* shm, const Params& P) {
  float* tl = (float*)shm;
  unsigned char* ws = optr(P.ws);
  int bx_ = blockIdx.x; asm volatile("" : "+s"(bx_));
  int G_ = gridDim.x; asm volatile("" : "+s"(G_));
  const int G = G_, bx = bx_, tid = otid();
  const int njobs = 2 * 6464;
  if (bx < njobs) {
    f32x4 v[2];
    { const TJob J0 = tjob_of(P, ws, bx); tjob_load(J0, tid, v); }
    _Pragma("unroll 1") for (int job = bx; job < njobs; job += G) {
      __syncthreads();
      { const int nn = (tid & 15) * 4; _Pragma("unroll") for (int i = 0; i < 2; ++i) { const int kk = (tid >> 4) + 32 * i;
          _Pragma("unroll") for (int q = 0; q < 4; ++q) tl[kk * 65 + nn + q] = v[i][q]; } }
      if (job + G < njobs) { const TJob Jn = tjob_of(P, ws, job + G); tjob_load(Jn, tid, v); }
      __syncthreads();
      { const TJob Jc = tjob_of(P, ws, job);
        const int nn = tid >> 3, kp = tid & 7; float o[8]; _Pragma("unroll") for (int j = 0; j < 8; ++j) o[j] = tl[(kp * 8 + j) * 65 + nn];
        const int ncol = Jc.tn * 64 + nn, c5 = ncol & 31, slot = (ncol & ~31) + 16 * ((c5 >> 2) & 1) + 4 * (c5 >> 3) + (c5 & 3);
        st8(Jc.dst + (size_t)slot * Jc.K + Jc.tk * 64 + kp * 8, pack8(o)); }
    }
  }
  { unsigned* shb = (unsigned*)(ws + WS_SHB); _Pragma("unroll 1") for (int e = bx * NT + tid; e < 3 * 256 * 1024 / 2; e += G * NT) shb[e] = 0u; }
  u16* sc = (u16*)(ws + WS_SC);
  _Pragma("unroll 1") for (int e = bx * NT + tid; e < 256 * 1024; e += G * NT) {
    int row = e >> 10, c = e & 1023; float v = 0.f;
    if (row < 16) v = siluf(P.c_prompt[row * D + c]); else if (row < 144) v = siluf(P.c_sample[(row - 16) * D + c]);
    sc[e] = f2bf(v);
  }
  if (bx == 0) {
    float* bt = (float*)(ws + WS_BT);
    for (int e = tid; e < 128 * 16; e += NT) {
      int n = e >> 4, hd = e & 15; int bk;
      if (n < 16) bk = n; else { float nf = (float)n; int lg = 16 + (int)(logf(nf / 16.f) / 2.0794415416798357f * 16.f); bk = lg < 31 ? lg : 31; }
      bt[e] = P.rel[bk * 16 + hd];
    }
  }
}

DI void norm_phase(const Params& P, int l, int hf, int which  , bool from_input) {
  const int RB = hf * HALF_ROWS, NV = hf ? 16512 : 16384, NR = hf ? 16640 : 16384;
  const int tid = otid(); const int w = tid >> 6, lane = tid & 63;
  u16* H = (u16*)(optr(P.ws) + WS_H);
  const float* mod = (const float*)(optr(P.ws) + WS_MOD);
  const float* nw = (which ? P.n2 : P.n1) + l * D;
  const int stride = gridDim.x * 8;
  f32x4 nx[4];
#define NORM_SRC(lrow) (from_input ? ((RB + (lrow)) < MPROMPT ? P.x_prompt + (size_t)(RB + (lrow)) * D : P.x_sample + (size_t)(RB + (lrow) - MPROMPT) * D) : P.out + (size_t)(RB + (lrow)) * D)
  f32x4 nsh[4], nsc[4], nw4[4];
  _Pragma("unroll") for (int k = 0; k < 4; ++k) nw4[k] = *reinterpret_cast<const f32x4*>(nw + lane * 4 + 256 * k);
#define NORM_LOAD(lrow) do { const float* _xr = NORM_SRC(lrow); const float* _mr = mod + (size_t)modrow(RB + (lrow)) * MODS + l * 6144 + which * 3072; \
    _Pragma("unroll") for (int k = 0; k < 4; ++k) { nx[k] = *reinterpret_cast<const f32x4*>(_xr + lane * 4 + 256 * k); nsh[k] = *reinterpret_cast<const f32x4*>(_mr + lane * 4 + 256 * k); nsc[k] = *reinterpret_cast<const f32x4*>(_mr + 1024 + lane * 4 + 256 * k); } } while (0)
  int lr = blockIdx.x * 8 + w;
  if (lr < NV) NORM_LOAD(lr);
  _Pragma("unroll 1") for (; lr < NR; lr += stride) {
    u16* hrow = H + (size_t)lr * D;
    if (lr >= NV) { _Pragma("unroll") for (int k = 0; k < 4; ++k) st4bf(hrow + lane * 4 + 256 * k, 0.f, 0.f, 0.f, 0.f); continue; }
    const int r = RB + lr;
    f32x4 x[4], csh[4], csc[4]; float ss = 0.f;
    _Pragma("unroll") for (int k = 0; k < 4; ++k) { x[k] = nx[k]; csh[k] = nsh[k]; csc[k] = nsc[k]; ss += x[k][0] * x[k][0] + x[k][1] * x[k][1] + x[k][2] * x[k][2] + x[k][3] * x[k][3]; }
    if (lr + stride < NV) NORM_LOAD(lr + stride);
    for (int o = 32; o >= 1; o >>= 1) ss += shx(ss, o, lane);
    const float rs = rsqrtf(ss * (1.f / D) + EPS);
    if (from_input && r >= MPROMPT) { _Pragma("unroll") for (int k = 0; k < 4; ++k) *reinterpret_cast<f32x4*>(P.out + (size_t)r * D + lane * 4 + 256 * k) = x[k]; }
    _Pragma("unroll") for (int k = 0; k < 4; ++k) {
      const int c = lane * 4 + 256 * k;
      f32x4 y = x[k] * rs * nw4[k] * (csc[k] + 1.f) + csh[k];
      st4bf(hrow + c, y[0], y[1], y[2], y[3]);
    }
  }
}

DI void final_norm_phase(const Params& P) {
  const int tid = otid(); const int w = tid >> 6, lane = tid & 63;
  const int stride = gridDim.x * 8;
  f32x4 nx[4], fw4[4];
  _Pragma("unroll") for (int k = 0; k < 4; ++k) fw4[k] = *reinterpret_cast<const f32x4*>(P.fnw + lane * 4 + 256 * k);
  int r = blockIdx.x * 8 + w;
  if (r < MVALID) { _Pragma("unroll") for (int k = 0; k < 4; ++k) nx[k] = *reinterpret_cast<const f32x4*>(P.out + (size_t)r * D + lane * 4 + 256 * k); }
  _Pragma("unroll 1") for (; r < MVALID; r += stride) {
    float* xr = P.out + (size_t)r * D;
    f32x4 x[4]; float ss = 0.f;
    _Pragma("unroll") for (int k = 0; k < 4; ++k) { x[k] = nx[k]; ss += x[k][0] * x[k][0] + x[k][1] * x[k][1] + x[k][2] * x[k][2] + x[k][3] * x[k][3]; }
    if (r + stride < MVALID) { _Pragma("unroll") for (int k = 0; k < 4; ++k) nx[k] = *reinterpret_cast<const f32x4*>(P.out + (size_t)(r + stride) * D + lane * 4 + 256 * k); }
    for (int o = 32; o >= 1; o >>= 1) ss += shx(ss, o, lane);
    const float rs = rsqrtf(ss * (1.f / D) + EPS);
    _Pragma("unroll") for (int k = 0; k < 4; ++k) { const int c = lane * 4 + 256 * k; *reinterpret_cast<f32x4*>(xr + c) = x[k] * rs * fw4[k]; }
  }
}

DI void conv_phase(const Params& P, int l, int hf) {
  const int tid = otid();
  const u16* Z = (const u16*)(optr(P.ws) + WS_Z);
  u16* XBC = (u16*)(optr(P.ws) + WS_XBC);
  float* DT = (float*)(optr(P.ws) + WS_DT);
  const float* cw = P.conv_w + (size_t)l * 4 * 1536;
  const float* cb = P.conv_b + (size_t)l * 1536;
  const int nstrips = 16384 / 32;
  for (int sp = blockIdx.x * 2; sp < nstrips; sp += gridDim.x * 2) {
    if (tid < 384) {
      const int part = tid % 192, strip = sp + tid / 192, ch0 = part * 8;
      const int lr0 = strip * 32;
      float w[4][8], bias[8];
      _Pragma("unroll") for (int i = 0; i < 4; ++i) { const f32x4 a = *reinterpret_cast<const f32x4*>(cw + i * 1536 + ch0), b = *reinterpret_cast<const f32x4*>(cw + i * 1536 + ch0 + 4);
        _Pragma("unroll") for (int j = 0; j < 4; ++j) { w[i][j] = a[j]; w[i][4 + j] = b[j]; } }
      { const f32x4 a = *reinterpret_cast<const f32x4*>(cb + ch0), b = *reinterpret_cast<const f32x4*>(cb + ch0 + 4);
        _Pragma("unroll") for (int j = 0; j < 4; ++j) { bias[j] = a[j]; bias[4 + j] = b[j]; } }
      bf16x8 h0, h1, h2;
      const u16* zp = Z + (size_t)lr0 * ZS + C_CX + ch0;
      if ((lr0 & 2047) == 0) { _Pragma("unroll") for (int j = 0; j < 8; ++j) { h0[j] = 0; h1[j] = 0; h2[j] = 0; } }
      else { h0 = ld8(zp - 3 * (size_t)ZS); h1 = ld8(zp - 2 * (size_t)ZS); h2 = ld8(zp - (size_t)ZS); }
      u16* xo = XBC + (size_t)lr0 * 1536 + ch0;
      _Pragma("unroll 1") for (int rb = 0; rb < 32; rb += 8) {
        bf16x8 cur[8];
        _Pragma("unroll") for (int k = 0; k < 8; ++k) cur[k] = ld8(zp + (size_t)(rb + k) * ZS);
        _Pragma("unroll") for (int k = 0; k < 8; ++k) {
          float a[8];
          _Pragma("unroll") for (int j = 0; j < 8; ++j) a[j] = siluf(bias[j] + w[0][j] * bfs(h0[j]) + w[1][j] * bfs(h1[j]) + w[2][j] * bfs(h2[j]) + w[3][j] * bfs(cur[k][j]));
          st8(xo + (size_t)(rb + k) * 1536, pack8(a));
          h0 = h1; h1 = h2; h2 = cur[k];
        }
      }
    } else {
      const int t = tid - 384;
      u16 zv[8];
      _Pragma("unroll") for (int k = 0; k < 8; ++k) { const int u = t + 128 * k; zv[k] = Z[(size_t)(sp * 32 + (u >> 4)) * ZS + C_DT + (u & 15)]; }
      const float dtb = P.dt_bias[l * 16 + (t & 15)];
      _Pragma("unroll") for (int k = 0; k < 8; ++k) { const int u = t + 128 * k; DT[(size_t)(sp * 32 + (u >> 4)) * 16 + (u & 15)] = softplusf(bf2f(zv[k]) + dtb); }
    }
  }
}

DI void mix_phase(const Params& P, int l, int hf) {
  const int NV = hf ? 16512 : 16384, NR = hf ? 16640 : 16384;
  const int tid = otid(); const int w = tid >> 6, lane = tid & 63;
  u16* H = (u16*)(optr(P.ws) + WS_H);
  const u16* Z = (const u16*)(optr(P.ws) + WS_Z);
  const u16* YC = (const u16*)(optr(P.ws) + WS_YC);
  const float* snw = P.snw + l * D;
  bf16x8 nob[2], ny[2], ncz[2], noa[2], nbg[2], nga[2], ngb[2], ngc[2];
#define MIX_LOAD(row) do { const u16* zr = Z + (size_t)(row) * ZS + lane * 8; const u16* yr = YC + (size_t)(row) * D + lane * 8; \
    _Pragma("unroll") for (int k = 0; k < 2; ++k) { \
      nob[k] = ld8(zr + C_BV + 512 * k); ny[k] = ld8(yr + 512 * k); ncz[k] = ld8(zr + C_CZ + 512 * k); noa[k] = ld8(zr + C_AQ + 512 * k); \
      nbg[k] = ld8(zr + C_BG + 512 * k); nga[k] = ld8(zr + C_GA + 512 * k); ngb[k] = ld8(zr + C_GB + 512 * k); ngc[k] = ld8(zr + C_GC + 512 * k); } } while (0)
  const int stride = gridDim.x * 8;
  f32x4 snv[2][2];
  _Pragma("unroll") for (int k = 0; k < 2; ++k) { snv[k][0] = *reinterpret_cast<const f32x4*>(snw + lane * 8 + 512 * k); snv[k][1] = *reinterpret_cast<const f32x4*>(snw + lane * 8 + 512 * k + 4); }
  int lr = blockIdx.x * 8 + w;
  if (lr < NV) MIX_LOAD(lr);
  float* SS1 = (float*)(optr(P.ws) + WS_SS1); float* SS2 = (float*)(optr(P.ws) + WS_SS2);
  _Pragma("unroll 1") for (; lr < NR; lr += stride) {
    u16* hrow = H + (size_t)lr * D + lane * 8;
    if (lane == 0) { SS1[lr] = 0.f; SS2[lr] = 0.f; }
    if (lr >= NV) { _Pragma("unroll") for (int k = 0; k < 2; ++k) { st4bf(hrow + 512 * k, 0.f, 0.f, 0.f, 0.f); st4bf(hrow + 512 * k + 4, 0.f, 0.f, 0.f, 0.f); } continue; }
    bf16x8 vob[2], vy[2], vcz[2], voa[2], vbg[2], vga[2], vgb[2], vgc[2];
    _Pragma("unroll") for (int k = 0; k < 2; ++k) { vob[k] = nob[k]; vy[k] = ny[k]; vcz[k] = ncz[k]; voa[k] = noa[k]; vbg[k] = nbg[k]; vga[k] = nga[k]; vgb[k] = ngb[k]; vgc[k] = ngc[k]; }
    if (lr + stride < NV) MIX_LOAD(lr + stride);
    _Pragma("unroll") for (int k = 0; k < 2; ++k) {
      float ob[8], yg[8], so = 0.f, sy = 0.f;
      _Pragma("unroll") for (int j = 0; j < 8; ++j) { float o = bfs(vob[k][j]); ob[j] = o; so += o * o; float t = bfs(vy[k][j]) * siluf(bfs(vcz[k][j])); yg[j] = t; sy += t * t; }
      so += shx(so, 1, lane); so += shx(so, 2, lane); so += shx(so, 4, lane); so += shx(so, 8, lane);
      for (int o = 32; o >= 1; o >>= 1) sy += shx(sy, o, lane);
      const float ro = rsqrtf(so * (1.f / 128.f) + EPS), ry = rsqrtf(sy * (1.f / 512.f) + EPS);
      float m[8];
      const f32x4 s0 = snv[k][0], s1 = snv[k][1];
      _Pragma("unroll") for (int j = 0; j < 8; ++j) {
        const float obn = ob[j] * ro * siluf(bfs(vbg[k][j]));
        const float ocn = yg[j] * ry * (j < 4 ? s0[j & 3] : s1[j & 3]);
        m[j] = sigmf(bfs(vga[k][j])) * bfs(voa[k][j]) + sigmf(bfs(vgb[k][j])) * obn + sigmf(bfs(vgc[k][j])) * ocn;
      }
      st8(hrow + 512 * k, pack8(m));
    }
  }
}

DI void att_prompt_item(char* shm, const Params& P, int l, int hf, int b, int blk, int kvh) {
  u16* Ks = (u16*)shm;
  u16* Vt = Ks + 256 * 72;
  float* bias = (float*)(Vt + 64 * 268);
  u16* Z = (u16*)(optr(P.ws) + WS_Z);
  const float* bt = (const float*)(optr(P.ws) + WS_BT);
  const int tid = otid(), lane = tid & 63, w = tid >> 6;
  const int lr0 = b * 2048 + blk * 128 - hf * HALF_ROWS;
  const int g = w >> 1, qh = kvh * 4 + g, r = lane & 31, h = lane >> 5;
  bf16x8 qall[2][4];
  _Pragma("unroll") for (int qq = 0; qq < 2; ++qq) { const u16* qp = Z + (size_t)(lr0 + ((w & 1) * 2 + qq) * 32 + r) * ZS + C_AQ + qh * 64;
    _Pragma("unroll") for (int s = 0; s < 4; ++s) qall[qq][s] = ld8(qp + 16 * s + 8 * h); }
  const float sink = P.sinks[l * 16 + qh];
  const float btv = bt[(tid & 127) * 16 + kvh * 4 + (tid >> 7)];
  __syncthreads();
  {
    bf16x8 kr[4], vr[4];
    _Pragma("unroll") for (int it = 0; it < 4; ++it) { const int c = tid + it * NT, key = c >> 3, part = c & 7;
      if (blk > 0 || key >= 128) { const u16* src = Z + (size_t)(lr0 - 128 + key) * ZS; kr[it] = ld8(src + C_AK + kvh * 64 + part * 8); vr[it] = ld8(src + C_AV + kvh * 64 + part * 8); }
      else { _Pragma("unroll") for (int j = 0; j < 8; ++j) { kr[it][j] = 0; vr[it][j] = 0; } } }
    _Pragma("unroll") for (int it = 0; it < 4; ++it) { const int c = tid + it * NT, key = c >> 3, part = c & 7;
      st8(Ks + key * 72 + part * 8, kr[it]);
      _Pragma("unroll") for (int jj = 0; jj < 8; ++jj) Vt[(part * 8 + jj) * 268 + key] = (u16)vr[it][jj]; }
  }
  { const int g3 = tid >> 7, dist = tid & 127; bias[g3 * 192 + 32 + dist] = btv * 1.4426950408889634f;
    if (tid < 256) { const int g2 = tid >> 6, k = tid & 63; bias[g2 * 192 + (k < 32 ? k : 128 + k)] = 0.f; } }
  __syncthreads();
  _Pragma("unroll") for (int qq = 0; qq < 2; ++qq) {
    const int qt = (w & 1) * 2 + qq, qi = qt * 32 + r;
    u16* qrow = Z + (size_t)(lr0 + qi) * ZS + C_AQ + qh * 64;
    bf16x8 qf[4];
    _Pragma("unroll") for (int s = 0; s < 4; ++s) qf[s] = qall[qq][s];
    f32x16 O0 = zero16(), O1 = zero16();
    float m = sink * 1.4426950408889634f, lsum = 1.f;
    const int kt0 = (blk == 0) ? 4 : qt;
    _Pragma("unroll 1") for (int kt = kt0; kt <= qt + 4; ++kt) {
      f32x16 S = zero16();
      _Pragma("unroll") for (int s = 0; s < 4; ++s) { const bf16x8 kf = ld8(Ks + (kt * 32 + r) * 72 + 16 * s + 8 * h); S = MFMA32(kf, qf[s], S); }
      const float* bp = bias + g * 192 + 32 + (qi - 32 * kt + 128 - 4 * h);
      float mloc = -INFINITY;
      _Pragma("unroll") for (int i = 0; i < 16; ++i) S[i] = fmaf(S[i], 0.125f * 1.4426950408889634f, bp[-((i & 3) + 8 * (i >> 2))]);
      if (kt == qt) { _Pragma("unroll") for (int i = 0; i < 16; ++i) S[i] = (crow(i, h) > r) ? S[i] : -INFINITY; }
      if (kt == qt + 4) { _Pragma("unroll") for (int i = 0; i < 16; ++i) S[i] = (crow(i, h) <= r) ? S[i] : -INFINITY; }
      _Pragma("unroll") for (int i = 0; i < 16; ++i) mloc = fmaxf(mloc, S[i]);
      mloc = fmaxf(mloc, shx(mloc, 32, lane));
      const float mnew = fmaxf(m, mloc), alpha = __builtin_amdgcn_exp2f(m - mnew);
      float ps = 0.f;
      _Pragma("unroll") for (int i = 0; i < 16; ++i) { const float p = __builtin_amdgcn_exp2f(S[i] - mnew); S[i] = p; ps += p; }
      ps += shx(ps, 32, lane);
      lsum = lsum * alpha + ps; m = mnew;
      _Pragma("unroll") for (int i = 0; i < 16; ++i) { O0[i] *= alpha; O1[i] *= alpha; }
      const bf16x8 p0 = packP<0>(S), p1 = packP<1>(S);
      { const u16* vp = Vt + (r) * 268 + kt * 32 + 4 * h;
        O0 = MFMA32(cat4(*(const s16x4*)vp, *(const s16x4*)(vp + 8)), p0, O0);
        O0 = MFMA32(cat4(*(const s16x4*)(vp + 16), *(const s16x4*)(vp + 24)), p1, O0); }
      { const u16* vp = Vt + (32 + r) * 268 + kt * 32 + 4 * h;
        O1 = MFMA32(cat4(*(const s16x4*)vp, *(const s16x4*)(vp + 8)), p0, O1);
        O1 = MFMA32(cat4(*(const s16x4*)(vp + 16), *(const s16x4*)(vp + 24)), p1, O1); }
    }
    const float inv = 1.f / lsum;
    _Pragma("unroll") for (int gq = 0; gq < 4; ++gq) {
      st4bf(qrow + 8 * gq + 4 * h, O0[4 * gq] * inv, O0[4 * gq + 1] * inv, O0[4 * gq + 2] * inv, O0[4 * gq + 3] * inv);
      st4bf(qrow + 32 + 8 * gq + 4 * h, O1[4 * gq] * inv, O1[4 * gq + 1] * inv, O1[4 * gq + 2] * inv, O1[4 * gq + 3] * inv);
    }
  }
  if (blk == 15) {
    float* wk = P.out + O_WKP + (size_t)(l * 16 + b) * 128 * 256 + kvh * 64;
    float* wv = P.out + O_WVP + (size_t)(l * 16 + b) * 128 * 256 + kvh * 64;
    for (int idx = tid; idx < 128 * 64; idx += NT) { const int j = idx >> 6, d = idx & 63; wk[j * 256 + d] = bf2f(Ks[(128 + j) * 72 + d]); wv[j * 256 + d] = bf2f(Vt[d * 268 + 128 + j]); }
  }
}

DI void ret_prompt_item(char* shm, const Params& P, int l, int hf, int b, int hd) {
  u16* QQ = (u16*)shm;
  u16* KK = QQ + 128 * 72;
  u16* KKt = KK + 128 * 72;
  u16* Vt = KKt + 64 * 136;
  u16* St = Vt + 128 * 136;
  float* th = (float*)(St + 128 * 72);
  u16* Z = (u16*)(optr(P.ws) + WS_Z);
  const int tid = otid(), lane = tid & 63, w = tid >> 6, r = lane & 31, hh = lane >> 5;
  const float log2g = log2f(1.f - exp2f(-5.f - (float)hd));
  const float g128 = exp2f(log2g * 128.f);
  __syncthreads();
  for (int e = tid; e < 128 * 72; e += NT) St[e] = 0;
  if (tid < 32) th[tid] = 1.f / powf(10000.f, (float)tid / 31.f);
  f32x16 Sacc = zero16();
  const int lt = w & 3, eh = w >> 2;
  bf16x8 qv[2], kv[2], vv[4];
#define RET_ISSUE(cc) do { const int _lr = b * 2048 + (cc) * 128 - hf * HALF_ROWS; \
    _Pragma("unroll") for (int it = 0; it < 2; ++it) { const int idx = tid + it * NT, row = idx & 127, part = idx >> 7; \
      const u16* zr = Z + (size_t)(_lr + row) * ZS; qv[it] = ld8(zr + C_BQ + hd * 64 + part * 8); kv[it] = ld8(zr + C_BK + hd * 64 + part * 8); } \
    _Pragma("unroll") for (int it = 0; it < 4; ++it) { const int idx = tid + it * NT, row = idx & 127, part = idx >> 7; \
      vv[it] = ld8(Z + (size_t)(_lr + row) * ZS + C_BV + hd * 128 + part * 8); } } while (0)
  RET_ISSUE(0);
  _Pragma("unroll 1") for (int c = 0; c < 16; ++c) {
    const int tok0 = c * 128;
    const int lrow0 = b * 2048 + tok0 - hf * HALF_ROWS;
    __syncthreads();
    {
      _Pragma("unroll") for (int it = 0; it < 2; ++it) {
        const int idx = tid + it * NT, row = idx & 127, part = idx >> 7;
        const float pos = (float)(tok0 + row);
        const float gq = exp2f(log2g * (float)(row + 1)), gk = 0.125f * exp2f(-log2g * (float)(row + 1));
        float qo[8], ko[8];
        _Pragma("unroll") for (int pr = 0; pr < 4; ++pr) {
          float sn, cs; sincos_rev(pos * th[part * 4 + pr], sn, cs);
          const float q1 = bfs(qv[it][2 * pr]), q2 = bfs(qv[it][2 * pr + 1]), k1 = bfs(kv[it][2 * pr]), k2 = bfs(kv[it][2 * pr + 1]);
          qo[2 * pr] = (q1 * cs - q2 * sn) * gq; qo[2 * pr + 1] = (q1 * sn + q2 * cs) * gq;
          ko[2 * pr] = (k1 * cs - k2 * sn) * gk; ko[2 * pr + 1] = (k1 * sn + k2 * cs) * gk;
        }
        st8(QQ + row * 72 + part * 8, pack8(qo));
        st8(KK + row * 72 + part * 8, pack8(ko));
        _Pragma("unroll") for (int jj = 0; jj < 8; ++jj) KKt[(part * 8 + jj) * 136 + row] = f2bf(ko[jj]);
      }
      _Pragma("unroll") for (int it = 0; it < 4; ++it) { const int idx = tid + it * NT, row = idx & 127, part = idx >> 7;
        _Pragma("unroll") for (int jj = 0; jj < 8; ++jj) Vt[(part * 8 + jj) * 136 + row] = (u16)vv[it][jj]; }
    }
    if (c + 1 < 16) RET_ISSUE(c + 1);
    __syncthreads();
    bf16x8 qf[4];
    _Pragma("unroll") for (int s = 0; s < 4; ++s) qf[s] = ld8(QQ + (lt * 32 + r) * 72 + 16 * s + 8 * hh);
    f32x16 O0 = zero16(), O1 = zero16();
    _Pragma("unroll") for (int s = 0; s < 4; ++s) {
      O0 = MFMA32(ld8(St + ((2 * eh) * 32 + r) * 72 + 16 * s + 8 * hh), qf[s], O0);
      O1 = MFMA32(ld8(St + ((2 * eh + 1) * 32 + r) * 72 + 16 * s + 8 * hh), qf[s], O1);
    }
    _Pragma("unroll 1") for (int mk = 0; mk <= lt; ++mk) {
      f32x16 Aa = zero16();
      _Pragma("unroll") for (int s = 0; s < 4; ++s) Aa = MFMA32(ld8(KK + (mk * 32 + r) * 72 + 16 * s + 8 * hh), qf[s], Aa);
      if (mk == lt) _Pragma("unroll") for (int i = 0; i < 16; ++i) if (crow(i, hh) > r) Aa[i] = 0.f;
      const bf16x8 p0 = packP<0>(Aa), p1 = packP<1>(Aa);
      { const u16* vp = Vt + ((2 * eh) * 32 + r) * 136 + mk * 32 + 4 * hh;
        O0 = MFMA32(cat4(*(const s16x4*)vp, *(const s16x4*)(vp + 8)), p0, O0);
        O0 = MFMA32(cat4(*(const s16x4*)(vp + 16), *(const s16x4*)(vp + 24)), p1, O0); }
      { const u16* vp = Vt + ((2 * eh + 1) * 32 + r) * 136 + mk * 32 + 4 * hh;
        O1 = MFMA32(cat4(*(const s16x4*)vp, *(const s16x4*)(vp + 8)), p0, O1);
        O1 = MFMA32(cat4(*(const s16x4*)(vp + 16), *(const s16x4*)(vp + 24)), p1, O1); }
    }
    { u16* orow = Z + (size_t)(lrow0 + lt * 32 + r) * ZS + C_BV + hd * 128 + (2 * eh) * 32;
      _Pragma("unroll") for (int gq = 0; gq < 4; ++gq) {
        st4bf(orow + 8 * gq + 4 * hh, O0[4 * gq], O0[4 * gq + 1], O0[4 * gq + 2], O0[4 * gq + 3]);
        st4bf(orow + 32 + 8 * gq + 4 * hh, O1[4 * gq], O1[4 * gq + 1], O1[4 * gq + 2], O1[4 * gq + 3]);
      } }
    _Pragma("unroll") for (int s = 0; s < 8; ++s)
      Sacc = MFMA32(ld8(Vt + (lt * 32 + r) * 136 + 16 * s + 8 * hh), ld8(KKt + (eh * 32 + r) * 136 + 16 * s + 8 * hh), Sacc);
    _Pragma("unroll") for (int i = 0; i < 16; ++i) Sacc[i] *= g128;
    __syncthreads();
    _Pragma("unroll") for (int i = 0; i < 16; ++i) St[(lt * 32 + crow(i, hh)) * 72 + eh * 32 + r] = f2bf(Sacc[i]);
  }
  float* so = P.out + O_RETP + (size_t)((l * 16 + b) * 8 + hd) * 8192 + (size_t)(eh * 32 + r) * 128 + lt * 32;
  _Pragma("unroll") for (int gq = 0; gq < 4; ++gq) *reinterpret_cast<f32x4*>(so + 8 * gq + 4 * hh) = (f32x4){Sacc[4 * gq], Sacc[4 * gq + 1], Sacc[4 * gq + 2], Sacc[4 * gq + 3]};
}

DI void ssd_prompt_item(char* shm, const Params& P, int l, int hf, int b, int hc) {
  u16* Bm = (u16*)shm;
  u16* Cm = Bm + 128 * 136;
  u16* Xs = Cm + 128 * 136;
  u16* XwT = Xs + 64 * 136;
  u16* Hs = XwT + 64 * 136;
  float* acum = (float*)(Hs + 64 * 136);
  float* dtv = acum + 128;
  float* tot = dtv + 128;
  const u16* Z = (const u16*)(optr(P.ws) + WS_Z);
  u16* YC = (u16*)(optr(P.ws) + WS_YC);
  const u16* XBC = (const u16*)(optr(P.ws) + WS_XBC);
  const float* DT = (const float*)(optr(P.ws) + WS_DT);
  const int tid = otid(), lane = tid & 63, w = tid >> 6, r = lane & 31, hh = lane >> 5;
  const int g = hc >> 3;
  const float Aneg = -expf(P.A_log[l * 16 + hc]), dtb = P.dt_bias[l * 16 + hc], dsk = P.D_skip[l * 16 + hc];
  const float* cw = P.conv_w + (size_t)l * 4 * 1536;
  const float* cb = P.conv_b + (size_t)l * 1536;
  const int lrowb = b * 2048 - hf * HALF_ROWS;
  __syncthreads();
  for (int e = tid; e < 64 * 136; e += NT) Hs[e] = 0;
  f32x16 Hacc = zero16();
  const int pt = w >> 2, it = w & 3;
  bf16x8 pB[4], pC[4], pX[2]; float pdt = 0.f;
#define SSD_ISSUE(cc) do { const int _t0 = (cc) * 128; \
    _Pragma("unroll") for (int itr = 0; itr < 4; ++itr) { const int idx = tid + itr * NT, row = idx >> 4, part = idx & 15; \
      const u16* _p = XBC + (size_t)(lrowb + _t0 + row) * 1536 + g * 128 + part * 8; pB[itr] = ld8(_p + 1024); pC[itr] = ld8(_p + 1280); } \
    _Pragma("unroll") for (int itr = 0; itr < 2; ++itr) { const int idx = tid + itr * NT, row = idx & 127, part = idx >> 7; \
      pX[itr] = ld8(XBC + (size_t)(lrowb + _t0 + row) * 1536 + hc * 64 + part * 8); } \
    if (tid < 128) pdt = DT[(size_t)(lrowb + _t0 + tid) * 16 + hc]; } while (0)
  SSD_ISSUE(0);
  _Pragma("unroll 1") for (int c = 0; c < 16; ++c) {
    const int tok0 = c * 128;
    bf16x8 xr[2]; xr[0] = pX[0]; xr[1] = pX[1];
    if (tid < 128) {
      const float dt = pdt;
      float v = dt * Aneg;
      for (int o = 1; o < 64; o <<= 1) { const float t = shup(v, o, lane); if (lane >= o) v += t; }
      dtv[tid] = dt; acum[tid] = v;
      if (tid == 63) tot[0] = v;
    }
    _Pragma("unroll") for (int itr = 0; itr < 4; ++itr) { const int idx = tid + itr * NT, row = idx >> 4, part = idx & 15;
      st8(Bm + row * 136 + part * 8, pB[itr]); st8(Cm + row * 136 + part * 8, pC[itr]); }
    __syncthreads();
    if (tid >= 64 && tid < 128) acum[tid] += tot[0];
    __syncthreads();
    const float alast = acum[127];
    _Pragma("unroll") for (int itr = 0; itr < 2; ++itr) {
      const int idx = tid + itr * NT, row = idx & 127, part = idx >> 7;
      const float wj = __expf(alast - acum[row]) * dtv[row];
      _Pragma("unroll") for (int j = 0; j < 8; ++j) { const float xs = bfs(xr[itr][j]); Xs[(part * 8 + j) * 136 + row] = (u16)xr[itr][j]; XwT[(part * 8 + j) * 136 + row] = f2bf(xs * wj); }
    }
    if (c + 1 < 16) SSD_ISSUE(c + 1);
    __syncthreads();
    const u16* cfp = Cm + (it * 32 + r) * 136 + 8 * hh;
    f32x16 Y = zero16();
    _Pragma("unroll") for (int s = 0; s < 8; ++s) Y = MFMA32(ld8(Hs + (pt * 32 + r) * 136 + 16 * s + 8 * hh), ld8(cfp + 16 * s), Y);
    const float ai = acum[it * 32 + r];
    { const float ea = __expf(ai); _Pragma("unroll") for (int i = 0; i < 16; ++i) Y[i] *= ea; }
    _Pragma("unroll 1") for (int jt = 0; jt <= it; ++jt) {
      f32x16 Gm = zero16();
      _Pragma("unroll") for (int s = 0; s < 8; ++s) Gm = MFMA32(ld8(Bm + (jt * 32 + r) * 136 + 16 * s + 8 * hh), ld8(cfp + 16 * s), Gm);
      _Pragma("unroll") for (int i = 0; i < 16; ++i) {
        const int jl = crow(i, hh), j = jt * 32 + jl;
        const float v = Gm[i] * __expf(ai - acum[j]) * dtv[j];
        Gm[i] = (jt == it && jl > r) ? 0.f : v;
      }
      const bf16x8 p0 = packP<0>(Gm), p1 = packP<1>(Gm);
      const u16* xp = Xs + (pt * 32 + r) * 136 + jt * 32 + 4 * hh;
      Y = MFMA32(cat4(*(const s16x4*)xp, *(const s16x4*)(xp + 8)), p0, Y);
      Y = MFMA32(cat4(*(const s16x4*)(xp + 16), *(const s16x4*)(xp + 24)), p1, Y);
    }
    _Pragma("unroll") for (int i = 0; i < 16; ++i) Y[i] += dsk * bf2f(Xs[(pt * 32 + crow(i, hh)) * 136 + it * 32 + r]);
    { u16* yrow = YC + (size_t)(lrowb + tok0 + it * 32 + r) * D + hc * 64 + pt * 32;
      _Pragma("unroll") for (int gq = 0; gq < 4; ++gq) st4bf(yrow + 8 * gq + 4 * hh, Y[4 * gq], Y[4 * gq + 1], Y[4 * gq + 2], Y[4 * gq + 3]); }
    { const float dl = __expf(alast); _Pragma("unroll") for (int i = 0; i < 16; ++i) Hacc[i] *= dl; }
    _Pragma("unroll") for (int s = 0; s < 8; ++s) {
      const bf16x8 xf = ld8(XwT + (pt * 32 + r) * 136 + 16 * s + 8 * hh);
      const u16* bp = Bm + (16 * s + 8 * hh) * 136 + it * 32 + r;
      u32x4 pb;
      _Pragma("unroll") for (int q = 0; q < 4; ++q) pb[q] = (unsigned)bp[(2 * q) * 136] | ((unsigned)bp[(2 * q + 1) * 136] << 16);
      Hacc = MFMA32(xf, __builtin_bit_cast(bf16x8, pb), Hacc);
    }
    __syncthreads();
    _Pragma("unroll") for (int i = 0; i < 16; ++i) Hs[(pt * 32 + crow(i, hh)) * 136 + it * 32 + r] = f2bf(Hacc[i]);
  }
  { float* ho = P.out + O_SSMP + (size_t)((l * 16 + b) * 16 + hc) * 8192;
    _Pragma("unroll") for (int i = 0; i < 16; ++i) ho[(pt * 32 + crow(i, hh)) * 128 + it * 32 + r] = Hacc[i]; }
  { float* co = P.out + O_CONVP + (size_t)(l * 16 + b) * 3 * 1536;
    for (int e = tid; e < 3 * 64; e += NT) { const int i = e >> 6, ch = hc * 64 + (e & 63); co[i * 1536 + ch] = bf2f(Z[(size_t)(lrowb + 2045 + i) * ZS + C_CX + ch]); }
    if ((hc & 7) == 0) for (int e = tid; e < 3 * 256; e += NT) { const int i = e >> 8, q = e & 255; const int ch = (q < 128 ? 1024 : 1280 - 128) + g * 128 + q; co[i * 1536 + ch] = bf2f(Z[(size_t)(lrowb + 2045 + i) * ZS + C_CX + ch]); } }
}

DI void ssd_sample_item(char* shm, const Params& P, int l, int s, int g) {
  float* xs = (float*)shm;
  float* Bs = xs + 512;
  float* Cs = Bs + 128;
  float* dts = Cs + 128;
  const int tid = otid(), lane = tid & 63, w = tid >> 6;
  const int lr = MPROMPT + s - HALF_ROWS;
  const u16* zr = (const u16*)(optr(P.ws) + WS_Z) + (size_t)lr * ZS;
  u16* YC = (u16*)(optr(P.ws) + WS_YC) + (size_t)lr * D;
  const float* cw = P.conv_w + (size_t)l * 4 * 1536;
  const float* cb = P.conv_b + (size_t)l * 1536;
  const float* hist = P.state_conv + (size_t)(l * 128 + s) * 3 * 1536;
  float* cso = P.out + O_CONVS + (size_t)(l * 128 + s) * 3 * 1536;
  __syncthreads();
  for (int u = tid; u < 768; u += NT) {
    int ch; float* dst;
    if (u < 512) { ch = g * 512 + u; dst = xs + u; } else if (u < 640) { ch = 1024 + g * 128 + (u - 512); dst = Bs + (u - 512); } else { ch = 1280 + g * 128 + (u - 640); dst = Cs + (u - 640); }
    const float h0 = hist[ch], h1 = hist[1536 + ch], h2 = hist[2 * 1536 + ch], nw = bf2f(zr[C_CX + ch]);
    const float a = cb[ch] + cw[ch] * h0 + cw[1536 + ch] * h1 + cw[2 * 1536 + ch] * h2 + cw[3 * 1536 + ch] * nw;
    *dst = siluf(a);
    cso[ch] = h1; cso[1536 + ch] = h2; cso[2 * 1536 + ch] = nw;
  }
  if (tid < 8) { const int hc = g * 8 + tid; const float dt = softplusf(bf2f(zr[C_DT + hc]) + P.dt_bias[l * 16 + hc]); dts[tid] = dt; dts[8 + tid] = expf(dt * -expf(P.A_log[l * 16 + hc])); }
  __syncthreads();
  const int hc = g * 8 + w;
  const float dt = dts[w], dA = dts[8 + w], dsk = P.D_skip[l * 16 + hc];
  const float* hin = P.state_ssm + (size_t)((l * 128 + s) * 16 + hc) * 8192;
  float* hout = P.out + O_SSMS + (size_t)((l * 128 + s) * 16 + hc) * 8192;
  const int n4 = (lane & 31) * 4, psub = lane >> 5;
  const f32x4 Bv = *reinterpret_cast<const f32x4*>(Bs + n4), Cv = *reinterpret_cast<const f32x4*>(Cs + n4);
  {
    const int ib = 0;
    f32x4 hv[32];
    _Pragma("unroll") for (int k = 0; k < 32; ++k) hv[k] = __builtin_nontemporal_load(reinterpret_cast<const f32x4*>(hin + (k * 2 + psub) * 128 + n4));
    _Pragma("unroll") for (int k = 0; k < 32; ++k) {
      const int p = (ib * 16 + k) * 2 + psub;
      const float xv = xs[w * 64 + p];
      const f32x4 hn = hv[k] * dA + Bv * (dt * xv);
      __builtin_nontemporal_store(hn, reinterpret_cast<f32x4*>(hout + p * 128 + n4));
      float y = hn[0] * Cv[0] + hn[1] * Cv[1] + hn[2] * Cv[2] + hn[3] * Cv[3];
      for (int o = 16; o >= 1; o >>= 1) y += shx(y, o, lane);
      if ((lane & 31) == 0) YC[hc * 64 + p] = f2bf(y + dsk * xv);
    }
  }
}

DI void ret_sample_item(char* shm, const Params& P, int l, int s) {
  float* qk = (float*)shm;
  const int tid = otid(), lane = tid & 63, w = tid >> 6;
  const int lr = MPROMPT + s - HALF_ROWS;
  u16* zr = (u16*)(optr(P.ws) + WS_Z) + (size_t)lr * ZS;
  __syncthreads();
  const float gamma = 1.f - exp2f(-5.f - (float)w);
  if (lane < 32) {
    const float th = 1.f / powf(10000.f, (float)lane / 31.f);
    float sn, cs; sincos_rev(16384.f * th, sn, cs);
    const float q1 = bf2f(zr[C_BQ + w * 64 + 2 * lane]), q2 = bf2f(zr[C_BQ + w * 64 + 2 * lane + 1]);
    const float k1 = bf2f(zr[C_BK + w * 64 + 2 * lane]) * 0.125f, k2 = bf2f(zr[C_BK + w * 64 + 2 * lane + 1]) * 0.125f;
    qk[w * 128 + 2 * lane] = q1 * cs - q2 * sn; qk[w * 128 + 2 * lane + 1] = q1 * sn + q2 * cs;
    qk[w * 128 + 64 + 2 * lane] = k1 * cs - k2 * sn; qk[w * 128 + 64 + 2 * lane + 1] = k1 * sn + k2 * cs;
  }
  const int e4 = (lane & 31) * 4, dsub = lane >> 5;
  f32x4 v4;
  _Pragma("unroll") for (int j = 0; j < 4; ++j) v4[j] = bf2f(zr[C_BV + w * 128 + e4 + j]);
  __syncthreads();
  const float* Sin = P.state_ret + (size_t)((l * 128 + s) * 8 + w) * 8192;
  float* Sout = P.out + O_RETS + (size_t)((l * 128 + s) * 8 + w) * 8192;
  f32x4 o4 = (f32x4){0.f, 0.f, 0.f, 0.f};
  {
    const int ib = 0;
    f32x4 sv[32];
    _Pragma("unroll") for (int k = 0; k < 32; ++k) sv[k] = __builtin_nontemporal_load(reinterpret_cast<const f32x4*>(Sin + (k * 2 + dsub) * 128 + e4));
    _Pragma("unroll") for (int k = 0; k < 32; ++k) {
      const int d = (ib * 16 + k) * 2 + dsub;
      const f32x4 sn = sv[k] * gamma + v4 * qk[w * 128 + 64 + d];
      __builtin_nontemporal_store(sn, reinterpret_cast<f32x4*>(Sout + d * 128 + e4));
      o4 += sn * qk[w * 128 + d];
    }
  }
  _Pragma("unroll") for (int j = 0; j < 4; ++j) o4[j] += shx(o4[j], 32, lane);
  if (dsub == 0) st4bf(zr + C_BV + w * 128 + e4, o4[0], o4[1], o4[2], o4[3]);
}

DI void att_sample_item(char* shm, const Params& P, int l, int s) {
  float* Kc = (float*)shm;
  float* Vc = Kc + 129 * 65;
  float* qv = Vc + 129 * 65;
  float* sc = qv + 256;
  float* red = sc + 512;
  const int tid = otid(), lane = tid & 63, w = tid >> 6;
  const int lr = MPROMPT + s - HALF_ROWS;
  u16* zr = (u16*)(optr(P.ws) + WS_Z) + (size_t)lr * ZS;
  const float* bt = (const float*)(optr(P.ws) + WS_BT);
  const float* ck = P.cache_k + (size_t)(l * 128 + s) * 128 * 256;
  const float* cv = P.cache_v + (size_t)(l * 128 + s) * 128 * 256;
  float* ok = P.out + O_WKS + (size_t)(l * 128 + s) * 128 * 256;
  float* ov = P.out + O_WVS + (size_t)(l * 128 + s) * 128 * 256;
  _Pragma("unroll 1") for (int kvh = 0; kvh < 4; ++kvh) {
    __syncthreads();
    {
      const int d4 = (tid & 15) * 4;
      f32x4 kk[4], vv[4];
      _Pragma("unroll") for (int itr = 0; itr < 4; ++itr) { const int j = (tid >> 4) + 32 * itr;
        kk[itr] = __builtin_nontemporal_load(reinterpret_cast<const f32x4*>(ck + j * 256 + kvh * 64 + d4)); vv[itr] = __builtin_nontemporal_load(reinterpret_cast<const f32x4*>(cv + j * 256 + kvh * 64 + d4)); }
      _Pragma("unroll") for (int itr = 0; itr < 4; ++itr) { const int j = (tid >> 4) + 32 * itr;
        _Pragma("unroll") for (int q = 0; q < 4; ++q) { Kc[j * 65 + d4 + q] = kk[itr][q]; Vc[j * 65 + d4 + q] = vv[itr][q]; }
        if (j >= 1) { __builtin_nontemporal_store(kk[itr], reinterpret_cast<f32x4*>(ok + (j - 1) * 256 + kvh * 64 + d4)); __builtin_nontemporal_store(vv[itr], reinterpret_cast<f32x4*>(ov + (j - 1) * 256 + kvh * 64 + d4)); } }
    }
    if (tid < 64) { const float kn = bf2f(zr[C_AK + kvh * 64 + tid]), vn = bf2f(zr[C_AV + kvh * 64 + tid]); Kc[128 * 65 + tid] = kn; Vc[128 * 65 + tid] = vn; ok[127 * 256 + kvh * 64 + tid] = kn; ov[127 * 256 + kvh * 64 + tid] = vn; }
    if (tid < 256) qv[tid] = bf2f(zr[C_AQ + kvh * 256 + tid]);
    __syncthreads();
    const int g = tid >> 7, c = 1 + (tid & 127), qh = kvh * 4 + g;
    float dot = 0.f;
    _Pragma("unroll 1") for (int d = 0; d < 64; ++d) dot += qv[g * 64 + d] * Kc[c * 65 + d];
    const float score = dot * 0.125f + bt[(128 - c) * 16 + qh];
    float mx = score;
    for (int o = 32; o >= 1; o >>= 1) mx = fmaxf(mx, shx(mx, o, lane));
    if (lane == 0) red[w] = mx;
    __syncthreads();
    const float sink = P.sinks[l * 16 + qh];
    const float m = fmaxf(fmaxf(red[2 * g], red[2 * g + 1]), sink);
    const float e = __expf(score - m);
    float sm = e;
    for (int o = 32; o >= 1; o >>= 1) sm += shx(sm, o, lane);
    if (lane == 0) red[8 + w] = sm;
    __syncthreads();
    const float den = red[8 + 2 * g] + red[8 + 2 * g + 1] + __expf(sink - m);
    sc[g * 128 + (c - 1)] = e / den;
    __syncthreads();
    if (tid < 256) {
      const int g2 = tid >> 6, d = tid & 63; float o = 0.f;
      for (int cc = 1; cc <= 128; ++cc) o += sc[g2 * 128 + cc - 1] * Vc[cc * 65 + d];
      zr[C_AQ + (kvh * 4 + g2) * 64 + d] = f2bf(o);
    }
  }
}

DI void mixer_phase(char* shm, const Params& P, int l, int hf, int ph) {
  __shared__ int s_item;
  unsigned* ctr = (unsigned*)(optr(P.ws) + WS_CTR) + ph;
  const int nitems = 128 + 64 + 512 + (hf ? 512 : 0);
  for (;;) {
    __syncthreads();
    if (threadIdx.x == 0) s_item = (int)atomicAdd(ctr, 1u);
    __syncthreads();
    int it = s_item;
    if (it >= nitems) break;
    if (it < 128) { ssd_prompt_item(shm, P, l, hf, hf * 8 + (it >> 4), it & 15); }
    else if ((it -= 128) < 64) { ret_prompt_item(shm, P, l, hf, hf * 8 + (it >> 3), it & 7); }
    else if ((it -= 64) < 512) { att_prompt_item(shm, P, l, hf, hf * 8 + (it >> 6), (it >> 2) & 15, it & 3); }
    else if ((it -= 512) < 256) { ssd_sample_item(shm, P, l, it >> 1, it & 1); }
    else if ((it -= 256) < 128) { ret_sample_item(shm, P, l, it); }
    else { it -= 128; att_sample_item(shm, P, l, it); }
  }
}

#define SEQ0 0x87543210ull
#define LEN0 8
#define SEQ1 0x8754321ull
#define LEN1 7
constexpr int PH_G0 = 3;
constexpr int N_PHASES = PH_G0 + 2 * (LEN0 + LEN1) + 1;
#ifndef MAXPH
#define MAXPH N_PHASES
#endif
__global__ void __launch_bounds__(NT) fwd_kernel(Params P) {
  extern __shared__ __attribute__((aligned(16))) unsigned char lds[];
  char* shm = (char*)lds;
  cg::grid_group grid = cg::this_grid();
  unsigned char* ws = P.ws;
  const float* mod = (const float*)(ws + WS_MOD);
  for (int ph = P.ph_lo; ph < P.ph_hi; ++ph) {
    if (ph > P.ph_lo) grid.sync();
    if (ph == 0) { prep_phase(shm, P); continue; }
    if (ph == N_PHASES - 1) { final_norm_phase(P); continue; }
    const int q = (ph < PH_G0) ? 0 : ph - PH_G0, hf = q / (LEN0 + LEN1), qq = q % (LEN0 + LEN1), l = (qq >= LEN0) ? 1 : 0;
    const int sub = (ph == 1) ? 9 : (ph == 2) ? 10 : l ? (int)((SEQ1 >> (4 * (qq - LEN0))) & 15ull) : (int)((SEQ0 >> (4 * qq)) & 15ull);
    const int ntm = hf ? 65 : 64, RB = hf * HALF_ROWS, NV = hf ? 16512 : 16384;
    if (sub == 0) { norm_phase(P, l, hf, 0, l == 0); continue; }
    if (sub == 2) { conv_phase(P, l, hf); continue; }
    if (sub == 3) { mixer_phase(shm, P, l, hf, ph); continue; }
    if (sub == 4) { mix_phase(P, l, hf); continue; }
    Epi E{};
    const int Gd = gridDim.x;
    const int bxr = (Gd % 8 == 0) ? (int)((blockIdx.x % 8) * (Gd / 8) + blockIdx.x / 8) : (int)blockIdx.x;
    const int cw = (bxr < 41) ? 0 : (bxr < 57) ? 1 : 2;
    const bool first_res = (sub == 5 && l == 0);
    E.kind = (sub == 9) ? 3 : (sub == 10) ? 6 : (sub == 1) ? 0 : (sub == 7) ? 1 : 2;
    E.c16 = (u16*)(ws + WS_Z); E.ldc = (sub == 1) ? ZS : (sub == 10) ? (cw == 0 ? ZS : DFF) : DFF;
    E.rb = RB; E.nv = NV; E.xout = P.out; E.mod = mod; E.goff = l * 6144 + ((sub == 5) ? 2048 : 5120);
    E.res_p = first_res ? P.x_prompt : (const float*)P.out;
    E.res_s = first_res ? P.x_sample : (const float*)(P.out + (size_t)MPROMPT * D);
    E.modout = (float*)(ws + WS_MOD); E.ada_b = P.ada_b; E.shb = (u16*)(ws + WS_SHB);
    E.cout = (float*)(ws + ((cw == 0) ? WS_C1 : WS_C2 + (size_t)(cw - 1) * 144 * DFF * 4));
    E.fuse = (sub == 5 || (sub == 8 && l == 0)) ? 1 : 0;
    E.fw = (sub == 5) ? P.n2 + l * D : P.n1 + D;
    E.fsc = (sub == 5) ? l * 6144 + 4096 : 6144 + 1024;
    E.fa = (u16*)(ws + ((sub == 5) ? WS_XBC : WS_H));
    E.fss = (float*)(ws + ((sub == 5) ? WS_SS2 : WS_SS1));
    E.cons = (sub == 7 || (sub == 1 && l == 1)) ? 1 : 0;
    E.css = (const float*)(ws + ((sub == 7) ? WS_SS2 : WS_SS1));
    E.cc = (const float*)(ws + ((sub == 7) ? WS_C2 + (size_t)l * 144 * DFF * 4 : WS_C1));
    E.ccld = (sub == 7) ? DFF : ZS;
    const bf16* A = (const bf16*)(ws + ((sub == 9) ? WS_SC : (sub == 10) ? WS_SHB + (size_t)cw * 256 * D * 2 : (sub == 8) ? WS_Z : (sub == 7) ? WS_XBC : WS_H));
    const size_t boff = (sub == 9) ? WS_AWT : (sub == 10) ? (cw == 0 ? WS_WIN + (size_t)ZS * D * 2 : WS_WUP + (size_t)(cw - 1) * DFF * D * 2)
                      : (sub == 1) ? WS_WIN + (size_t)l * ZS * D * 2 : (sub == 5) ? WS_WOUT + (size_t)l * D * D * 2
                      : (sub == 7) ? WS_WUP + (size_t)l * DFF * D * 2 : WS_WDN + (size_t)l * D * DFF * 2;
    const bf16* Bt = (const bf16*)(ws + boff);
    const int K = (sub == 8) ? DFF : D;
    const int tm = (sub == 9 || sub == 10) ? 1 : ntm;
    const int tn = (sub == 9) ? 48 : (sub == 10) ? (cw == 0 ? 41 : 16) : (sub == 1) ? 41 : (sub == 7) ? 16 : 4;
    const int toff = (sub == 10) ? (cw == 0 ? 0 : cw == 1 ? 41 : 57) : 0;
    asm volatile("" : "+s"(E.xout), "+s"(E.res_p), "+s"(E.res_s), "+s"(E.mod), "+s"(A), "+s"(Bt), "+s"(E.fa), "+s"(E.fss), "+s"(E.css), "+s"(E.cc), "+s"(E.cout));
    gemm_phase(shm, A, Bt, K, tm, tn, E, (hf == 1 && sub == 8 && l == 1) ? 1 : 0, toff);
  }
}

extern "C" void kernel_launch(void* const* d_in, const int* in_sizes, int n_in, void* d_out, int out_size, void* d_ws, size_t ws_size, hipStream_t stream) {
  static int grid = 0;
  if (grid == 0) {
    if (n_in != 26 || ws_size < WS_END) { fprintf(stderr, "kernel_launch: bad inputs n_in=%d ws=%zu need %zu\n", n_in, ws_size, (size_t)WS_END); grid = -1; return; }
    int dev = 0, cus = 0, per_cu = 0;
    (void)hipGetDevice(&dev);
    (void)hipDeviceGetAttribute(&cus, hipDeviceAttributeMultiprocessorCount, dev);
    if (hipFuncSetAttribute((const void*)fwd_kernel, hipFuncAttributeMaxDynamicSharedMemorySize, LDS_BYTES) != hipSuccess) { fprintf(stderr, "hipFuncSetAttribute failed\n"); grid = -1; return; }
    (void)hipOccupancyMaxActiveBlocksPerMultiprocessor(&per_cu, (const void*)fwd_kernel, NT, LDS_BYTES);
    if (per_cu < 1) { fprintf(stderr, "occupancy query returned %d\n", per_cu); per_cu = 1; }
    (void)hipGetLastError();
    grid = cus * per_cu;
  }
  if (grid < 0) return;
  (void)hipMemsetAsync((char*)d_ws + WS_CTR, 0, 256, stream);
  Params p{};
  const float** pp = (const float**)&p;
  _Pragma("unroll") for (int i = 0; i < 26; ++i) pp[i] = (const float*)d_in[i];
  p.out = (float*)d_out; p.ws = (unsigned char*)d_ws;
#if FUSED
  p.ph_lo = 0; p.ph_hi = MAXPH;
  void* args[] = {&p};
  hipError_t e = hipLaunchCooperativeKernel((const void*)fwd_kernel, dim3(grid), dim3(NT), args, LDS_BYTES, stream);
  if (e != hipSuccess) fprintf(stderr, "cooperative launch failed: %s (grid %d)\n", hipGetErrorString(e), grid);
#else
  for (int ph = 0; ph < MAXPH; ++ph) {
    p.ph_lo = ph; p.ph_hi = ph + 1;
    hipLaunchKernelGGL(fwd_kernel, dim3(grid), dim3(NT), LDS_BYTES, stream, p);
  }
#endif
}
```

```cpp
#include <hip/hip_runtime.h>
#include <hip/hip_bf16.h>
#include <hip/hip_cooperative_groups.h>
#include <cstdio>
namespace cg = cooperative_groups;

#ifndef FUSED
#define FUSED 1
#endif

typedef unsigned short u16;
using bf16 = __hip_bfloat16;
using bf16x8 = __attribute__((ext_vector_type(8))) short;
using s16x4  = __attribute__((ext_vector_type(4))) short;
using f32x4  = __attribute__((ext_vector_type(4))) float;
using f32x16 = __attribute__((ext_vector_type(16))) float;
using u32x4  = __attribute__((ext_vector_type(4))) unsigned;
using u32x2  = __attribute__((ext_vector_type(2))) unsigned;
#define DI __device__ __forceinline__

constexpr int D = 1024, DIN = 10256, ZS = 10496, DFF = 4096;
constexpr int MPROMPT = 32768, MVALID = 32896;
constexpr int HALF_ROWS = 16384, ZROWS = 16640;
constexpr int C_AQ = 0, C_AK = 1024, C_AV = 1280, C_BQ = 1536, C_BK = 2048, C_BV = 2560, C_BG = 3584, C_CZ = 4608,
              C_CX = 5632, C_DT = 7168, C_GA = 7184, C_GB = 8208, C_GC = 9232;
constexpr int MODS = 12288;
constexpr float EPS = 1e-6f;
constexpr int NT = 512;

constexpr size_t O_YP = 0, O_YS = O_YP + 33554432, O_WKP = O_YS + 131072, O_WVP = O_WKP + 1048576, O_RETP = O_WVP + 1048576,
                 O_SSMP = O_RETP + 2097152, O_CONVP = O_SSMP + 4194304, O_WKS = O_CONVP + 147456, O_WVS = O_WKS + 8388608,
                 O_RETS = O_WVS + 8388608, O_SSMS = O_RETS + 16777216, O_CONVS = O_SSMS + 33554432;
constexpr size_t WS_CTR = 0, WS_BT = 256, WS_SC = 16384, WS_MOD = WS_SC + 524288, WS_AWT = WS_MOD + 7077888,
                 WS_WIN = WS_AWT + 25165824, WS_WOUT = WS_WIN + 42991616, WS_WUP = WS_WOUT + 4194304, WS_WDN = WS_WUP + 16777216,
                 WS_H = WS_WDN + 16777216, WS_YC = WS_H + 34078720, WS_Z = WS_YC + 34078720, WS_XBC = WS_Z + 349306880,
                 WS_DT = WS_XBC + 51118080, WS_SS1 = WS_DT + 1064960, WS_SS2 = WS_SS1 + 66560, WS_C1 = WS_SS2 + 66560,
                 WS_C2 = WS_C1 + 6045696, WS_SHB = WS_C2 + 4718592, WS_END = WS_SHB + 1572864;
constexpr int LDS_BYTES = 147456;

struct Params {
  const float *x_prompt, *x_sample, *cache_k, *cache_v, *state_ret, *state_ssm, *state_conv, *c_prompt, *c_sample, *rel, *sinks,
      *n1, *n2, *ada_w, *ada_b, *w_in, *conv_w, *conv_b, *dt_bias, *A_log, *D_skip, *snw, *w_out, *w_up, *w_down, *fnw;
  float* out; unsigned char* ws; int ph_lo, ph_hi;
};

typedef float f32x2v __attribute__((ext_vector_type(2)));
typedef __bf16 bf16x2v __attribute__((ext_vector_type(2)));
DI unsigned pack2(float a, float b) { f32x2v v = {a, b}; return __builtin_bit_cast(unsigned, __builtin_convertvector(v, bf16x2v)); }
DI u16 f2bf(float x) { return (u16)(pack2(x, 0.f) & 0xffffu); }
DI float bf2f(u16 h) { return __uint_as_float(((unsigned)h) << 16); }
DI float bfs(short h) { return __uint_as_float(((unsigned)(u16)h) << 16); }
DI bf16x8 ld8(const u16* p) { return *reinterpret_cast<const bf16x8*>(p); }
DI void st8(u16* p, bf16x8 v) { *reinterpret_cast<bf16x8*>(p) = v; }
DI bf16x8 cat4(s16x4 lo, s16x4 hi) { return __builtin_shufflevector(lo, hi, 0, 1, 2, 3, 4, 5, 6, 7); }
DI f32x16 zero16() { f32x16 v; _Pragma("unroll") for (int i = 0; i < 16; ++i) v[i] = 0.f; return v; }
DI int crow(int i, int h) { return (i & 3) + 8 * (i >> 2) + 4 * h; }
#define MFMA32(a, b, c) __builtin_amdgcn_mfma_f32_32x32x16_bf16((a), (b), (c), 0, 0, 0)
template <int S> DI bf16x8 packP(const f32x16& x) {
  u32x4 p; p[0] = pack2(x[8 * S], x[8 * S + 1]); p[1] = pack2(x[8 * S + 2], x[8 * S + 3]);
  p[2] = pack2(x[8 * S + 4], x[8 * S + 5]); p[3] = pack2(x[8 * S + 6], x[8 * S + 7]);
  return __builtin_bit_cast(bf16x8, p);
}
DI bf16x8 pack8(const float* v) {
  u32x4 p; p[0] = pack2(v[0], v[1]); p[1] = pack2(v[2], v[3]); p[2] = pack2(v[4], v[5]); p[3] = pack2(v[6], v[7]);
  return __builtin_bit_cast(bf16x8, p);
}
DI void st4bf(u16* p, float a, float b, float c, float d) { u32x2 v; v[0] = pack2(a, b); v[1] = pack2(c, d); *reinterpret_cast<u32x2*>(p) = v; }
DI float siluf(float x) { return x / (1.f + __expf(-x)); }
DI float sigmf(float x) { return 1.f / (1.f + __expf(-x)); }
DI float softplusf(float x) { return x > 20.f ? x : log1pf(expf(x)); }
DI int otid() { int t = threadIdx.x; asm volatile("" : "+v"(t)); return t; }
template <class T> DI T* optr(T* p) { asm volatile("" : "+s"(p)); return p; }
DI float shx(float v, int m, int lane) { return __int_as_float(__builtin_amdgcn_ds_bpermute((lane ^ m) << 2, __float_as_int(v))); }
DI float shup(float v, int o, int lane) { return __int_as_float(__builtin_amdgcn_ds_bpermute((lane - o) << 2, __float_as_int(v))); }
DI int modrow(int r) { return r < MPROMPT ? (r >> 11) : 16 + (r - MPROMPT); }
DI void sincos_rev(float ang, float& s, float& c) {
  float k = rintf(ang * 0.15915494309189535f);
  float red = fmaf(-k, 6.28318548202514648f, ang);
  red = fmaf(-k, -1.7484555e-7f, red);
  float fr = red * 0.15915494309189535f;
  s = __builtin_amdgcn_sinf(fr); c = __builtin_amdgcn_cosf(fr);
}

constexpr int BM = 256, BK = 64, HALFT = 128, HT = HALFT * BK;
DI int lds_byte(int r, int c) { int st = (r >> 4) * 2 + (c >> 5), rr = r & 15, cc = c & 31, ob = rr * 64 + cc * 2; return st * 1024 + (ob ^ (((ob >> 9) & 1) << 5)); }
DI void stage_rc(int b, int& R, int& C) { int st = b / 1024, sb = b % 1024, swz = sb ^ (((sb >> 9) & 1) << 5); R = (st >> 1) * 16 + swz / 64; C = (st & 1) * 32 + (swz % 64) / 2; }

struct Epi {
  int kind;
  u16* c16; int ldc;
  int rb, nv;
  const float* res_p; const float* res_s;
  float* xout;
  const float* mod; int goff;
  float* modout; const float* ada_b;
  u16* shb;
  float* cout;
  int fuse;
  const float* fw; int fsc; u16* fa; float* fss;
  int cons;
  const float* css; const float* cc; int ccld;
};

#define LAS __attribute__((address_space(3)))
constexpr int HTB = HALFT * BK * 2;
DI void epilogue(const f32x4 (&acc)[2][2][4][2], const Epi& E, int brow, int bcol, int wr, int wc, int fr, int fq, int at) {
  const int col0 = bcol + wc * 32 + fq * 8;
  const int row0 = brow + wr * 64 + fr;
  const int lane = (fq << 4) | fr;
  const bool ptile = (E.rb + brow + 255) < MPROMPT;
  const int pb = (E.rb + brow) >> 11;
#define ECOL(j) (col0 + ((j) >> 1) * HALFT + ((j) & 1) * 4)
#define EROW(g) (row0 + ((g) >> 2) * HALFT + ((g) & 3) * 16)
#define EACC(g, j) acc[(g) >> 2][(j) >> 1][(g) & 3][(j) & 1]
  if (E.kind <= 1) {
    float ssv[8]; f32x4 cv[4];
    if (E.cons) {
      _Pragma("unroll") for (int g = 0; g < 8; ++g) ssv[g] = E.css[EROW(g)];
      if (ptile) { _Pragma("unroll") for (int j = 0; j < 4; ++j) cv[j] = *reinterpret_cast<const f32x4*>(E.cc + (size_t)pb * E.ccld + ECOL(j)); }
    }
    _Pragma("unroll") for (int g = 0; g < 8; ++g) {
      const int row = EROW(g);
      float rsv = 1.f;
      if (E.cons) {
        rsv = rsqrtf(ssv[g] * (1.f / D) + EPS);
        if (!ptile) { const int mrc = min(modrow(E.rb + row), 143);
          _Pragma("unroll") for (int j = 0; j < 4; ++j) cv[j] = *reinterpret_cast<const f32x4*>(E.cc + (size_t)mrc * E.ccld + ECOL(j)); }
      }
      _Pragma("unroll") for (int jb = 0; jb < 2; ++jb) {
        float o[8];
        _Pragma("unroll") for (int n = 0; n < 2; ++n) {
          f32x4 v = EACC(g, 2 * jb + n);
          if (E.cons) v = v * rsv + cv[2 * jb + n];
          if (E.kind == 1) { _Pragma("unroll") for (int q = 0; q < 4; ++q) { const float a = fmaxf(v[q], 0.f); v[q] = a * a; } }
          _Pragma("unroll") for (int q = 0; q < 4; ++q) o[4 * n + q] = v[q];
        }
        st8(E.c16 + (size_t)row * E.ldc + ECOL(2 * jb), pack8(o));
      }
    }
  } else if (E.kind == 2) {
    if (at) {
      _Pragma("unroll") for (int g = 0; g < 8; ++g) {
        const int row = EROW(g);
        if (row < E.nv) {
          const int r = E.rb + row;
          _Pragma("unroll") for (int j = 0; j < 4; ++j) {
            const f32x4 gg = *reinterpret_cast<const f32x4*>(E.mod + (size_t)modrow(r) * MODS + E.goff + ECOL(j));
            const f32x4 v = EACC(g, j);
            float* xp = E.xout + (size_t)r * D + ECOL(j);
            _Pragma("unroll") for (int q = 0; q < 4; ++q) unsafeAtomicAdd(xp + q, gg[q] * v[q]);
          }
        }
      }
    } else {
      f32x4 g4[4], w4[4], s4[4], xc[4], xq[4];
      const float* mrow0 = E.mod + (size_t)pb * MODS;
      if (ptile) { _Pragma("unroll") for (int j = 0; j < 4; ++j) { g4[j] = *reinterpret_cast<const f32x4*>(mrow0 + E.goff + ECOL(j));
          if (E.fuse) s4[j] = *reinterpret_cast<const f32x4*>(mrow0 + E.fsc + ECOL(j)); } }
      if (E.fuse) { _Pragma("unroll") for (int j = 0; j < 4; ++j) w4[j] = *reinterpret_cast<const f32x4*>(E.fw + ECOL(j)); }
#define LOADX(g, dst) do { const int _row = EROW(g); const int _r = E.rb + _row; \
        const float* _rs = (_r < MPROMPT) ? (E.res_p + (size_t)_r * D) : (E.res_s + (size_t)(_r - MPROMPT) * D); \
        _Pragma("unroll") for (int j = 0; j < 4; ++j) dst[j] = (_row < E.nv) ? *reinterpret_cast<const f32x4*>(_rs + ECOL(j)) : (f32x4){0.f, 0.f, 0.f, 0.f}; } while (0)
      LOADX(0, xc);
      _Pragma("unroll") for (int g = 0; g < 8; ++g) {
        const int row = EROW(g); const int r = E.rb + row; const bool ok = row < E.nv;
        if (g + 1 < 8) LOADX(g + 1, xq);
        if (!ptile && ok) { const float* mr = E.mod + (size_t)modrow(r) * MODS;
          _Pragma("unroll") for (int j = 0; j < 4; ++j) { g4[j] = *reinterpret_cast<const f32x4*>(mr + E.goff + ECOL(j)); if (E.fuse) s4[j] = *reinterpret_cast<const f32x4*>(mr + E.fsc + ECOL(j)); } }
        float ssq = 0.f;
        if (ok) {
          _Pragma("unroll") for (int j = 0; j < 4; ++j) {
            const f32x4 xn = xc[j] + g4[j] * EACC(g, j);
            *reinterpret_cast<f32x4*>(E.xout + (size_t)r * D + ECOL(j)) = xn;
            if (E.fuse) {
              const f32x4 a = xn * w4[j] * (s4[j] + 1.f);
              st4bf(E.fa + (size_t)row * D + ECOL(j), a[0], a[1], a[2], a[3]);
              ssq += xn[0] * xn[0] + xn[1] * xn[1] + xn[2] * xn[2] + xn[3] * xn[3];
            }
          }
        }
        if (E.fuse) {
          ssq += shx(ssq, 16, lane); ssq += shx(ssq, 32, lane);
          if (fq == 0 && ok) unsafeAtomicAdd(E.fss + row, ssq);
        }
        _Pragma("unroll") for (int j = 0; j < 4; ++j) xc[j] = xq[j];
      }
#undef LOADX
    }
  } else if (E.kind == 3) {
    _Pragma("unroll") for (int g = 0; g < 8; ++g) {
      const int row = EROW(g);
      if (row < 144) {
        _Pragma("unroll") for (int j = 0; j < 4; ++j) {
          const int col = ECOL(j);
          const f32x4 bb = *reinterpret_cast<const f32x4*>(E.ada_b + col);
          const f32x4 o = EACC(g, j) + bb;
          *reinterpret_cast<f32x4*>(E.modout + (size_t)row * MODS + col) = o;
          const int ch = col >> 10;
          const int sl = (ch == 6) ? 0 : (ch == 3) ? 1 : (ch == 9) ? 2 : -1;
          if (sl >= 0) st4bf(E.shb + ((size_t)sl * 256 + row) * D + (col & 1023), o[0], o[1], o[2], o[3]);
        }
      }
    }
  } else {
    _Pragma("unroll") for (int g = 0; g < 8; ++g) {
      const int row = EROW(g);
      if (row < 144) { _Pragma("unroll") for (int j = 0; j < 4; ++j) *reinterpret_cast<f32x4*>(E.cout + (size_t)row * E.ldc + ECOL(j)) = EACC(g, j); }
    }
  }
#undef ECOL
#undef EROW
#undef EACC
}

DI int perm32(int rho) { const int n = rho >> 4, i = rho & 15; return 8 * (i >> 2) + 4 * n + (i & 3); }
DI void tile_of(int tile, int ntm, int ntn, int& pm, int& pn) {
  const int nig = 8 * ntn, gid = tile / nig, fm = gid * 8, gsz = min(ntm - fm, 8);
  pm = fm + ((tile % nig) % gsz); pn = (tile % nig) / gsz;
}

DI void gemm_phase(char* shm_, const bf16* __restrict__ Ag, const bf16* __restrict__ Btg, int K, int ntm, int ntn, const Epi& E, int split, int toff, int shalf) {
  LAS unsigned char* lds = (LAS unsigned char*)shm_;
  const int tid = otid(), wid = __builtin_amdgcn_readfirstlane(tid >> 6), lane = tid & 63, wr = wid >> 2, wc = wid & 3, fr = lane & 15, fq = lane >> 4;
  const int ntk = K / BK;
  const int ntmf = split ? ntm - 1 : ntm, nfull = ntmf * ntn;
  const int G = gridDim.x, ntiles = nfull + (split ? ntn * (K / 256) : 0);
  const int bxr = (G % 8 == 0) ? (int)((blockIdx.x % 8) * (G / 8) + blockIdx.x / 8) : (int)blockIdx.x;
  unsigned voffA;
  { int R, C; stage_rc(tid * 16, R, C); voffA = (unsigned)(R * K + C) * 2u; }
  const size_t istep = (size_t)64 * K * 2;
  const size_t kstep = (size_t)(BK * 2), hstep = (size_t)HALFT * K * 2, tstep = 2 * hstep;
  const unsigned ldsw = (unsigned)wid * 1024u;
  const int aoff = lds_byte(wr * 64 + fr, fq * 8), boff = lds_byte(wc * 32 + fr, fq * 8);
#define PSA(b, h) (((b) * 2 + (h)) * HTB)
#define PSB(b, h) ((4 + (b) * 2 + (h)) * HTB)
#define PSTAGE(bufoff, gbase) PSTAGEX(bufoff, gbase, voffA)
#define PSTAGEB(bufoff, gbase) PSTAGEX(bufoff, gbase, voffA)
#define PSTAGEX(bufoff, gbase, VO) do { _Pragma("unroll") for (int _i = 0; _i < 2; ++_i) \
    __builtin_amdgcn_global_load_lds((const unsigned*)((const char*)(gbase) + (size_t)_i * istep + VO), (LAS unsigned*)(lds + (bufoff) + ldsw + _i * 8192), 16, 0, 0); } while (0)
#define PLDA(dst, b, h) do { _Pragma("unroll") for (int m = 0; m < 4; ++m) _Pragma("unroll") for (int k = 0; k < 2; ++k) dst[m][k] = *(const LAS bf16x8*)(lds + PSA(b, h) + aoff + m * 2048 + k * 1024); } while (0)
#define PLDB(dst, b, h) do { _Pragma("unroll") for (int n = 0; n < 2; ++n) _Pragma("unroll") for (int k = 0; k < 2; ++k) dst[n][k] = *(const LAS bf16x8*)(lds + PSB(b, h) + boff + n * 2048 + k * 1024); } while (0)
#define PMMA(ai, bj, At, Bq) do { __builtin_amdgcn_s_setprio(1); _Pragma("unroll") for (int m = 0; m < 4; ++m) _Pragma("unroll") for (int n = 0; n < 2; ++n) _Pragma("unroll") for (int k = 0; k < 2; ++k) \
    acc[ai][bj][m][n] = __builtin_amdgcn_mfma_f32_16x16x32_bf16(Bq[n][k], At[m][k], acc[ai][bj][m][n], 0, 0, 0); __builtin_amdgcn_s_setprio(0); } while (0)
#define WAIT_V(n) asm volatile("s_waitcnt vmcnt(" #n ")" ::: "memory")
#define WAIT_L(n) asm volatile("s_waitcnt lgkmcnt(" #n ")" ::: "memory")
#define BAR __builtin_amdgcn_s_barrier()
#define SCHED __builtin_amdgcn_sched_barrier(0)
  int tile = bxr - toff;
  if (tile < 0 || tile >= ntiles) return;
#define UNIT_OF(u, PM, PN, K0, NTU, AT, HL) do { if ((u) < nfull) { tile_of((u), ntmf, ntn, PM, PN); K0 = 0; NTU = ntk; AT = 0; } \
    else { const int _s = (u) - nfull; PN = _s % ntn; PM = ntmf; K0 = (_s / ntn) * 256; NTU = 4; AT = 1; } \
    HL = (shalf && PM == ntm - 1) ? 1 : 0; } while (0)
  int pm, pn, k0, nt, at, hl; UNIT_OF(tile, pm, pn, k0, nt, at, hl);
  f32x4 acc[2][2][4][2];
  _Pragma("unroll") for (int a = 0; a < 2; ++a) _Pragma("unroll") for (int b = 0; b < 2; ++b) _Pragma("unroll") for (int m = 0; m < 4; ++m) _Pragma("unroll") for (int n = 0; n < 2; ++n) acc[a][b][m][n] = (f32x4){0.f, 0.f, 0.f, 0.f};
  bf16x8 At[4][2], B0[2][2], B1[2][2];
  const char* cA = (const char*)Ag + (size_t)pm * tstep + (size_t)k0 * 2; const char* cB = (const char*)Btg + (size_t)pn * tstep + (size_t)k0 * 2;
  PSTAGEB(PSB(0, 0), cB); PSTAGE(PSA(0, 0), cA); PSTAGEB(PSB(0, 1), cB + hstep); PSTAGE(PSA(0, 1), cA + hstep);
  if (wr == 1) BAR;
  WAIT_V(4); BAR;
  PSTAGEB(PSB(1, 0), cB + kstep); PSTAGE(PSA(1, 0), cA + kstep); PSTAGEB(PSB(1, 1), cB + hstep + kstep);
  WAIT_V(6); BAR;
  for (;;) {
    const int ntile = tile + G;
    const bool has_next = ntile < ntiles;
    int npm = pm, npn = pn, nk0 = k0, nnt = nt, nat = at, nhl = hl; if (has_next) UNIT_OF(ntile, npm, npn, nk0, nnt, nat, nhl);
    const char* nA = has_next ? (const char*)Ag + (size_t)npm * tstep + (size_t)nk0 * 2 : cA; const char* nB = has_next ? (const char*)Btg + (size_t)npn * tstep + (size_t)nk0 * 2 : cB;
#define KLOOP(SK)     for (int t = 0; t < nt; t += 2) { \
      const bool last = (t == nt - 2); \
      const char* a1 = cA + (size_t)(t + 1) * kstep; \
      const char* a2 = last ? nA : cA + (size_t)(t + 2) * kstep; const char* b2 = last ? nB : cB + (size_t)(t + 2) * kstep; \
      const char* a3 = a2 + kstep; const char* b3 = b2 + kstep; \
      PLDB(B0, 0, 0); SCHED; PLDA(At, 0, 0); PSTAGE(PSA(1, 1), a1 + hstep); \
      WAIT_L(8); BAR; WAIT_L(0); PMMA(0, 0, At, B0); BAR; SCHED; \
      PLDB(B1, 0, 1); PSTAGEB(PSB(0, 0), b2); \
      BAR; WAIT_L(0); PMMA(0, 1, At, B1); BAR; \
      PLDA(At, 0, 1); PSTAGE(PSA(0, 0), a2); \
      BAR; WAIT_L(0); if (!(SK)) PMMA(1, 0, At, B0); BAR; SCHED; \
      PSTAGEB(PSB(0, 1), b2 + hstep); \
      WAIT_V(6); BAR; if (!(SK)) PMMA(1, 1, At, B1); BAR; \
      PLDB(B0, 1, 0); SCHED; PLDA(At, 1, 0); PSTAGE(PSA(0, 1), a2 + hstep); \
      WAIT_L(8); BAR; WAIT_L(0); PMMA(0, 0, At, B0); BAR; SCHED; \
      PLDB(B1, 1, 1); PSTAGEB(PSB(1, 0), b3); \
      BAR; WAIT_L(0); PMMA(0, 1, At, B1); BAR; \
      PLDA(At, 1, 1); PSTAGE(PSA(1, 0), a3); \
      BAR; WAIT_L(0); if (!(SK)) PMMA(1, 0, At, B0); BAR; SCHED; \
      PSTAGEB(PSB(1, 1), b3 + hstep); \
      WAIT_V(6); BAR; if (!(SK)) PMMA(1, 1, At, B1); BAR; \
    }
    if (hl) { KLOOP(1) } else { KLOOP(0) }
#undef KLOOP
    epilogue(acc, E, pm * BM, pn * BM, wr, wc, fr, fq, at);
    if (!has_next) break;
    _Pragma("unroll") for (int a = 0; a < 2; ++a) _Pragma("unroll") for (int b = 0; b < 2; ++b) _Pragma("unroll") for (int m = 0; m < 4; ++m) _Pragma("unroll") for (int n = 0; n < 2; ++n) acc[a][b][m][n] = (f32x4){0.f, 0.f, 0.f, 0.f};
    tile = ntile; pm = npm; pn = npn; k0 = nk0; nt = nnt; at = nat; hl = nhl; cA = nA; cB = nB;
  }
  WAIT_V(0);
  if (wr == 0) BAR;
  BAR;
}

struct TJob { const float* src; u16* dst; int K, N, tk, tn; };
DI TJob tjob_of(const Params& P, unsigned char* ws, int job) {
  TJob J; const int l = job / 6464; int j = job % 6464;
  if (j < 2624) { J.src = P.w_in + (size_t)l * D * DIN; J.dst = (u16*)(ws + WS_WIN) + (size_t)l * ZS * D; J.K = D; J.N = DIN; J.tk = j / 164; J.tn = j % 164; }
  else if ((j -= 2624) < 256) { J.src = P.w_out + (size_t)l * D * D; J.dst = (u16*)(ws + WS_WOUT) + (size_t)l * D * D; J.K = D; J.N = D; J.tk = j / 16; J.tn = j % 16; }
  else if ((j -= 256) < 1024) { J.src = P.w_up + (size_t)l * D * DFF; J.dst = (u16*)(ws + WS_WUP) + (size_t)l * DFF * D; J.K = D; J.N = DFF; J.tk = j / 64; J.tn = j % 64; }
  else if ((j -= 1024) < 1024) { J.src = P.w_down + (size_t)l * DFF * D; J.dst = (u16*)(ws + WS_WDN) + (size_t)l * D * DFF; J.K = DFF; J.N = D; J.tk = j / 16; J.tn = j % 16; }
  else { j -= 1024; J.src = P.ada_w + (size_t)l * D * 6144; J.dst = (u16*)(ws + WS_AWT) + (size_t)l * 6144 * D; J.K = D; J.N = 6144; J.tk = j / 96; J.tn = j % 96; }
  return J;
}
DI void tjob_load(const TJob& J, int tid, f32x4 (&v)[2]) {
  const int nn = (tid & 15) * 4, n = J.tn * 64 + nn;
  _Pragma("unroll") for (int i = 0; i < 2; ++i) { const int kk = (tid >> 4) + 32 * i;
    v[i] = (n < J.N) ? *reinterpret_cast<const f32x4*>(J.src + (size_t)(J.tk * 64 + kk) * J.N + n) : (f32x4){0.f, 0.f, 0.f, 0.f}; }
}

DI void prep_phase(char* shm, const Params& P) {
  float* tl = (float*)shm;
  unsigned char* ws = optr(P.ws);
  int bx_ = blockIdx.x; asm volatile("" : "+s"(bx_));
  int G_ = gridDim.x; asm volatile("" : "+s"(G_));
  const int G = G_, bx = bx_, tid = otid();
  const int njobs = 2 * 6464;
  if (bx < njobs) {
    f32x4 v[2];
    { const TJob J0 = tjob_of(P, ws, bx); tjob_load(J0, tid, v); }
    _Pragma("unroll 1") for (int job = bx; job < njobs; job += G) {
      __syncthreads();
      { const int nn = (tid & 15) * 4; _Pragma("unroll") for (int i = 0; i < 2; ++i) { const int kk = (tid >> 4) + 32 * i;
          _Pragma("unroll") for (int q = 0; q < 4; ++q) tl[kk * 65 + nn + q] = v[i][q]; } }
      if (job + G < njobs) { const TJob Jn = tjob_of(P, ws, job + G); tjob_load(Jn, tid, v); }
      __syncthreads();
      { const TJob Jc = tjob_of(P, ws, job);
        const int nn = tid >> 3, kp = tid & 7; float o[8]; _Pragma("unroll") for (int j = 0; j < 8; ++j) o[j] = tl[(kp * 8 + j) * 65 + nn];
        const int ncol = Jc.tn * 64 + nn, c5 = ncol & 31, slot = (ncol & ~31) + 16 * ((c5 >> 2) & 1) + 4 * (c5 >> 3) + (c5 & 3);
        st8(Jc.dst + (size_t)slot * Jc.K + Jc.tk * 64 + kp * 8, pack8(o)); }
    }
  }
  { unsigned* shb = (unsigned*)(ws + WS_SHB); _Pragma("unroll 1") for (int e = bx * NT + tid; e < 3 * 256 * 1024 / 2; e += G * NT) shb[e] = 0u; }
  u16* sc = (u16*)(ws + WS_SC);
  _Pragma("unroll 1") for (int e = bx * NT + tid; e < 256 * 1024; e += G * NT) {
    int row = e >> 10, c = e & 1023; float v = 0.f;
    if (row < 16) v = siluf(P.c_prompt[row * D + c]); else if (row < 144) v = siluf(P.c_sample[(row - 16) * D + c]);
    sc[e] = f2bf(v);
  }
  if (bx == 0) {
    float* bt = (float*)(ws + WS_BT);
    for (int e = tid; e < 128 * 16; e += NT) {
      int n = e >> 4, hd = e & 15; int bk;
      if (n < 16) bk = n; else { float nf = (float)n; int lg = 16 + (int)(logf(nf / 16.f) / 2.0794415416798357f * 16.f); bk = lg < 31 ? lg : 31; }
      bt[e] = P.rel[bk * 16 + hd];
    }
  }
}

DI void norm_phase(const Params& P, int l, int hf, int which  , bool from_input) {
  const int RB = hf * HALF_ROWS, NV = hf ? 16512 : 16384, NR = hf ? 16640 : 16384;
  const int tid = otid(); const int w = tid >> 6, lane = tid & 63;
  u16* H = (u16*)(optr(P.ws) + WS_H);
  const float* mod = (const float*)(optr(P.ws) + WS_MOD);
  const float* nw = (which ? P.n2 : P.n1) + l * D;
  const int stride = gridDim.x * 8;
  f32x4 nx[4];
#define NORM_SRC(lrow) (from_input ? ((RB + (lrow)) < MPROMPT ? P.x_prompt + (size_t)(RB + (lrow)) * D : P.x_sample + (size_t)(RB + (lrow) - MPROMPT) * D) : P.out + (size_t)(RB + (lrow)) * D)
  f32x4 nsh[4], nsc[4], nw4[4];
  _Pragma("unroll") for (int k = 0; k < 4; ++k) nw4[k] = *reinterpret_cast<const f32x4*>(nw + lane * 4 + 256 * k);
#define NORM_LOAD(lrow) do { const float* _xr = NORM_SRC(lrow); const float* _mr = mod + (size_t)modrow(RB + (lrow)) * MODS + l * 6144 + which * 3072; \
    _Pragma("unroll") for (int k = 0; k < 4; ++k) { nx[k] = *reinterpret_cast<const f32x4*>(_xr + lane * 4 + 256 * k); nsh[k] = *reinterpret_cast<const f32x4*>(_mr + lane * 4 + 256 * k); nsc[k] = *reinterpret_cast<const f32x4*>(_mr + 1024 + lane * 4 + 256 * k); } } while (0)
  int lr = blockIdx.x * 8 + w;
  if (lr < NV) NORM_LOAD(lr);
  _Pragma("unroll 1") for (; lr < NR; lr += stride) {
    u16* hrow = H + (size_t)lr * D;
    if (lr >= NV) { _Pragma("unroll") for (int k = 0; k < 4; ++k) st4bf(hrow + lane * 4 + 256 * k, 0.f, 0.f, 0.f, 0.f); continue; }
    const int r = RB + lr;
    f32x4 x[4], csh[4], csc[4]; float ss = 0.f;
    _Pragma("unroll") for (int k = 0; k < 4; ++k) { x[k] = nx[k]; csh[k] = nsh[k]; csc[k] = nsc[k]; ss += x[k][0] * x[k][0] + x[k][1] * x[k][1] + x[k][2] * x[k][2] + x[k][3] * x[k][3]; }
    if (lr + stride < NV) NORM_LOAD(lr + stride);
    for (int o = 32; o >= 1; o >>= 1) ss += shx(ss, o, lane);
    const float rs = rsqrtf(ss * (1.f / D) + EPS);
    if (from_input && r >= MPROMPT) { _Pragma("unroll") for (int k = 0; k < 4; ++k) *reinterpret_cast<f32x4*>(P.out + (size_t)r * D + lane * 4 + 256 * k) = x[k]; }
    _Pragma("unroll") for (int k = 0; k < 4; ++k) {
      const int c = lane * 4 + 256 * k;
      f32x4 y = x[k] * rs * nw4[k] * (csc[k] + 1.f) + csh[k];
      st4bf(hrow + c, y[0], y[1], y[2], y[3]);
    }
  }
}

DI void final_norm_phase(const Params& P) {
  const int tid = otid(); const int w = tid >> 6, lane = tid & 63;
  const int stride = gridDim.x * 8;
  f32x4 nx[4], fw4[4];
  _Pragma("unroll") for (int k = 0; k < 4; ++k) fw4[k] = *reinterpret_cast<const f32x4*>(P.fnw + lane * 4 + 256 * k);
  int r = blockIdx.x * 8 + w;
  if (r < MVALID) { _Pragma("unroll") for (int k = 0; k < 4; ++k) nx[k] = *reinterpret_cast<const f32x4*>(P.out + (size_t)r * D + lane * 4 + 256 * k); }
  _Pragma("unroll 1") for (; r < MVALID; r += stride) {
    float* xr = P.out + (size_t)r * D;
    f32x4 x[4]; float ss = 0.f;
    _Pragma("unroll") for (int k = 0; k < 4; ++k) { x[k] = nx[k]; ss += x[k][0] * x[k][0] + x[k][1] * x[k][1] + x[k][2] * x[k][2] + x[k][3] * x[k][3]; }
    if (r + stride < MVALID) { _Pragma("unroll") for (int k = 0; k < 4; ++k) nx[k] = *reinterpret_cast<const f32x4*>(P.out + (size_t)(r + stride) * D + lane * 4 + 256 * k); }
    for (int o = 32; o >= 1; o >>= 1) ss += shx(ss, o, lane);
    const float rs = rsqrtf(ss * (1.f / D) + EPS);
    _Pragma("unroll") for (int k = 0; k < 4; ++k) { const int c = lane * 4 + 256 * k; *reinterpret_cast<f32x4*>(xr + c) = x[k] * rs * fw4[k]; }
  }
}

DI void conv_phase(const Params& P, int l, int hf) {
  const int tid = otid();
  const u16* Z = (const u16*)(optr(P.ws) + WS_Z);
  u16* XBC = (u16*)(optr(P.ws) + WS_XBC);
  float* DT = (float*)(optr(P.ws) + WS_DT);
  const float* cw = P.conv_w + (size_t)l * 4 * 1536;
  const float* cb = P.conv_b + (size_t)l * 1536;
  const int nstrips = 16384 / 32;
  for (int sp = blockIdx.x * 2; sp < nstrips; sp += gridDim.x * 2) {
    if (tid < 384) {
      const int part = tid % 192, strip = sp + tid / 192, ch0 = part * 8;
      const int lr0 = strip * 32;
      float w[4][8], bias[8];
      _Pragma("unroll") for (int i = 0; i < 4; ++i) { const f32x4 a = *reinterpret_cast<const f32x4*>(cw + i * 1536 + ch0), b = *reinterpret_cast<const f32x4*>(cw + i * 1536 + ch0 + 4);
        _Pragma("unroll") for (int j = 0; j < 4; ++j) { w[i][j] = a[j]; w[i][4 + j] = b[j]; } }
      { const f32x4 a = *reinterpret_cast<const f32x4*>(cb + ch0), b = *reinterpret_cast<const f32x4*>(cb + ch0 + 4);
        _Pragma("unroll") for (int j = 0; j < 4; ++j) { bias[j] = a[j]; bias[4 + j] = b[j]; } }
      bf16x8 h0, h1, h2;
      const u16* zp = Z + (size_t)lr0 * ZS + C_CX + ch0;
      if ((lr0 & 2047) == 0) { _Pragma("unroll") for (int j = 0; j < 8; ++j) { h0[j] = 0; h1[j] = 0; h2[j] = 0; } }
      else { h0 = ld8(zp - 3 * (size_t)ZS); h1 = ld8(zp - 2 * (size_t)ZS); h2 = ld8(zp - (size_t)ZS); }
      u16* xo = XBC + (size_t)lr0 * 1536 + ch0;
      _Pragma("unroll 1") for (int rb = 0; rb < 32; rb += 8) {
        bf16x8 cur[8];
        _Pragma("unroll") for (int k = 0; k < 8; ++k) cur[k] = ld8(zp + (size_t)(rb + k) * ZS);
        _Pragma("unroll") for (int k = 0; k < 8; ++k) {
          float a[8];
          _Pragma("unroll") for (int j = 0; j < 8; ++j) a[j] = siluf(bias[j] + w[0][j] * bfs(h0[j]) + w[1][j] * bfs(h1[j]) + w[2][j] * bfs(h2[j]) + w[3][j] * bfs(cur[k][j]));
          st8(xo + (size_t)(rb + k) * 1536, pack8(a));
          h0 = h1; h1 = h2; h2 = cur[k];
        }
      }
    } else {
      const int t = tid - 384;
      u16 zv[8];
      _Pragma("unroll") for (int k = 0; k < 8; ++k) { const int u = t + 128 * k; zv[k] = Z[(size_t)(sp * 32 + (u >> 4)) * ZS + C_DT + (u & 15)]; }
      const float dtb = P.dt_bias[l * 16 + (t & 15)];
      _Pragma("unroll") for (int k = 0; k < 8; ++k) { const int u = t + 128 * k; DT[(size_t)(sp * 32 + (u >> 4)) * 16 + (u & 15)] = softplusf(bf2f(zv[k]) + dtb); }
    }
  }
}

DI void mix_phase(const Params& P, int l, int hf) {
  const int NV = hf ? 16512 : 16384, NR = hf ? 16640 : 16384;
  const int tid = otid(); const int w = tid >> 6, lane = tid & 63;
  u16* H = (u16*)(optr(P.ws) + WS_H);
  const u16* Z = (const u16*)(optr(P.ws) + WS_Z);
  const u16* YC = (const u16*)(optr(P.ws) + WS_YC);
  const float* snw = P.snw + l * D;
  bf16x8 nob[2], ny[2], ncz[2], noa[2], nbg[2], nga[2], ngb[2], ngc[2];
#define MIX_LOAD(row) do { const u16* zr = Z + (size_t)(row) * ZS + lane * 8; const u16* yr = YC + (size_t)(row) * D + lane * 8; \
    _Pragma("unroll") for (int k = 0; k < 2; ++k) { \
      nob[k] = ld8(zr + C_BV + 512 * k); ny[k] = ld8(yr + 512 * k); ncz[k] = ld8(zr + C_CZ + 512 * k); noa[k] = ld8(zr + C_AQ + 512 * k); \
      nbg[k] = ld8(zr + C_BG + 512 * k); nga[k] = ld8(zr + C_GA + 512 * k); ngb[k] = ld8(zr + C_GB + 512 * k); ngc[k] = ld8(zr + C_GC + 512 * k); } } while (0)
  const int stride = gridDim.x * 8;
  f32x4 snv[2][2];
  _Pragma("unroll") for (int k = 0; k < 2; ++k) { snv[k][0] = *reinterpret_cast<const f32x4*>(snw + lane * 8 + 512 * k); snv[k][1] = *reinterpret_cast<const f32x4*>(snw + lane * 8 + 512 * k + 4); }
  int lr = blockIdx.x * 8 + w;
  if (lr < NV) MIX_LOAD(lr);
  float* SS1 = (float*)(optr(P.ws) + WS_SS1); float* SS2 = (float*)(optr(P.ws) + WS_SS2);
  _Pragma("unroll 1") for (; lr < NR; lr += stride) {
    u16* hrow = H + (size_t)lr * D + lane * 8;
    if (lane == 0) { SS1[lr] = 0.f; SS2[lr] = 0.f; }
    if (lr >= NV) { _Pragma("unroll") for (int k = 0; k < 2; ++k) { st4bf(hrow + 512 * k, 0.f, 0.f, 0.f, 0.f); st4bf(hrow + 512 * k + 4, 0.f, 0.f, 0.f, 0.f); } continue; }
    bf16x8 vob[2], vy[2], vcz[2], voa[2], vbg[2], vga[2], vgb[2], vgc[2];
    _Pragma("unroll") for (int k = 0; k < 2; ++k) { vob[k] = nob[k]; vy[k] = ny[k]; vcz[k] = ncz[k]; voa[k] = noa[k]; vbg[k] = nbg[k]; vga[k] = nga[k]; vgb[k] = ngb[k]; vgc[k] = ngc[k]; }
    if (lr + stride < NV) MIX_LOAD(lr + stride);
    _Pragma("unroll") for (int k = 0; k < 2; ++k) {
      float ob[8], yg[8], so = 0.f, sy = 0.f;
      _Pragma("unroll") for (int j = 0; j < 8; ++j) { float o = bfs(vob[k][j]); ob[j] = o; so += o * o; float t = bfs(vy[k][j]) * siluf(bfs(vcz[k][j])); yg[j] = t; sy += t * t; }
      so += shx(so, 1, lane); so += shx(so, 2, lane); so += shx(so, 4, lane); so += shx(so, 8, lane);
      for (int o = 32; o >= 1; o >>= 1) sy += shx(sy, o, lane);
      const float ro = rsqrtf(so * (1.f / 128.f) + EPS), ry = rsqrtf(sy * (1.f / 512.f) + EPS);
      float m[8];
      const f32x4 s0 = snv[k][0], s1 = snv[k][1];
      _Pragma("unroll") for (int j = 0; j < 8; ++j) {
        const float obn = ob[j] * ro * siluf(bfs(vbg[k][j]));
        const float ocn = yg[j] * ry * (j < 4 ? s0[j & 3] : s1[j & 3]);
        m[j] = sigmf(bfs(vga[k][j])) * bfs(voa[k][j]) + sigmf(bfs(vgb[k][j])) * obn + sigmf(bfs(vgc[k][j])) * ocn;
      }
      st8(hrow + 512 * k, pack8(m));
    }
  }
}

DI void att_prompt_item(char* shm, const Params& P, int l, int hf, int b, int blk, int kvh) {
  u16* Ks = (u16*)shm;
  u16* Vt = Ks + 256 * 72;
  float* bias = (float*)(Vt + 64 * 268);
  u16* Z = (u16*)(optr(P.ws) + WS_Z);
  const float* bt = (const float*)(optr(P.ws) + WS_BT);
  const int tid = otid(), lane = tid & 63, w = tid >> 6;
  const int lr0 = b * 2048 + blk * 128 - hf * HALF_ROWS;
  const int g = w >> 1, qh = kvh * 4 + g, r = lane & 31, h = lane >> 5;
  bf16x8 qall[2][4];
  _Pragma("unroll") for (int qq = 0; qq < 2; ++qq) { const u16* qp = Z + (size_t)(lr0 + ((w & 1) * 2 + qq) * 32 + r) * ZS + C_AQ + qh * 64;
    _Pragma("unroll") for (int s = 0; s < 4; ++s) qall[qq][s] = ld8(qp + 16 * s + 8 * h); }
  const float sink = P.sinks[l * 16 + qh];
  const float btv = bt[(tid & 127) * 16 + kvh * 4 + (tid >> 7)];
  __syncthreads();
  {
    bf16x8 kr[4], vr[4];
    _Pragma("unroll") for (int it = 0; it < 4; ++it) { const int c = tid + it * NT, key = c >> 3, part = c & 7;
      if (blk > 0 || key >= 128) { const u16* src = Z + (size_t)(lr0 - 128 + key) * ZS; kr[it] = ld8(src + C_AK + kvh * 64 + part * 8); vr[it] = ld8(src + C_AV + kvh * 64 + part * 8); }
      else { _Pragma("unroll") for (int j = 0; j < 8; ++j) { kr[it][j] = 0; vr[it][j] = 0; } } }
    _Pragma("unroll") for (int it = 0; it < 4; ++it) { const int c = tid + it * NT, key = c >> 3, part = c & 7;
      st8(Ks + key * 72 + part * 8, kr[it]);
      _Pragma("unroll") for (int jj = 0; jj < 8; ++jj) Vt[(part * 8 + jj) * 268 + key] = (u16)vr[it][jj]; }
  }
  { const int g3 = tid >> 7, dist = tid & 127; bias[g3 * 192 + 32 + dist] = btv * 1.4426950408889634f;
    if (tid < 256) { const int g2 = tid >> 6, k = tid & 63; bias[g2 * 192 + (k < 32 ? k : 128 + k)] = 0.f; } }
  __syncthreads();
  _Pragma("unroll") for (int qq = 0; qq < 2; ++qq) {
    const int qt = (w & 1) * 2 + qq, qi = qt * 32 + r;
    u16* qrow = Z + (size_t)(lr0 + qi) * ZS + C_AQ + qh * 64;
    bf16x8 qf[4];
    _Pragma("unroll") for (int s = 0; s < 4; ++s) qf[s] = qall[qq][s];
    f32x16 O0 = zero16(), O1 = zero16();
    float m = sink * 1.4426950408889634f, lsum = 1.f;
    const int kt0 = (blk == 0) ? 4 : qt;
    _Pragma("unroll 1") for (int kt = kt0; kt <= qt + 4; ++kt) {
      f32x16 S = zero16();
      _Pragma("unroll") for (int s = 0; s < 4; ++s) { const bf16x8 kf = ld8(Ks + (kt * 32 + r) * 72 + 16 * s + 8 * h); S = MFMA32(kf, qf[s], S); }
      const float* bp = bias + g * 192 + 32 + (qi - 32 * kt + 128 - 4 * h);
      float mloc = -INFINITY;
      _Pragma("unroll") for (int i = 0; i < 16; ++i) S[i] = fmaf(S[i], 0.125f * 1.4426950408889634f, bp[-((i & 3) + 8 * (i >> 2))]);
      if (kt == qt) { _Pragma("unroll") for (int i = 0; i < 16; ++i) S[i] = (crow(i, h) > r) ? S[i] : -INFINITY; }
      if (kt == qt + 4) { _Pragma("unroll") for (int i = 0; i < 16; ++i) S[i] = (crow(i, h) <= r) ? S[i] : -INFINITY; }
      _Pragma("unroll") for (int i = 0; i < 16; ++i) mloc = fmaxf(mloc, S[i]);
      mloc = fmaxf(mloc, shx(mloc, 32, lane));
      const float mnew = fmaxf(m, mloc), alpha = __builtin_amdgcn_exp2f(m - mnew);
      float ps = 0.f;
      _Pragma("unroll") for (int i = 0; i < 16; ++i) { const float p = __builtin_amdgcn_exp2f(S[i] - mnew); S[i] = p; ps += p; }
      ps += shx(ps, 32, lane);
      lsum = lsum * alpha + ps; m = mnew;
      _Pragma("unroll") for (int i = 0; i < 16; ++i) { O0[i] *= alpha; O1[i] *= alpha; }
      const bf16x8 p0 = packP<0>(S), p1 = packP<1>(S);
      { const u16* vp = Vt + (r) * 268 + kt * 32 + 4 * h;
        O0 = MFMA32(cat4(*(const s16x4*)vp, *(const s16x4*)(vp + 8)), p0, O0);
        O0 = MFMA32(cat4(*(const s16x4*)(vp + 16), *(const s16x4*)(vp + 24)), p1, O0); }
      { const u16* vp = Vt + (32 + r) * 268 + kt * 32 + 4 * h;
        O1 = MFMA32(cat4(*(const s16x4*)vp, *(const s16x4*)(vp + 8)), p0, O1);
        O1 = MFMA32(cat4(*(const s16x4*)(vp + 16), *(const s16x4*)(vp + 24)), p1, O1); }
    }
    const float inv = 1.f / lsum;
    _Pragma("unroll") for (int gq = 0; gq < 4; ++gq) {
      st4bf(qrow + 8 * gq + 4 * h, O0[4 * gq] * inv, O0[4 * gq + 1] * inv, O0[4 * gq + 2] * inv, O0[4 * gq + 3] * inv);
      st4bf(qrow + 32 + 8 * gq + 4 * h, O1[4 * gq] * inv, O1[4 * gq + 1] * inv, O1[4 * gq + 2] * inv, O1[4 * gq + 3] * inv);
    }
  }
  if (blk == 15) {
    float* wk = P.out + O_WKP + (size_t)(l * 16 + b) * 128 * 256 + kvh * 64;
    float* wv = P.out + O_WVP + (size_t)(l * 16 + b) * 128 * 256 + kvh * 64;
    for (int idx = tid; idx < 128 * 64; idx += NT) { const int j = idx >> 6, d = idx & 63; wk[j * 256 + d] = bf2f(Ks[(128 + j) * 72 + d]); wv[j * 256 + d] = bf2f(Vt[d * 268 + 128 + j]); }
  }
}

DI void ret_prompt_item(char* shm, const Params& P, int l, int hf, int b, int hd) {
  u16* QQ = (u16*)shm;
  u16* KK = QQ + 128 * 72;
  u16* KKt = KK + 128 * 72;
  u16* Vt = KKt + 64 * 136;
  u16* St = Vt + 128 * 136;
  float* th = (float*)(St + 128 * 72);
  u16* Z = (u16*)(optr(P.ws) + WS_Z);
  const int tid = otid(), lane = tid & 63, w = tid >> 6, r = lane & 31, hh = lane >> 5;
  const float log2g = log2f(1.f - exp2f(-5.f - (float)hd));
  const float g128 = exp2f(log2g * 128.f);
  __syncthreads();
  for (int e = tid; e < 128 * 72; e += NT) St[e] = 0;
  if (tid < 32) th[tid] = 1.f / powf(10000.f, (float)tid / 31.f);
  f32x16 Sacc = zero16();
  const int lt = w & 3, eh = w >> 2;
  bf16x8 qv[2], kv[2], vv[4];
#define RET_ISSUE(cc) do { const int _lr = b * 2048 + (cc) * 128 - hf * HALF_ROWS; \
    _Pragma("unroll") for (int it = 0; it < 2; ++it) { const int idx = tid + it * NT, row = idx & 127, part = idx >> 7; \
      const u16* zr = Z + (size_t)(_lr + row) * ZS; qv[it] = ld8(zr + C_BQ + hd * 64 + part * 8); kv[it] = ld8(zr + C_BK + hd * 64 + part * 8); } \
    _Pragma("unroll") for (int it = 0; it < 4; ++it) { const int idx = tid + it * NT, row = idx & 127, part = idx >> 7; \
      vv[it] = ld8(Z + (size_t)(_lr + row) * ZS + C_BV + hd * 128 + part * 8); } } while (0)
  RET_ISSUE(0);
  _Pragma("unroll 1") for (int c = 0; c < 16; ++c) {
    const int tok0 = c * 128;
    const int lrow0 = b * 2048 + tok0 - hf * HALF_ROWS;
    __syncthreads();
    {
      _Pragma("unroll") for (int it = 0; it < 2; ++it) {
        const int idx = tid + it * NT, row = idx & 127, part = idx >> 7;
        const float pos = (float)(tok0 + row);
        const float gq = exp2f(log2g * (float)(row + 1)), gk = 0.125f * exp2f(-log2g * (float)(row + 1));
        float qo[8], ko[8];
        _Pragma("unroll") for (int pr = 0; pr < 4; ++pr) {
          float sn, cs; sincos_rev(pos * th[part * 4 + pr], sn, cs);
          const float q1 = bfs(qv[it][2 * pr]), q2 = bfs(qv[it][2 * pr + 1]), k1 = bfs(kv[it][2 * pr]), k2 = bfs(kv[it][2 * pr + 1]);
          qo[2 * pr] = (q1 * cs - q2 * sn) * gq; qo[2 * pr + 1] = (q1 * sn + q2 * cs) * gq;
          ko[2 * pr] = (k1 * cs - k2 * sn) * gk; ko[2 * pr + 1] = (k1 * sn + k2 * cs) * gk;
        }
        st8(QQ + row * 72 + part * 8, pack8(qo));
        st8(KK + row * 72 + part * 8, pack8(ko));
        _Pragma("unroll") for (int jj = 0; jj < 8; ++jj) KKt[(part * 8 + jj) * 136 + row] = f2bf(ko[jj]);
      }
      _Pragma("unroll") for (int it = 0; it < 4; ++it) { const int idx = tid + it * NT, row = idx & 127, part = idx >> 7;
        _Pragma("unroll") for (int jj = 0; jj < 8; ++jj) Vt[(part * 8 + jj) * 136 + row] = (u16)vv[it][jj]; }
    }
    if (c + 1 < 16) RET_ISSUE(c + 1);
    __syncthreads();
    bf16x8 qf[4];
    _Pragma("unroll") for (int s = 0; s < 4; ++s) qf[s] = ld8(QQ + (lt * 32 + r) * 72 + 16 * s + 8 * hh);
    f32x16 O0 = zero16(), O1 = zero16();
    _Pragma("unroll") for (int s = 0; s < 4; ++s) {
      O0 = MFMA32(ld8(St + ((2 * eh) * 32 + r) * 72 + 16 * s + 8 * hh), qf[s], O0);
      O1 = MFMA32(ld8(St + ((2 * eh + 1) * 32 + r) * 72 + 16 * s + 8 * hh), qf[s], O1);
    }
    _Pragma("unroll 1") for (int mk = 0; mk <= lt; ++mk) {
      f32x16 Aa = zero16();
      _Pragma("unroll") for (int s = 0; s < 4; ++s) Aa = MFMA32(ld8(KK + (mk * 32 + r) * 72 + 16 * s + 8 * hh), qf[s], Aa);
      if (mk == lt) _Pragma("unroll") for (int i = 0; i < 16; ++i) if (crow(i, hh) > r) Aa[i] = 0.f;
      const bf16x8 p0 = packP<0>(Aa), p1 = packP<1>(Aa);
      { const u16* vp = Vt + ((2 * eh) * 32 + r) * 136 + mk * 32 + 4 * hh;
        O0 = MFMA32(cat4(*(const s16x4*)vp, *(const s16x4*)(vp + 8)), p0, O0);
        O0 = MFMA32(cat4(*(const s16x4*)(vp + 16), *(const s16x4*)(vp + 24)), p1, O0); }
      { const u16* vp = Vt + ((2 * eh + 1) * 32 + r) * 136 + mk * 32 + 4 * hh;
        O1 = MFMA32(cat4(*(const s16x4*)vp, *(const s16x4*)(vp + 8)), p0, O1);
        O1 = MFMA32(cat4(*(const s16x4*)(vp + 16), *(const s16x4*)(vp + 24)), p1, O1); }
    }
    { u16* orow = Z + (size_t)(lrow0 + lt * 32 + r) * ZS + C_BV + hd * 128 + (2 * eh) * 32;
      _Pragma("unroll") for (int gq = 0; gq < 4; ++gq) {
        st4bf(orow + 8 * gq + 4 * hh, O0[4 * gq], O0[4 * gq + 1], O0[4 * gq + 2], O0[4 * gq + 3]);
        st4bf(orow + 32 + 8 * gq + 4 * hh, O1[4 * gq], O1[4 * gq + 1], O1[4 * gq + 2], O1[4 * gq + 3]);
      } }
    _Pragma("unroll") for (int s = 0; s < 8; ++s)
      Sacc = MFMA32(ld8(Vt + (lt * 32 + r) * 136 + 16 * s + 8 * hh), ld8(KKt + (eh * 32 + r) * 136 + 16 * s + 8 * hh), Sacc);
    _Pragma("unroll") for (int i = 0; i < 16; ++i) Sacc[i] *= g128;
    __syncthreads();
    _Pragma("unroll") for (int i = 0; i < 16; ++i) St[(lt * 32 + crow(i, hh)) * 72 + eh * 32 + r] = f2bf(Sacc[i]);
  }
  float* so = P.out + O_RETP + (size_t)((l * 16 + b) * 8 + hd) * 8192 + (size_t)(eh * 32 + r) * 128 + lt * 32;
  _Pragma("unroll") for (int gq = 0; gq < 4; ++gq) *reinterpret_cast<f32x4*>(so + 8 * gq + 4 * hh) = (f32x4){Sacc[4 * gq], Sacc[4 * gq + 1], Sacc[4 * gq + 2], Sacc[4 * gq + 3]};
}

DI void ssd_prompt_item(char* shm, const Params& P, int l, int hf, int b, int hc) {
  u16* Bm = (u16*)shm;
  u16* Cm = Bm + 128 * 136;
  u16* Xs = Cm + 128 * 136;
  u16* XwT = Xs + 64 * 136;
  u16* Hs = XwT + 64 * 136;
  float* acum = (float*)(Hs + 64 * 136);
  float* dtv = acum + 128;
  float* tot = dtv + 128;
  const u16* Z = (const u16*)(optr(P.ws) + WS_Z);
  u16* YC = (u16*)(optr(P.ws) + WS_YC);
  const u16* XBC = (const u16*)(optr(P.ws) + WS_XBC);
  const float* DT = (const float*)(optr(P.ws) + WS_DT);
  const int tid = otid(), lane = tid & 63, w = tid >> 6, r = lane & 31, hh = lane >> 5;
  const int g = hc >> 3;
  const float Aneg = -expf(P.A_log[l * 16 + hc]), dtb = P.dt_bias[l * 16 + hc], dsk = P.D_skip[l * 16 + hc];
  const float* cw = P.conv_w + (size_t)l * 4 * 1536;
  const float* cb = P.conv_b + (size_t)l * 1536;
  const int lrowb = b * 2048 - hf * HALF_ROWS;
  __syncthreads();
  for (int e = tid; e < 64 * 136; e += NT) Hs[e] = 0;
  f32x16 Hacc = zero16();
  const int pt = w >> 2, it = w & 3;
  bf16x8 pB[4], pC[4], pX[2]; float pdt = 0.f;
#define SSD_ISSUE(cc) do { const int _t0 = (cc) * 128; \
    _Pragma("unroll") for (int itr = 0; itr < 4; ++itr) { const int idx = tid + itr * NT, row = idx >> 4, part = idx & 15; \
      const u16* _p = XBC + (size_t)(lrowb + _t0 + row) * 1536 + g * 128 + part * 8; pB[itr] = ld8(_p + 1024); pC[itr] = ld8(_p + 1280); } \
    _Pragma("unroll") for (int itr = 0; itr < 2; ++itr) { const int idx = tid + itr * NT, row = idx & 127, part = idx >> 7; \
      pX[itr] = ld8(XBC + (size_t)(lrowb + _t0 + row) * 1536 + hc * 64 + part * 8); } \
    if (tid < 128) pdt = DT[(size_t)(lrowb + _t0 + tid) * 16 + hc]; } while (0)
  SSD_ISSUE(0);
  _Pragma("unroll 1") for (int c = 0; c < 16; ++c) {
    const int tok0 = c * 128;
    bf16x8 xr[2]; xr[0] = pX[0]; xr[1] = pX[1];
    if (tid < 128) {
      const float dt = pdt;
      float v = dt * Aneg;
      for (int o = 1; o < 64; o <<= 1) { const float t = shup(v, o, lane); if (lane >= o) v += t; }
      dtv[tid] = dt; acum[tid] = v;
      if (tid == 63) tot[0] = v;
    }
    _Pragma("unroll") for (int itr = 0; itr < 4; ++itr) { const int idx = tid + itr * NT, row = idx >> 4, part = idx & 15;
      st8(Bm + row * 136 + part * 8, pB[itr]); st8(Cm + row * 136 + part * 8, pC[itr]); }
    __syncthreads();
    if (tid >= 64 && tid < 128) acum[tid] += tot[0];
    __syncthreads();
    const float alast = acum[127];
    _Pragma("unroll") for (int itr = 0; itr < 2; ++itr) {
      const int idx = tid + itr * NT, row = idx & 127, part = idx >> 7;
      const float wj = __expf(alast - acum[row]) * dtv[row];
      _Pragma("unroll") for (int j = 0; j < 8; ++j) { const float xs = bfs(xr[itr][j]); Xs[(part * 8 + j) * 136 + row] = (u16)xr[itr][j]; XwT[(part * 8 + j) * 136 + row] = f2bf(xs * wj); }
    }
    if (c + 1 < 16) SSD_ISSUE(c + 1);
    __syncthreads();
    const u16* cfp = Cm + (it * 32 + r) * 136 + 8 * hh;
    f32x16 Y = zero16();
    _Pragma("unroll") for (int s = 0; s < 8; ++s) Y = MFMA32(ld8(Hs + (pt * 32 + r) * 136 + 16 * s + 8 * hh), ld8(cfp + 16 * s), Y);
    const float ai = acum[it * 32 + r];
    { const float ea = __expf(ai); _Pragma("unroll") for (int i = 0; i < 16; ++i) Y[i] *= ea; }
    _Pragma("unroll 1") for (int jt = 0; jt <= it; ++jt) {
      f32x16 Gm = zero16();
      _Pragma("unroll") for (int s = 0; s < 8; ++s) Gm = MFMA32(ld8(Bm + (jt * 32 + r) * 136 + 16 * s + 8 * hh), ld8(cfp + 16 * s), Gm);
      _Pragma("unroll") for (int i = 0; i < 16; ++i) {
        const int jl = crow(i, hh), j = jt * 32 + jl;
        const float v = Gm[i] * __expf(ai - acum[j]) * dtv[j];
        Gm[i] = (jt == it && jl > r) ? 0.f : v;
      }
      const bf16x8 p0 = packP<0>(Gm), p1 = packP<1>(Gm);
      const u16* xp = Xs + (pt * 32 + r) * 136 + jt * 32 + 4 * hh;
      Y = MFMA32(cat4(*(const s16x4*)xp, *(const s16x4*)(xp + 8)), p0, Y);
      Y = MFMA32(cat4(*(const s16x4*)(xp + 16), *(const s16x4*)(xp + 24)), p1, Y);
    }
    _Pragma("unroll") for (int i = 0; i < 16; ++i) Y[i] += dsk * bf2f(Xs[(pt * 32 + crow(i, hh)) * 136 + it * 32 + r]);
    { u16* yrow = YC + (size_t)(lrowb + tok0 + it * 32 + r) * D + hc * 64 + pt * 32;
      _Pragma("unroll") for (int gq = 0; gq < 4; ++gq) st4bf(yrow + 8 * gq + 4 * hh, Y[4 * gq], Y[4 * gq + 1], Y[4 * gq + 2], Y[4 * gq + 3]); }
    { const float dl = __expf(alast); _Pragma("unroll") for (int i = 0; i < 16; ++i) Hacc[i] *= dl; }
    _Pragma("unroll") for (int s = 0; s < 8; ++s) {
      const bf16x8 xf = ld8(XwT + (pt * 32 + r) * 136 + 16 * s + 8 * hh);
      const u16* bp = Bm + (16 * s + 8 * hh) * 136 + it * 32 + r;
      u32x4 pb;
      _Pragma("unroll") for (int q = 0; q < 4; ++q) pb[q] = (unsigned)bp[(2 * q) * 136] | ((unsigned)bp[(2 * q + 1) * 136] << 16);
      Hacc = MFMA32(xf, __builtin_bit_cast(bf16x8, pb), Hacc);
    }
    __syncthreads();
    _Pragma("unroll") for (int i = 0; i < 16; ++i) Hs[(pt * 32 + crow(i, hh)) * 136 + it * 32 + r] = f2bf(Hacc[i]);
  }
  { float* ho = P.out + O_SSMP + (size_t)((l * 16 + b) * 16 + hc) * 8192;
    _Pragma("unroll") for (int i = 0; i < 16; ++i) ho[(pt * 32 + crow(i, hh)) * 128 + it * 32 + r] = Hacc[i]; }
  { float* co = P.out + O_CONVP + (size_t)(l * 16 + b) * 3 * 1536;
    for (int e = tid; e < 3 * 64; e += NT) { const int i = e >> 6, ch = hc * 64 + (e & 63); co[i * 1536 + ch] = bf2f(Z[(size_t)(lrowb + 2045 + i) * ZS + C_CX + ch]); }
    if ((hc & 7) == 0) for (int e = tid; e < 3 * 256; e += NT) { const int i = e >> 8, q = e & 255; const int ch = (q < 128 ? 1024 : 1280 - 128) + g * 128 + q; co[i * 1536 + ch] = bf2f(Z[(size_t)(lrowb + 2045 + i) * ZS + C_CX + ch]); } }
}

DI void ssd_sample_item(char* shm, const Params& P, int l, int s, int g) {
  float* xs = (float*)shm;
  float* Bs = xs + 512;
  float* Cs = Bs + 128;
  float* dts = Cs + 128;
  const int tid = otid(), lane = tid & 63, w = tid >> 6;
  const int lr = MPROMPT + s - HALF_ROWS;
  const u16* zr = (const u16*)(optr(P.ws) + WS_Z) + (size_t)lr * ZS;
  u16* YC = (u16*)(optr(P.ws) + WS_YC) + (size_t)lr * D;
  const float* cw = P.conv_w + (size_t)l * 4 * 1536;
  const float* cb = P.conv_b + (size_t)l * 1536;
  const float* hist = P.state_conv + (size_t)(l * 128 + s) * 3 * 1536;
  float* cso = P.out + O_CONVS + (size_t)(l * 128 + s) * 3 * 1536;
  __syncthreads();
  for (int u = tid; u < 768; u += NT) {
    int ch; float* dst;
    if (u < 512) { ch = g * 512 + u; dst = xs + u; } else if (u < 640) { ch = 1024 + g * 128 + (u - 512); dst = Bs + (u - 512); } else { ch = 1280 + g * 128 + (u - 640); dst = Cs + (u - 640); }
    const float h0 = hist[ch], h1 = hist[1536 + ch], h2 = hist[2 * 1536 + ch], nw = bf2f(zr[C_CX + ch]);
    const float a = cb[ch] + cw[ch] * h0 + cw[1536 + ch] * h1 + cw[2 * 1536 + ch] * h2 + cw[3 * 1536 + ch] * nw;
    *dst = siluf(a);
    cso[ch] = h1; cso[1536 + ch] = h2; cso[2 * 1536 + ch] = nw;
  }
  if (tid < 8) { const int hc = g * 8 + tid; const float dt = softplusf(bf2f(zr[C_DT + hc]) + P.dt_bias[l * 16 + hc]); dts[tid] = dt; dts[8 + tid] = expf(dt * -expf(P.A_log[l * 16 + hc])); }
  __syncthreads();
  const int hc = g * 8 + w;
  const float dt = dts[w], dA = dts[8 + w], dsk = P.D_skip[l * 16 + hc];
  const float* hin = P.state_ssm + (size_t)((l * 128 + s) * 16 + hc) * 8192;
  float* hout = P.out + O_SSMS + (size_t)((l * 128 + s) * 16 + hc) * 8192;
  const int n4 = (lane & 31) * 4, psub = lane >> 5;
  const f32x4 Bv = *reinterpret_cast<const f32x4*>(Bs + n4), Cv = *reinterpret_cast<const f32x4*>(Cs + n4);
  {
    const int ib = 0;
    f32x4 hv[32];
    _Pragma("unroll") for (int k = 0; k < 32; ++k) hv[k] = __builtin_nontemporal_load(reinterpret_cast<const f32x4*>(hin + (k * 2 + psub) * 128 + n4));
    _Pragma("unroll") for (int k = 0; k < 32; ++k) {
      const int p = (ib * 16 + k) * 2 + psub;
      const float xv = xs[w * 64 + p];
      const f32x4 hn = hv[k] * dA + Bv * (dt * xv);
      __builtin_nontemporal_store(hn, reinterpret_cast<f32x4*>(hout + p * 128 + n4));
      float y = hn[0] * Cv[0] + hn[1] * Cv[1] + hn[2] * Cv[2] + hn[3] * Cv[3];
      for (int o = 16; o >= 1; o >>= 1) y += shx(y, o, lane);
      if ((lane & 31) == 0) YC[hc * 64 + p] = f2bf(y + dsk * xv);
    }
  }
}

DI void ret_sample_item(char* shm, const Params& P, int l, int s) {
  float* qk = (float*)shm;
  const int tid = otid(), lane = tid & 63, w = tid >> 6;
  const int lr = MPROMPT + s - HALF_ROWS;
  u16* zr = (u16*)(optr(P.ws) + WS_Z) + (size_t)lr * ZS;
  __syncthreads();
  const float gamma = 1.f - exp2f(-5.f - (float)w);
  if (lane < 32) {
    const float th = 1.f / powf(10000.f, (float)lane / 31.f);
    float sn, cs; sincos_rev(16384.f * th, sn, cs);
    const float q1 = bf2f(zr[C_BQ + w * 64 + 2 * lane]), q2 = bf2f(zr[C_BQ + w * 64 + 2 * lane + 1]);
    const float k1 = bf2f(zr[C_BK + w * 64 + 2 * lane]) * 0.125f, k2 = bf2f(zr[C_BK + w * 64 + 2 * lane + 1]) * 0.125f;
    qk[w * 128 + 2 * lane] = q1 * cs - q2 * sn; qk[w * 128 + 2 * lane + 1] = q1 * sn + q2 * cs;
    qk[w * 128 + 64 + 2 * lane] = k1 * cs - k2 * sn; qk[w * 128 + 64 + 2 * lane + 1] = k1 * sn + k2 * cs;
  }
  const int e4 = (lane & 31) * 4, dsub = lane >> 5;
  f32x4 v4;
  _Pragma("unroll") for (int j = 0; j < 4; ++j) v4[j] = bf2f(zr[C_BV + w * 128 + e4 + j]);
  __syncthreads();
  const float* Sin = P.state_ret + (size_t)((l * 128 + s) * 8 + w) * 8192;
  float* Sout = P.out + O_RETS + (size_t)((l * 128 + s) * 8 + w) * 8192;
  f32x4 o4 = (f32x4){0.f, 0.f, 0.f, 0.f};
  {
    const int ib = 0;
    f32x4 sv[32];
    _Pragma("unroll") for (int k = 0; k < 32; ++k) sv[k] = __builtin_nontemporal_load(reinterpret_cast<const f32x4*>(Sin + (k * 2 + dsub) * 128 + e4));
    _Pragma("unroll") for (int k = 0; k < 32; ++k) {
      const int d = (ib * 16 + k) * 2 + dsub;
      const f32x4 sn = sv[k] * gamma + v4 * qk[w * 128 + 64 + d];
      __builtin_nontemporal_store(sn, reinterpret_cast<f32x4*>(Sout + d * 128 + e4));
      o4 += sn * qk[w * 128 + d];
    }
  }
  _Pragma("unroll") for (int j = 0; j < 4; ++j) o4[j] += shx(o4[j], 32, lane);
  if (dsub == 0) st4bf(zr + C_BV + w * 128 + e4, o4[0], o4[1], o4[2], o4[3]);
}

DI void att_sample_item(char* shm, const Params& P, int l, int s) {
  float* Kc = (float*)shm;
  float* Vc = Kc + 129 * 65;
  float* qv = Vc + 129 * 65;
  float* sc = qv + 256;
  float* red = sc + 512;
  const int tid = otid(), lane = tid & 63, w = tid >> 6;
  const int lr = MPROMPT + s - HALF_ROWS;
  u16* zr = (u16*)(optr(P.ws) + WS_Z) + (size_t)lr * ZS;
  const float* bt = (const float*)(optr(P.ws) + WS_BT);
  const float* ck = P.cache_k + (size_t)(l * 128 + s) * 128 * 256;
  const float* cv = P.cache_v + (size_t)(l * 128 + s) * 128 * 256;
  float* ok = P.out + O_WKS + (size_t)(l * 128 + s) * 128 * 256;
  float* ov = P.out + O_WVS + (size_t)(l * 128 + s) * 128 * 256;
  _Pragma("unroll 1") for (int kvh = 0; kvh < 4; ++kvh) {
    __syncthreads();
    {
      const int d4 = (tid & 15) * 4;
      f32x4 kk[4], vv[4];
      _Pragma("unroll") for (int itr = 0; itr < 4; ++itr) { const int j = (tid >> 4) + 32 * itr;
        kk[itr] = __builtin_nontemporal_load(reinterpret_cast<const f32x4*>(ck + j * 256 + kvh * 64 + d4)); vv[itr] = __builtin_nontemporal_load(reinterpret_cast<const f32x4*>(cv + j * 256 + kvh * 64 + d4)); }
      _Pragma("unroll") for (int itr = 0; itr < 4; ++itr) { const int j = (tid >> 4) + 32 * itr;
        _Pragma("unroll") for (int q = 0; q < 4; ++q) { Kc[j * 65 + d4 + q] = kk[itr][q]; Vc[j * 65 + d4 + q] = vv[itr][q]; }
        if (j >= 1) { __builtin_nontemporal_store(kk[itr], reinterpret_cast<f32x4*>(ok + (j - 1) * 256 + kvh * 64 + d4)); __builtin_nontemporal_store(vv[itr], reinterpret_cast<f32x4*>(ov + (j - 1) * 256 + kvh * 64 + d4)); } }
    }
    if (tid < 64) { const float kn = bf2f(zr[C_AK + kvh * 64 + tid]), vn = bf2f(zr[C_AV + kvh * 64 + tid]); Kc[128 * 65 + tid] = kn; Vc[128 * 65 + tid] = vn; ok[127 * 256 + kvh * 64 + tid] = kn; ov[127 * 256 + kvh * 64 + tid] = vn; }
    if (tid < 256) qv[tid] = bf2f(zr[C_AQ + kvh * 256 + tid]);
    __syncthreads();
    const int g = tid >> 7, c = 1 + (tid & 127), qh = kvh * 4 + g;
    float dot = 0.f;
    _Pragma("unroll 1") for (int d = 0; d < 64; ++d) dot += qv[g * 64 + d] * Kc[c * 65 + d];
    const float score = dot * 0.125f + bt[(128 - c) * 16 + qh];
    float mx = score;
    for (int o = 32; o >= 1; o >>= 1) mx = fmaxf(mx, shx(mx, o, lane));
    if (lane == 0) red[w] = mx;
    __syncthreads();
    const float sink = P.sinks[l * 16 + qh];
    const float m = fmaxf(fmaxf(red[2 * g], red[2 * g + 1]), sink);
    const float e = __expf(score - m);
    float sm = e;
    for (int o = 32; o >= 1; o >>= 1) sm += shx(sm, o, lane);
    if (lane == 0) red[8 + w] = sm;
    __syncthreads();
    const float den = red[8 + 2 * g] + red[8 + 2 * g + 1] + __expf(sink - m);
    sc[g * 128 + (c - 1)] = e / den;
    __syncthreads();
    if (tid < 256) {
      const int g2 = tid >> 6, d = tid & 63; float o = 0.f;
      for (int cc = 1; cc <= 128; ++cc) o += sc[g2 * 128 + cc - 1] * Vc[cc * 65 + d];
      zr[C_AQ + (kvh * 4 + g2) * 64 + d] = f2bf(o);
    }
  }
}

DI void mixer_phase(char* shm, const Params& P, int l, int hf, int ph) {
  __shared__ int s_item;
  unsigned* ctr = (unsigned*)(optr(P.ws) + WS_CTR) + ph;
  const int nitems = 128 + 64 + 512 + (hf ? 512 : 0);
  for (;;) {
    __syncthreads();
    if (threadIdx.x == 0) s_item = (int)atomicAdd(ctr, 1u);
    __syncthreads();
    int it = s_item;
    if (it >= nitems) break;
    if (it < 128) { ssd_prompt_item(shm, P, l, hf, hf * 8 + (it >> 4), it & 15); }
    else if ((it -= 128) < 64) { ret_prompt_item(shm, P, l, hf, hf * 8 + (it >> 3), it & 7); }
    else if ((it -= 64) < 512) { att_prompt_item(shm, P, l, hf, hf * 8 + (it >> 6), (it >> 2) & 15, it & 3); }
    else if ((it -= 512) < 256) { ssd_sample_item(shm, P, l, it >> 1, it & 1); }
    else if ((it -= 256) < 128) { ret_sample_item(shm, P, l, it); }
    else { it -= 128; att_sample_item(shm, P, l, it); }
  }
}

#define SEQ0 0x87543210ull
#define LEN0 8
#define SEQ1 0x8754321ull
#define LEN1 7
constexpr int PH_G0 = 3;
constexpr int N_PHASES = PH_G0 + 2 * (LEN0 + LEN1) + 1;
#ifndef MAXPH
#define MAXPH N_PHASES
#endif
__global__ void __launch_bounds__(NT) fwd_kernel(Params P) {
  extern __shared__ __attribute__((aligned(16))) unsigned char lds[];
  char* shm = (char*)lds;
  cg::grid_group grid = cg::this_grid();
  unsigned char* ws = P.ws;
  const float* mod = (const float*)(ws + WS_MOD);
  for (int ph = P.ph_lo; ph < P.ph_hi; ++ph) {
    if (ph > P.ph_lo) grid.sync();
    if (ph == 0) { prep_phase(shm, P); continue; }
    if (ph == N_PHASES - 1) { final_norm_phase(P); continue; }
    const int q = (ph < PH_G0) ? 0 : ph - PH_G0, hf = q / (LEN0 + LEN1), qq = q % (LEN0 + LEN1), l = (qq >= LEN0) ? 1 : 0;
    const int sub = (ph == 1) ? 9 : (ph == 2) ? 10 : l ? (int)((SEQ1 >> (4 * (qq - LEN0))) & 15ull) : (int)((SEQ0 >> (4 * qq)) & 15ull);
    const int ntm = hf ? 65 : 64, RB = hf * HALF_ROWS, NV = hf ? 16512 : 16384;
    if (sub == 0) { norm_phase(P, l, hf, 0, l == 0); continue; }
    if (sub == 2) { conv_phase(P, l, hf); continue; }
    if (sub == 3) { mixer_phase(shm, P, l, hf, ph); continue; }
    if (sub == 4) { mix_phase(P, l, hf); continue; }
    Epi E{};
    const int Gd = gridDim.x;
    const int bxr = (Gd % 8 == 0) ? (int)((blockIdx.x % 8) * (Gd / 8) + blockIdx.x / 8) : (int)blockIdx.x;
    const int cw = (bxr < 41) ? 0 : (bxr < 57) ? 1 : 2;
    const bool first_res = (sub == 5 && l == 0);
    E.kind = (sub == 9) ? 3 : (sub == 10) ? 6 : (sub == 1) ? 0 : (sub == 7) ? 1 : 2;
    E.c16 = (u16*)(ws + WS_Z); E.ldc = (sub == 1) ? ZS : (sub == 10) ? (cw == 0 ? ZS : DFF) : DFF;
    E.rb = RB; E.nv = NV; E.xout = P.out; E.mod = mod; E.goff = l * 6144 + ((sub == 5) ? 2048 : 5120);
    E.res_p = first_res ? P.x_prompt : (const float*)P.out;
    E.res_s = first_res ? P.x_sample : (const float*)(P.out + (size_t)MPROMPT * D);
    E.modout = (float*)(ws + WS_MOD); E.ada_b = P.ada_b; E.shb = (u16*)(ws + WS_SHB);
    E.cout = (float*)(ws + ((cw == 0) ? WS_C1 : WS_C2 + (size_t)(cw - 1) * 144 * DFF * 4));
    E.fuse = (sub == 5 || (sub == 8 && l == 0)) ? 1 : 0;
    E.fw = (sub == 5) ? P.n2 + l * D : P.n1 + D;
    E.fsc = (sub == 5) ? l * 6144 + 4096 : 6144 + 1024;
    E.fa = (u16*)(ws + ((sub == 5) ? WS_XBC : WS_H));
    E.fss = (float*)(ws + ((sub == 5) ? WS_SS2 : WS_SS1));
    E.cons = (sub == 7 || (sub == 1 && l == 1)) ? 1 : 0;
    E.css = (const float*)(ws + ((sub == 7) ? WS_SS2 : WS_SS1));
    E.cc = (const float*)(ws + ((sub == 7) ? WS_C2 + (size_t)l * 144 * DFF * 4 : WS_C1));
    E.ccld = (sub == 7) ? DFF : ZS;
    const bf16* A = (const bf16*)(ws + ((sub == 9) ? WS_SC : (sub == 10) ? WS_SHB + (size_t)cw * 256 * D * 2 : (sub == 8) ? WS_Z : (sub == 7) ? WS_XBC : WS_H));
    const size_t boff = (sub == 9) ? WS_AWT : (sub == 10) ? (cw == 0 ? WS_WIN + (size_t)ZS * D * 2 : WS_WUP + (size_t)(cw - 1) * DFF * D * 2)
                      : (sub == 1) ? WS_WIN + (size_t)l * ZS * D * 2 : (sub == 5) ? WS_WOUT + (size_t)l * D * D * 2
                      : (sub == 7) ? WS_WUP + (size_t)l * DFF * D * 2 : WS_WDN + (size_t)l * D * DFF * 2;
    const bf16* Bt = (const bf16*)(ws + boff);
    const int K = (sub == 8) ? DFF : D;
    const int tm = (sub == 9 || sub == 10) ? 1 : ntm;
    const int tn = (sub == 9) ? 48 : (sub == 10) ? (cw == 0 ? 41 : 16) : (sub == 1) ? 41 : (sub == 7) ? 16 : 4;
    const int toff = (sub == 10) ? (cw == 0 ? 0 : cw == 1 ? 41 : 57) : 0;
    asm volatile("" : "+s"(E.xout), "+s"(E.res_p), "+s"(E.res_s), "+s"(E.mod), "+s"(A), "+s"(Bt), "+s"(E.fa), "+s"(E.fss), "+s"(E.css), "+s"(E.cc), "+s"(E.cout));
    gemm_phase(shm, A, Bt, K, tm, tn, E, (hf == 1 && sub == 8 && l == 1) ? 1 : 0, toff, (hf == 1 && sub != 9 && sub != 10) ? 1 : 0);
  }
}

extern "C" void kernel_launch(void* const* d_in, const int* in_sizes, int n_in, void* d_out, int out_size, void* d_ws, size_t ws_size, hipStream_t stream) {
  static int grid = 0;
  if (grid == 0) {
    if (n_in != 26 || ws_size < WS_END) { fprintf(stderr, "kernel_launch: bad inputs n_in=%d ws=%zu need %zu\n", n_in, ws_size, (size_t)WS_END); grid = -1; return; }
    int dev = 0, cus = 0, per_cu = 0;
    (void)hipGetDevice(&dev);
    (void)hipDeviceGetAttribute(&cus, hipDeviceAttributeMultiprocessorCount, dev);
    if (hipFuncSetAttribute((const void*)fwd_kernel, hipFuncAttributeMaxDynamicSharedMemorySize, LDS_BYTES) != hipSuccess) { fprintf(stderr, "hipFuncSetAttribute failed\n"); grid = -1; return; }
    (void)hipOccupancyMaxActiveBlocksPerMultiprocessor(&per_cu, (const void*)fwd_kernel, NT, LDS_BYTES);
    if (per_cu < 1) { fprintf(stderr, "occupancy query returned %d\n", per_cu); per_cu = 1; }
    (void)hipGetLastError();
    grid = cus * per_cu;
  }
  if (grid < 0) return;
  (void)hipMemsetAsync((char*)d_ws + WS_CTR, 0, 256, stream);
  Params p{};
  const float** pp = (const float**)&p;
  _Pragma("unroll") for (int i = 0; i < 26; ++i) pp[i] = (const float*)d_in[i];
  p.out = (float*)d_out; p.ws = (unsigned char*)d_ws;
#if FUSED
  p.ph_lo = 0; p.ph_hi = MAXPH;
  void* args[] = {&p};
  hipError_t e = hipLaunchCooperativeKernel((const void*)fwd_kernel, dim3(grid), dim3(NT), args, LDS_BYTES, stream);
  if (e != hipSuccess) fprintf(stderr, "cooperative launch failed: %s (grid %d)\n", hipGetErrorString(e), grid);
#else
  for (int ph = 0; ph < MAXPH; ++ph) {
    p.ph_lo = ph; p.ph_hi = ph + 1;
    hipLaunchKernelGGL(fwd_kernel, dim3(grid), dim3(NT), LDS_BYTES, stream, p);
  }
#endif
}
```

```cpp
#include <hip/hip_runtime.h>
#include <hip/hip_bf16.h>
#include <hip/hip_cooperative_groups.h>
#include <cstdio>
namespace cg = cooperative_groups;

#ifndef FUSED
#define FUSED 1
#endif

typedef unsigned short u16;
using bf16 = __hip_bfloat16;
using bf16x8 = __attribute__((ext_vector_type(8))) short;
using s16x4  = __attribute__((ext_vector_type(4))) short;
using f32x4  = __attribute__((ext_vector_type(4))) float;
using f32x16 = __attribute__((ext_vector_type(16))) float;
using u32x4  = __attribute__((ext_vector_type(4))) unsigned;
using u32x2  = __attribute__((ext_vector_type(2))) unsigned;
#define DI __device__ __forceinline__

constexpr int D = 1024, DIN = 10256, ZS = 10496, DFF = 4096;
constexpr int MPROMPT = 32768, MVALID = 32896;
constexpr int HALF_ROWS = 16384, ZROWS = 16640;
constexpr int C_AQ = 0, C_AK = 1024, C_AV = 1280, C_BQ = 1536, C_BK = 2048, C_BV = 2560, C_BG = 3584, C_CZ = 4608,
              C_CX = 5632, C_DT = 7168, C_GA = 7184, C_GB = 8208, C_GC = 9232;
constexpr int MODS = 12288;
constexpr float EPS = 1e-6f;
constexpr int NT = 512;

constexpr size_t O_YP = 0, O_YS = O_YP + 33554432, O_WKP = O_YS + 131072, O_WVP = O_WKP + 1048576, O_RETP = O_WVP + 1048576,
                 O_SSMP = O_RETP + 2097152, O_CONVP = O_SSMP + 4194304, O_WKS = O_CONVP + 147456, O_WVS = O_WKS + 8388608,
                 O_RETS = O_WVS + 8388608, O_SSMS = O_RETS + 16777216, O_CONVS = O_SSMS + 33554432;
constexpr size_t WS_CTR = 0, WS_BT = 256, WS_SC = 16384, WS_MOD = WS_SC + 524288, WS_AWT = WS_MOD + 7077888,
                 WS_WIN = WS_AWT + 25165824, WS_WOUT = WS_WIN + 42991616, WS_WUP = WS_WOUT + 4194304, WS_WDN = WS_WUP + 16777216,
                 WS_H = WS_WDN + 16777216, WS_YC = WS_H + 34078720, WS_Z = WS_YC + 34078720, WS_XBC = WS_Z + 349306880,
                 WS_DT = WS_XBC + 51118080, WS_SS1 = WS_DT + 1064960, WS_SS2 = WS_SS1 + 66560, WS_C1 = WS_SS2 + 66560,
                 WS_C2 = WS_C1 + 6045696, WS_SHB = WS_C2 + 4718592, WS_END = WS_SHB + 1572864;
constexpr int LDS_BYTES = 147456;

struct Params {
  const float *x_prompt, *x_sample, *cache_k, *cache_v, *state_ret, *state_ssm, *state_conv, *c_prompt, *c_sample, *rel, *sinks,
      *n1, *n2, *ada_w, *ada_b, *w_in, *conv_w, *conv_b, *dt_bias, *A_log, *D_skip, *snw, *w_out, *w_up, *w_down, *fnw;
  float* out; unsigned char* ws; int ph_lo, ph_hi;
};

typedef float f32x2v __attribute__((ext_vector_type(2)));
typedef __bf16 bf16x2v __attribute__((ext_vector_type(2)));
DI unsigned pack2(float a, float b) { f32x2v v = {a, b}; return __builtin_bit_cast(unsigned, __builtin_convertvector(v, bf16x2v)); }
DI u16 f2bf(float x) { return (u16)(pack2(x, 0.f) & 0xffffu); }
DI float bf2f(u16 h) { return __uint_as_float(((unsigned)h) << 16); }
DI float bfs(short h) { return __uint_as_float(((unsigned)(u16)h) << 16); }
DI bf16x8 ld8(const u16* p) { return *reinterpret_cast<const bf16x8*>(p); }
DI void st8(u16* p, bf16x8 v) { *reinterpret_cast<bf16x8*>(p) = v; }
DI bf16x8 cat4(s16x4 lo, s16x4 hi) { return __builtin_shufflevector(lo, hi, 0, 1, 2, 3, 4, 5, 6, 7); }
DI f32x16 zero16() { f32x16 v; _Pragma("unroll") for (int i = 0; i < 16; ++i) v[i] = 0.f; return v; }
DI int crow(int i, int h) { return (i & 3) + 8 * (i >> 2) + 4 * h; }
#define MFMA32(a, b, c) __builtin_amdgcn_mfma_f32_32x32x16_bf16((a), (b), (c), 0, 0, 0)
template <int S> DI bf16x8 packP(const f32x16& x) {
  u32x4 p; p[0] = pack2(x[8 * S], x[8 * S + 1]); p[1] = pack2(x[8 * S + 2], x[8 * S + 3]);
  p[2] = pack2(x[8 * S + 4], x[8 * S + 5]); p[3] = pack2(x[8 * S + 6], x[8 * S + 7]);
  return __builtin_bit_cast(bf16x8, p);
}
DI bf16x8 pack8(const float* v) {
  u32x4 p; p[0] = pack2(v[0], v[1]); p[1] = pack2(v[2], v[3]); p[2] = pack2(v[4], v[5]); p[3] = pack2(v[6], v[7]);
  return __builtin_bit_cast(bf16x8, p);
}
DI void st4bf(u16* p, float a, float b, float c, float d) { u32x2 v; v[0] = pack2(a, b); v[1] = pack2(c, d); *reinterpret_cast<u32x2*>(p) = v; }
DI float siluf(float x) { return x / (1.f + __expf(-x)); }
DI float sigmf(float x) { return 1.f / (1.f + __expf(-x)); }
DI float softplusf(float x) { return x > 20.f ? x : log1pf(expf(x)); }
DI int otid() { int t = threadIdx.x; asm volatile("" : "+v"(t)); return t; }
template <class T> DI T* optr(T* p) { asm volatile("" : "+s"(p)); return p; }
DI float shx(float v, int m, int lane) { return __int_as_float(__builtin_amdgcn_ds_bpermute((lane ^ m) << 2, __float_as_int(v))); }
DI float shup(float v, int o, int lane) { return __int_as_float(__builtin_amdgcn_ds_bpermute((lane - o) << 2, __float_as_int(v))); }
DI int modrow(int r) { return r < MPROMPT ? (r >> 11) : 16 + (r - MPROMPT); }
DI void sincos_rev(float ang, float& s, float& c) {
  float k = rintf(ang * 0.15915494309189535f);
  float red = fmaf(-k, 6.28318548202514648f, ang);
  red = fmaf(-k, -1.7484555e-7f, red);
  float fr = red * 0.15915494309189535f;
  s = __builtin_amdgcn_sinf(fr); c = __builtin_amdgcn_cosf(fr);
}

constexpr int BM = 256, BK = 64, HALFT = 128, HT = HALFT * BK;
DI int lds_byte(int r, int c) { int st = (r >> 4) * 2 + (c >> 5), rr = r & 15, cc = c & 31, ob = rr * 64 + cc * 2; return st * 1024 + (ob ^ (((ob >> 9) & 1) << 5)); }
DI void stage_rc(int b, int& R, int& C) { int st = b / 1024, sb = b % 1024, swz = sb ^ (((sb >> 9) & 1) << 5); R = (st >> 1) * 16 + swz / 64; C = (st & 1) * 32 + (swz % 64) / 2; }

struct Epi {
  int kind;
  u16* c16; int ldc;
  int rb, nv;
  const float* res_p; const float* res_s;
  float* xout;
  const float* mod; int goff;
  float* modout; const float* ada_b;
  u16* shb;
  float* cout;
  int fuse;
  const float* fw; int fsc; u16* fa; float* fss;
  int cons;
  const float* css; const float* cc; int ccld;
};

#define LAS __attribute__((address_space(3)))
constexpr int HTB = HALFT * BK * 2;
DI void epilogue(const f32x4 (&acc)[2][2][4][2], const Epi& E, int brow, int bcol, int wr, int wc, int fr, int fq, int at) {
  const int col0 = bcol + wc * 32 + fq * 8;
  const int row0 = brow + wr * 64 + fr;
  const int lane = (fq << 4) | fr;
  const bool ptile = (E.rb + brow + 255) < MPROMPT;
  const int pb = (E.rb + brow) >> 11;
#define ECOL(j) (col0 + ((j) >> 1) * HALFT + ((j) & 1) * 4)
#define EROW(g) (row0 + ((g) >> 2) * HALFT + ((g) & 3) * 16)
#define EACC(g, j) acc[(g) >> 2][(j) >> 1][(g) & 3][(j) & 1]
  if (E.kind <= 1) {
    float ssv[8]; f32x4 cv[4];
    if (E.cons) {
      _Pragma("unroll") for (int g = 0; g < 8; ++g) ssv[g] = E.css[EROW(g)];
      if (ptile) { _Pragma("unroll") for (int j = 0; j < 4; ++j) cv[j] = *reinterpret_cast<const f32x4*>(E.cc + (size_t)pb * E.ccld + ECOL(j)); }
    }
    _Pragma("unroll") for (int g = 0; g < 8; ++g) {
      const int row = EROW(g);
      float rsv = 1.f;
      if (E.cons) {
        rsv = rsqrtf(ssv[g] * (1.f / D) + EPS);
        if (!ptile) { const int mrc = min(modrow(E.rb + row), 143);
          _Pragma("unroll") for (int j = 0; j < 4; ++j) cv[j] = *reinterpret_cast<const f32x4*>(E.cc + (size_t)mrc * E.ccld + ECOL(j)); }
      }
      _Pragma("unroll") for (int jb = 0; jb < 2; ++jb) {
        float o[8];
        _Pragma("unroll") for (int n = 0; n < 2; ++n) {
          f32x4 v = EACC(g, 2 * jb + n);
          if (E.cons) v = v * rsv + cv[2 * jb + n];
          if (E.kind == 1) { _Pragma("unroll") for (int q = 0; q < 4; ++q) { const float a = fmaxf(v[q], 0.f); v[q] = a * a; } }
          _Pragma("unroll") for (int q = 0; q < 4; ++q) o[4 * n + q] = v[q];
        }
        st8(E.c16 + (size_t)row * E.ldc + ECOL(2 * jb), pack8(o));
      }
    }
  } else if (E.kind == 2) {
    if (at) {
      _Pragma("unroll") for (int g = 0; g < 8; ++g) {
        const int row = EROW(g);
        if (row < E.nv) {
          const int r = E.rb + row;
          _Pragma("unroll") for (int j = 0; j < 4; ++j) {
            const f32x4 gg = *reinterpret_cast<const f32x4*>(E.mod + (size_t)modrow(r) * MODS + E.goff + ECOL(j));
            const f32x4 v = EACC(g, j);
            float* xp = E.xout + (size_t)r * D + ECOL(j);
            _Pragma("unroll") for (int q = 0; q < 4; ++q) unsafeAtomicAdd(xp + q, gg[q] * v[q]);
          }
        }
      }
    } else {
      f32x4 g4[4], w4[4], s4[4], xc[4], xq[4];
      const float* mrow0 = E.mod + (size_t)pb * MODS;
      if (ptile) { _Pragma("unroll") for (int j = 0; j < 4; ++j) { g4[j] = *reinterpret_cast<const f32x4*>(mrow0 + E.goff + ECOL(j));
          if (E.fuse) s4[j] = *reinterpret_cast<const f32x4*>(mrow0 + E.fsc + ECOL(j)); } }
      if (E.fuse) { _Pragma("unroll") for (int j = 0; j < 4; ++j) w4[j] = *reinterpret_cast<const f32x4*>(E.fw + ECOL(j)); }
#define LOADX(g, dst) do { const int _row = EROW(g); const int _r = E.rb + _row; \
        const float* _rs = (_r < MPROMPT) ? (E.res_p + (size_t)_r * D) : (E.res_s + (size_t)(_r - MPROMPT) * D); \
        _Pragma("unroll") for (int j = 0; j < 4; ++j) dst[j] = (_row < E.nv) ? *reinterpret_cast<const f32x4*>(_rs + ECOL(j)) : (f32x4){0.f, 0.f, 0.f, 0.f}; } while (0)
      LOADX(0, xc);
      _Pragma("unroll") for (int g = 0; g < 8; ++g) {
        const int row = EROW(g); const int r = E.rb + row; const bool ok = row < E.nv;
        if (g + 1 < 8) LOADX(g + 1, xq);
        if (!ptile && ok) { const float* mr = E.mod + (size_t)modrow(r) * MODS;
          _Pragma("unroll") for (int j = 0; j < 4; ++j) { g4[j] = *reinterpret_cast<const f32x4*>(mr + E.goff + ECOL(j)); if (E.fuse) s4[j] = *reinterpret_cast<const f32x4*>(mr + E.fsc + ECOL(j)); } }
        float ssq = 0.f;
        if (ok) {
          _Pragma("unroll") for (int j = 0; j < 4; ++j) {
            const f32x4 xn = xc[j] + g4[j] * EACC(g, j);
            *reinterpret_cast<f32x4*>(E.xout + (size_t)r * D + ECOL(j)) = xn;
            if (E.fuse) {
              const f32x4 a = xn * w4[j] * (s4[j] + 1.f);
              st4bf(E.fa + (size_t)row * D + ECOL(j), a[0], a[1], a[2], a[3]);
              ssq += xn[0] * xn[0] + xn[1] * xn[1] + xn[2] * xn[2] + xn[3] * xn[3];
            }
          }
        }
        if (E.fuse) {
          ssq += shx(ssq, 16, lane); ssq += shx(ssq, 32, lane);
          if (fq == 0 && ok) unsafeAtomicAdd(E.fss + row, ssq);
        }
        _Pragma("unroll") for (int j = 0; j < 4; ++j) xc[j] = xq[j];
      }
#undef LOADX
    }
  } else if (E.kind == 3) {
    _Pragma("unroll") for (int g = 0; g < 8; ++g) {
      const int row = EROW(g);
      if (row < 144) {
        _Pragma("unroll") for (int j = 0; j < 4; ++j) {
          const int col = ECOL(j);
          const f32x4 bb = *reinterpret_cast<const f32x4*>(E.ada_b + col);
          const f32x4 o = EACC(g, j) + bb;
          *reinterpret_cast<f32x4*>(E.modout + (size_t)row * MODS + col) = o;
          const int ch = col >> 10;
          const int sl = (ch == 6) ? 0 : (ch == 3) ? 1 : (ch == 9) ? 2 : -1;
          if (sl >= 0) st4bf(E.shb + ((size_t)sl * 256 + row) * D + (col & 1023), o[0], o[1], o[2], o[3]);
        }
      }
    }
  } else {
    _Pragma("unroll") for (int g = 0; g < 8; ++g) {
      const int row = EROW(g);
      if (row < 144) { _Pragma("unroll") for (int j = 0; j < 4; ++j) *reinterpret_cast<f32x4*>(E.cout + (size_t)row * E.ldc + ECOL(j)) = EACC(g, j); }
    }
  }
#undef ECOL
#undef EROW
#undef EACC
}

DI int perm32(int rho) { const int n = rho >> 4, i = rho & 15; return 8 * (i >> 2) + 4 * n + (i & 3); }
DI void tile_of(int tile, int ntm, int ntn, int& pm, int& pn) {
  const int nig = 8 * ntn, gid = tile / nig, fm = gid * 8, gsz = min(ntm - fm, 8);
  pm = fm + ((tile % nig) % gsz); pn = (tile % nig) / gsz;
}

DI void gemm_phase(char* shm_, const bf16* __restrict__ Ag, const bf16* __restrict__ Btg, int K, int ntm, int ntn, const Epi& E, int split, int toff, int shalf) {
  LAS unsigned char* lds = (LAS unsigned char*)shm_;
  const int tid = otid(), wid = __builtin_amdgcn_readfirstlane(tid >> 6), lane = tid & 63, wr = wid >> 2, wc = wid & 3, fr = lane & 15, fq = lane >> 4;
  const int ntk = K / BK;
  const int ntmf = split ? ntm - 1 : ntm, nfull = ntmf * ntn;
  const int G = gridDim.x, ntiles = nfull + (split ? ntn * (K / 256) : 0);
  const int bxr = (G % 8 == 0) ? (int)((blockIdx.x % 8) * (G / 8) + blockIdx.x / 8) : (int)blockIdx.x;
  unsigned voffA;
  { int R, C; stage_rc(tid * 16, R, C); voffA = (unsigned)(R * K + C) * 2u; }
  const size_t istep = (size_t)64 * K * 2;
  const size_t kstep = (size_t)(BK * 2), hstep = (size_t)HALFT * K * 2, tstep = 2 * hstep;
  const unsigned ldsw = (unsigned)wid * 1024u;
  const int aoff = lds_byte(wr * 64 + fr, fq * 8), boff = lds_byte(wc * 32 + fr, fq * 8);
#define PSA(b, h) (((b) * 2 + (h)) * HTB)
#define PSB(b, h) ((4 + (b) * 2 + (h)) * HTB)
#define PSTAGE(bufoff, gbase) PSTAGEX(bufoff, gbase, voffA)
#define PSTAGEB(bufoff, gbase) PSTAGEX(bufoff, gbase, voffA)
#define PSTAGEX(bufoff, gbase, VO) do { _Pragma("unroll") for (int _i = 0; _i < 2; ++_i) \
    __builtin_amdgcn_global_load_lds((const unsigned*)((const char*)(gbase) + (size_t)_i * istep + VO), (LAS unsigned*)(lds + (bufoff) + ldsw + _i * 8192), 16, 0, 0); } while (0)
#define PLDA(dst, b, h) do { _Pragma("unroll") for (int m = 0; m < 4; ++m) _Pragma("unroll") for (int k = 0; k < 2; ++k) dst[m][k] = *(const LAS bf16x8*)(lds + PSA(b, h) + aoff + m * 2048 + k * 1024); } while (0)
#define PLDB(dst, b, h) do { _Pragma("unroll") for (int n = 0; n < 2; ++n) _Pragma("unroll") for (int k = 0; k < 2; ++k) dst[n][k] = *(const LAS bf16x8*)(lds + PSB(b, h) + boff + n * 2048 + k * 1024); } while (0)
#define PMMA(ai, bj, At, Bq) do { __builtin_amdgcn_s_setprio(1); _Pragma("unroll") for (int m = 0; m < 4; ++m) _Pragma("unroll") for (int n = 0; n < 2; ++n) _Pragma("unroll") for (int k = 0; k < 2; ++k) \
    acc[ai][bj][m][n] = __builtin_amdgcn_mfma_f32_16x16x32_bf16(Bq[n][k], At[m][k], acc[ai][bj][m][n], 0, 0, 0); __builtin_amdgcn_s_setprio(0); } while (0)
#define WAIT_V(n) asm volatile("s_waitcnt vmcnt(" #n ")" ::: "memory")
#define WAIT_L(n) asm volatile("s_waitcnt lgkmcnt(" #n ")" ::: "memory")
#define BAR __builtin_amdgcn_s_barrier()
#define SCHED __builtin_amdgcn_sched_barrier(0)
  int tile = bxr - toff;
  if (tile < 0 || tile >= ntiles) return;
#define UNIT_OF(u, PM, PN, K0, NTU, AT, HL) do { if ((u) < nfull) { tile_of((u), ntmf, ntn, PM, PN); K0 = 0; NTU = ntk; AT = 0; } \
    else { const int _s = (u) - nfull; PN = _s % ntn; PM = ntmf; K0 = (_s / ntn) * 256; NTU = 4; AT = 1; } \
    HL = (shalf && PM == ntm - 1) ? 1 : 0; } while (0)
  int pm, pn, k0, nt, at, hl; UNIT_OF(tile, pm, pn, k0, nt, at, hl);
  f32x4 acc[2][2][4][2];
  _Pragma("unroll") for (int a = 0; a < 2; ++a) _Pragma("unroll") for (int b = 0; b < 2; ++b) _Pragma("unroll") for (int m = 0; m < 4; ++m) _Pragma("unroll") for (int n = 0; n < 2; ++n) acc[a][b][m][n] = (f32x4){0.f, 0.f, 0.f, 0.f};
  bf16x8 At[4][2], B0[2][2], B1[2][2];
  const char* cA = (const char*)Ag + (size_t)pm * tstep + (size_t)k0 * 2; const char* cB = (const char*)Btg + (size_t)pn * tstep + (size_t)k0 * 2;
  PSTAGEB(PSB(0, 0), cB); PSTAGE(PSA(0, 0), cA); PSTAGEB(PSB(0, 1), cB + hstep); PSTAGE(PSA(0, 1), cA + hstep);
  if (wr == 1) BAR;
  WAIT_V(4); BAR;
  PSTAGEB(PSB(1, 0), cB + kstep); PSTAGE(PSA(1, 0), cA + kstep); PSTAGEB(PSB(1, 1), cB + hstep + kstep);
  WAIT_V(6); BAR;
  for (;;) {
    const int ntile = tile + G;
    const bool has_next = ntile < ntiles;
    int npm = pm, npn = pn, nk0 = k0, nnt = nt, nat = at, nhl = hl; if (has_next) UNIT_OF(ntile, npm, npn, nk0, nnt, nat, nhl);
    const char* nA = has_next ? (const char*)Ag + (size_t)npm * tstep + (size_t)nk0 * 2 : cA; const char* nB = has_next ? (const char*)Btg + (size_t)npn * tstep + (size_t)nk0 * 2 : cB;
#define KLOOP(SK)     for (int t = 0; t < nt; t += 2) { \
      const bool last = (t == nt - 2); \
      const char* a1 = cA + (size_t)(t + 1) * kstep; \
      const char* a2 = last ? nA : cA + (size_t)(t + 2) * kstep; const char* b2 = last ? nB : cB + (size_t)(t + 2) * kstep; \
      const char* a3 = a2 + kstep; const char* b3 = b2 + kstep; \
      PLDB(B0, 0, 0); SCHED; PLDA(At, 0, 0); PSTAGE(PSA(1, 1), a1 + hstep); \
      WAIT_L(8); BAR; WAIT_L(0); PMMA(0, 0, At, B0); BAR; SCHED; \
      PLDB(B1, 0, 1); PSTAGEB(PSB(0, 0), b2); \
      BAR; WAIT_L(0); PMMA(0, 1, At, B1); BAR; \
      PLDA(At, 0, 1); PSTAGE(PSA(0, 0), a2); \
      BAR; WAIT_L(0); if (!(SK)) PMMA(1, 0, At, B0); BAR; SCHED; \
      PSTAGEB(PSB(0, 1), b2 + hstep); \
      WAIT_V(6); BAR; if (!(SK)) PMMA(1, 1, At, B1); BAR; \
      PLDB(B0, 1, 0); SCHED; PLDA(At, 1, 0); PSTAGE(PSA(0, 1), a2 + hstep); \
      WAIT_L(8); BAR; WAIT_L(0); PMMA(0, 0, At, B0); BAR; SCHED; \
      PLDB(B1, 1, 1); PSTAGEB(PSB(1, 0), b3); \
      BAR; WAIT_L(0); PMMA(0, 1, At, B1); BAR; \
      PLDA(At, 1, 1); PSTAGE(PSA(1, 0), a3); \
      BAR; WAIT_L(0); if (!(SK)) PMMA(1, 0, At, B0); BAR; SCHED; \
      PSTAGEB(PSB(1, 1), b3 + hstep); \
      WAIT_V(6); BAR; if (!(SK)) PMMA(1, 1, At, B1); BAR; \
    }
    if (hl) { KLOOP(1) } else { KLOOP(0) }
#undef KLOOP
    epilogue(acc, E, pm * BM, pn * BM, wr, wc, fr, fq, at);
    if (!has_next) break;
    _Pragma("unroll") for (int a = 0; a < 2; ++a) _Pragma("unroll") for (int b = 0; b < 2; ++b) _Pragma("unroll") for (int m = 0; m < 4; ++m) _Pragma("unroll") for (int n = 0; n < 2; ++n) acc[a][b][m][n] = (f32x4){0.f, 0.f, 0.f, 0.f};
    tile = ntile; pm = npm; pn = npn; k0 = nk0; nt = nnt; at = nat; hl = nhl; cA = nA; cB = nB;
  }
  WAIT_V(0);
  if (wr == 0) BAR;
  BAR;
}

struct TJob { const float* src; u16* dst; int K, N, tk, tn; };
DI TJob tjob_of(const Params& P, unsigned char* ws, int job) {
  TJob J; const int l = job / 6464; int j = job % 6464;
  if (j < 2624) { J.src = P.w_in + (size_t)l * D * DIN; J.dst = (u16*)(ws + WS_WIN) + (size_t)l * ZS * D; J.K = D; J.N = DIN; J.tk = j / 164; J.tn = j % 164; }
  else if ((j -= 2624) < 256) { J.src = P.w_out + (size_t)l * D * D; J.dst = (u16*)(ws + WS_WOUT) + (size_t)l * D * D; J.K = D; J.N = D; J.tk = j / 16; J.tn = j % 16; }
  else if ((j -= 256) < 1024) { J.src = P.w_up + (size_t)l * D * DFF; J.dst = (u16*)(ws + WS_WUP) + (size_t)l * DFF * D; J.K = D; J.N = DFF; J.tk = j / 64; J.tn = j % 64; }
  else if ((j -= 1024) < 1024) { J.src = P.w_down + (size_t)l * DFF * D; J.dst = (u16*)(ws + WS_WDN) + (size_t)l * D * DFF; J.K = DFF; J.N = D; J.tk = j / 16; J.tn = j % 16; }
  else { j -= 1024; J.src = P.ada_w + (size_t)l * D * 6144; J.dst = (u16*)(ws + WS_AWT) + (size_t)l * 6144 * D; J.K = D; J.N = 6144; J.tk = j / 96; J.tn = j % 96; }
  return J;
}
DI void tjob_load(const TJob& J, int tid, f32x4 (&v)[2]) {
  const int nn = (tid & 15) * 4, n = J.tn * 64 + nn;
  _Pragma("unroll") for (int i = 0; i < 2; ++i) { const int kk = (tid >> 4) + 32 * i;
    v[i] = (n < J.N) ? *reinterpret_cast<const f32x4*>(J.src + (size_t)(J.tk * 64 + kk) * J.N + n) : (f32x4){0.f, 0.f, 0.f, 0.f}; }
}

DI void prep_phase(char* shm, const Params& P) {
  float* tl = (float*)shm;
  unsigned char* ws = optr(P.ws);
  int bx_ = blockIdx.x; asm volatile("" : "+s"(bx_));
  int G_ = gridDim.x; asm volatile("" : "+s"(G_));
  const int G = G_, bx = bx_, tid = otid();
  const int njobs = 2 * 6464;
  if (bx < njobs) {
    f32x4 v[2];
    { const TJob J0 = tjob_of(P, ws, bx); tjob_load(J0, tid, v); }
    _Pragma("unroll 1") for (int job = bx; job < njobs; job += G) {
      __syncthreads();
      { const int nn = (tid & 15) * 4; _Pragma("unroll") for (int i = 0; i < 2; ++i) { const int kk = (tid >> 4) + 32 * i;
          _Pragma("unroll") for (int q = 0; q < 4; ++q) tl[kk * 65 + nn + q] = v[i][q]; } }
      if (job + G < njobs) { const TJob Jn = tjob_of(P, ws, job + G); tjob_load(Jn, tid, v); }
      __syncthreads();
      { const TJob Jc = tjob_of(P, ws, job);
        const int nn = tid >> 3, kp = tid & 7; float o[8]; _Pragma("unroll") for (int j = 0; j < 8; ++j) o[j] = tl[(kp * 8 + j) * 65 + nn];
        const int ncol = Jc.tn * 64 + nn, c5 = ncol & 31, slot = (ncol & ~31) + 16 * ((c5 >> 2) & 1) + 4 * (c5 >> 3) + (c5 & 3);
        st8(Jc.dst + (size_t)slot * Jc.K + Jc.tk * 64 + kp * 8, pack8(o)); }
    }
  }
  { unsigned* shb = (unsigned*)(ws + WS_SHB); _Pragma("unroll 1") for (int e = bx * NT + tid; e < 3 * 256 * 1024 / 2; e += G * NT) shb[e] = 0u; }
  u16* sc = (u16*)(ws + WS_SC);
  _Pragma("unroll 1") for (int e = bx * NT + tid; e < 256 * 1024; e += G * NT) {
    int row = e >> 10, c = e & 1023; float v = 0.f;
    if (row < 16) v = siluf(P.c_prompt[row * D + c]); else if (row < 144) v = siluf(P.c_sample[(row - 16) * D + c]);
    sc[e] = f2bf(v);
  }
  if (bx == 0) {
    float* bt = (float*)(ws + WS_BT);
    for (int e = tid; e < 128 * 16; e += NT) {
      int n = e >> 4, hd = e & 15; int bk;
      if (n < 16) bk = n; else { float nf = (float)n; int lg = 16 + (int)(logf(nf / 16.f) / 2.0794415416798357f * 16.f); bk = lg < 31 ? lg : 31; }
      bt[e] = P.rel[bk * 16 + hd];
    }
  }
}

DI void norm_phase(const Params& P, int l, int hf, int which  , bool from_input) {
  const int RB = hf * HALF_ROWS, NV = hf ? 16512 : 16384, NR = hf ? 16640 : 16384;
  const int tid = otid(); const int w = tid >> 6, lane = tid & 63;
  u16* H = (u16*)(optr(P.ws) + WS_H);
  const float* mod = (const float*)(optr(P.ws) + WS_MOD);
  const float* nw = (which ? P.n2 : P.n1) + l * D;
  const int stride = gridDim.x * 8;
  f32x4 nx[4];
#define NORM_SRC(lrow) (from_input ? ((RB + (lrow)) < MPROMPT ? P.x_prompt + (size_t)(RB + (lrow)) * D : P.x_sample + (size_t)(RB + (lrow) - MPROMPT) * D) : P.out + (size_t)(RB + (lrow)) * D)
  f32x4 nsh[4], nsc[4], nw4[4];
  _Pragma("unroll") for (int k = 0; k < 4; ++k) nw4[k] = *reinterpret_cast<const f32x4*>(nw + lane * 4 + 256 * k);
#define NORM_LOAD(lrow) do { const float* _xr = NORM_SRC(lrow); const float* _mr = mod + (size_t)modrow(RB + (lrow)) * MODS + l * 6144 + which * 3072; \
    _Pragma("unroll") for (int k = 0; k < 4; ++k) { nx[k] = *reinterpret_cast<const f32x4*>(_xr + lane * 4 + 256 * k); nsh[k] = *reinterpret_cast<const f32x4*>(_mr + lane * 4 + 256 * k); nsc[k] = *reinterpret_cast<const f32x4*>(_mr + 1024 + lane * 4 + 256 * k); } } while (0)
  int lr = blockIdx.x * 8 + w;
  if (lr < NV) NORM_LOAD(lr);
  _Pragma("unroll 1") for (; lr < NR; lr += stride) {
    u16* hrow = H + (size_t)lr * D;
    if (lr >= NV) { _Pragma("unroll") for (int k = 0; k < 4; ++k) st4bf(hrow + lane * 4 + 256 * k, 0.f, 0.f, 0.f, 0.f); continue; }
    const int r = RB + lr;
    f32x4 x[4], csh[4], csc[4]; float ss = 0.f;
    _Pragma("unroll") for (int k = 0; k < 4; ++k) { x[k] = nx[k]; csh[k] = nsh[k]; csc[k] = nsc[k]; ss += x[k][0] * x[k][0] + x[k][1] * x[k][1] + x[k][2] * x[k][2] + x[k][3] * x[k][3]; }
    if (lr + stride < NV) NORM_LOAD(lr + stride);
    for (int o = 32; o >= 1; o >>= 1) ss += shx(ss, o, lane);
    const float rs = rsqrtf(ss * (1.f / D) + EPS);
    if (from_input && r >= MPROMPT) { _Pragma("unroll") for (int k = 0; k < 4; ++k) *reinterpret_cast<f32x4*>(P.out + (size_t)r * D + lane * 4 + 256 * k) = x[k]; }
    _Pragma("unroll") for (int k = 0; k < 4; ++k) {
      const int c = lane * 4 + 256 * k;
      f32x4 y = x[k] * rs * nw4[k] * (csc[k] + 1.f) + csh[k];
      st4bf(hrow + c, y[0], y[1], y[2], y[3]);
    }
  }
}

DI void final_norm_phase(const Params& P) {
  const int tid = otid(); const int w = tid >> 6, lane = tid & 63;
  const int stride = gridDim.x * 8;
  f32x4 nx[4], fw4[4];
  _Pragma("unroll") for (int k = 0; k < 4; ++k) fw4[k] = *reinterpret_cast<const f32x4*>(P.fnw + lane * 4 + 256 * k);
  int r = blockIdx.x * 8 + w;
  if (r < MVALID) { _Pragma("unroll") for (int k = 0; k < 4; ++k) nx[k] = *reinterpret_cast<const f32x4*>(P.out + (size_t)r * D + lane * 4 + 256 * k); }
  _Pragma("unroll 1") for (; r < MVALID; r += stride) {
    float* xr = P.out + (size_t)r * D;
    f32x4 x[4]; float ss = 0.f;
    _Pragma("unroll") for (int k = 0; k < 4; ++k) { x[k] = nx[k]; ss += x[k][0] * x[k][0] + x[k][1] * x[k][1] + x[k][2] * x[k][2] + x[k][3] * x[k][3]; }
    if (r + stride < MVALID) { _Pragma("unroll") for (int k = 0; k < 4; ++k) nx[k] = *reinterpret_cast<const f32x4*>(P.out + (size_t)(r + stride) * D + lane * 4 + 256 * k); }
    for (int o = 32; o >= 1; o >>= 1) ss += shx(ss, o, lane);
    const float rs = rsqrtf(ss * (1.f / D) + EPS);
    _Pragma("unroll") for (int k = 0; k < 4; ++k) { const int c = lane * 4 + 256 * k; *reinterpret_cast<f32x4*>(xr + c) = x[k] * rs * fw4[k]; }
  }
}

DI void conv_phase(const Params& P, int l, int hf) {
  const int tid = otid();
  const u16* Z = (const u16*)(optr(P.ws) + WS_Z);
  u16* XBC = (u16*)(optr(P.ws) + WS_XBC);
  float* DT = (float*)(optr(P.ws) + WS_DT);
  const float* cw = P.conv_w + (size_t)l * 4 * 1536;
  const float* cb = P.conv_b + (size_t)l * 1536;
  const int nstrips = 16384 / 32;
  for (int sp = blockIdx.x * 2; sp < nstrips; sp += gridDim.x * 2) {
    if (tid < 384) {
      const int part = tid % 192, strip = sp + tid / 192, ch0 = part * 8;
      const int lr0 = strip * 32;
      float w[4][8], bias[8];
      _Pragma("unroll") for (int i = 0; i < 4; ++i) { const f32x4 a = *reinterpret_cast<const f32x4*>(cw + i * 1536 + ch0), b = *reinterpret_cast<const f32x4*>(cw + i * 1536 + ch0 + 4);
        _Pragma("unroll") for (int j = 0; j < 4; ++j) { w[i][j] = a[j]; w[i][4 + j] = b[j]; } }
      { const f32x4 a = *reinterpret_cast<const f32x4*>(cb + ch0), b = *reinterpret_cast<const f32x4*>(cb + ch0 + 4);
        _Pragma("unroll") for (int j = 0; j < 4; ++j) { bias[j] = a[j]; bias[4 + j] = b[j]; } }
      bf16x8 h0, h1, h2;
      const u16* zp = Z + (size_t)lr0 * ZS + C_CX + ch0;
      if ((lr0 & 2047) == 0) { _Pragma("unroll") for (int j = 0; j < 8; ++j) { h0[j] = 0; h1[j] = 0; h2[j] = 0; } }
      else { h0 = ld8(zp - 3 * (size_t)ZS); h1 = ld8(zp - 2 * (size_t)ZS); h2 = ld8(zp - (size_t)ZS); }
      u16* xo = XBC + (size_t)lr0 * 1536 + ch0;
      _Pragma("unroll 1") for (int rb = 0; rb < 32; rb += 8) {
        bf16x8 cur[8];
        _Pragma("unroll") for (int k = 0; k < 8; ++k) cur[k] = ld8(zp + (size_t)(rb + k) * ZS);
        _Pragma("unroll") for (int k = 0; k < 8; ++k) {
          float a[8];
          _Pragma("unroll") for (int j = 0; j < 8; ++j) a[j] = siluf(bias[j] + w[0][j] * bfs(h0[j]) + w[1][j] * bfs(h1[j]) + w[2][j] * bfs(h2[j]) + w[3][j] * bfs(cur[k][j]));
          st8(xo + (size_t)(rb + k) * 1536, pack8(a));
          h0 = h1; h1 = h2; h2 = cur[k];
        }
      }
    } else {
      const int t = tid - 384;
      u16 zv[8];
      _Pragma("unroll") for (int k = 0; k < 8; ++k) { const int u = t + 128 * k; zv[k] = Z[(size_t)(sp * 32 + (u >> 4)) * ZS + C_DT + (u & 15)]; }
      const float dtb = P.dt_bias[l * 16 + (t & 15)];
      _Pragma("unroll") for (int k = 0; k < 8; ++k) { const int u = t + 128 * k; DT[(size_t)(sp * 32 + (u >> 4)) * 16 + (u & 15)] = softplusf(bf2f(zv[k]) + dtb); }
    }
  }
}

DI void mix_phase(const Params& P, int l, int hf) {
  const int NV = hf ? 16512 : 16384, NR = hf ? 16640 : 16384;
  const int tid = otid(); const int w = tid >> 6, lane = tid & 63;
  u16* H = (u16*)(optr(P.ws) + WS_H);
  const u16* Z = (const u16*)(optr(P.ws) + WS_Z);
  const u16* YC = (const u16*)(optr(P.ws) + WS_YC);
  const float* snw = P.snw + l * D;
  bf16x8 nob[2], ny[2], ncz[2], noa[2], nbg[2], nga[2], ngb[2], ngc[2];
#define MIX_LOAD(row) do { const u16* zr = Z + (size_t)(row) * ZS + lane * 8; const u16* yr = YC + (size_t)(row) * D + lane * 8; \
    _Pragma("unroll") for (int k = 0; k < 2; ++k) { \
      nob[k] = ld8(zr + C_BV + 512 * k); ny[k] = ld8(yr + 512 * k); ncz[k] = ld8(zr + C_CZ + 512 * k); noa[k] = ld8(zr + C_AQ + 512 * k); \
      nbg[k] = ld8(zr + C_BG + 512 * k); nga[k] = ld8(zr + C_GA + 512 * k); ngb[k] = ld8(zr + C_GB + 512 * k); ngc[k] = ld8(zr + C_GC + 512 * k); } } while (0)
  const int stride = gridDim.x * 8;
  f32x4 snv[2][2];
  _Pragma("unroll") for (int k = 0; k < 2; ++k) { snv[k][0] = *reinterpret_cast<const f32x4*>(snw + lane * 8 + 512 * k); snv[k][1] = *reinterpret_cast<const f32x4*>(snw + lane * 8 + 512 * k + 4); }
  int lr = blockIdx.x * 8 + w;
  if (lr < NV) MIX_LOAD(lr);
  float* SS1 = (float*)(optr(P.ws) + WS_SS1); float* SS2 = (float*)(optr(P.ws) + WS_SS2);
  _Pragma("unroll 1") for (; lr < NR; lr += stride) {
    u16* hrow = H + (size_t)lr * D + lane * 8;
    if (lane == 0) { SS1[lr] = 0.f; SS2[lr] = 0.f; }
    if (lr >= NV) { _Pragma("unroll") for (int k = 0; k < 2; ++k) { st4bf(hrow + 512 * k, 0.f, 0.f, 0.f, 0.f); st4bf(hrow + 512 * k + 4, 0.f, 0.f, 0.f, 0.f); } continue; }
    bf16x8 vob[2], vy[2], vcz[2], voa[2], vbg[2], vga[2], vgb[2], vgc[2];
    _Pragma("unroll") for (int k = 0; k < 2; ++k) { vob[k] = nob[k]; vy[k] = ny[k]; vcz[k] = ncz[k]; voa[k] = noa[k]; vbg[k] = nbg[k]; vga[k] = nga[k]; vgb[k] = ngb[k]; vgc[k] = ngc[k]; }
    if (lr + stride < NV) MIX_LOAD(lr + stride);
    _Pragma("unroll") for (int k = 0; k < 2; ++k) {
      float ob[8], yg[8], so = 0.f, sy = 0.f;
      _Pragma("unroll") for (int j = 0; j < 8; ++j) { float o = bfs(vob[k][j]); ob[j] = o; so += o * o; float t = bfs(vy[k][j]) * siluf(bfs(vcz[k][j])); yg[j] = t; sy += t * t; }
      so += shx(so, 1, lane); so += shx(so, 2, lane); so += shx(so, 4, lane); so += shx(so, 8, lane);
      for (int o = 32; o >= 1; o >>= 1) sy += shx(sy, o, lane);
      const float ro = rsqrtf(so * (1.f / 128.f) + EPS), ry = rsqrtf(sy * (1.f / 512.f) + EPS);
      float m[8];
      const f32x4 s0 = snv[k][0], s1 = snv[k][1];
      _Pragma("unroll") for (int j = 0; j < 8; ++j) {
        const float obn = ob[j] * ro * siluf(bfs(vbg[k][j]));
        const float ocn = yg[j] * ry * (j < 4 ? s0[j & 3] : s1[j & 3]);
        m[j] = sigmf(bfs(vga[k][j])) * bfs(voa[k][j]) + sigmf(bfs(vgb[k][j])) * obn + sigmf(bfs(vgc[k][j])) * ocn;
      }
      st8(hrow + 512 * k, pack8(m));
    }
  }
}

DI void att_prompt_item(char* shm, const Params& P, int l, int hf, int b, int blk, int kvh) {
  u16* Ks = (u16*)shm;
  u16* Vt = Ks + 256 * 72;
  float* bias = (float*)(Vt + 64 * 268);
  u16* Z = (u16*)(optr(P.ws) + WS_Z);
  const float* bt = (const float*)(optr(P.ws) + WS_BT);
  const int tid = otid(), lane = tid & 63, w = tid >> 6;
  const int lr0 = b * 2048 + blk * 128 - hf * HALF_ROWS;
  const int g = w >> 1, qh = kvh * 4 + g, r = lane & 31, h = lane >> 5;
  bf16x8 qall[2][4];
  _Pragma("unroll") for (int qq = 0; qq < 2; ++qq) { const u16* qp = Z + (size_t)(lr0 + ((w & 1) * 2 + qq) * 32 + r) * ZS + C_AQ + qh * 64;
    _Pragma("unroll") for (int s = 0; s < 4; ++s) qall[qq][s] = ld8(qp + 16 * s + 8 * h); }
  const float sink = P.sinks[l * 16 + qh];
  const float btv = bt[(tid & 127) * 16 + kvh * 4 + (tid >> 7)];
  __syncthreads();
  {
    bf16x8 kr[4], vr[4];
    _Pragma("unroll") for (int it = 0; it < 4; ++it) { const int c = tid + it * NT, key = c >> 3, part = c & 7;
      if (blk > 0 || key >= 128) { const u16* src = Z + (size_t)(lr0 - 128 + key) * ZS; kr[it] = ld8(src + C_AK + kvh * 64 + part * 8); vr[it] = ld8(src + C_AV + kvh * 64 + part * 8); }
      else { _Pragma("unroll") for (int j = 0; j < 8; ++j) { kr[it][j] = 0; vr[it][j] = 0; } } }
    _Pragma("unroll") for (int it = 0; it < 4; ++it) { const int c = tid + it * NT, key = c >> 3, part = c & 7;
      st8(Ks + key * 72 + part * 8, kr[it]);
      _Pragma("unroll") for (int jj = 0; jj < 8; ++jj) Vt[(part * 8 + jj) * 268 + key] = (u16)vr[it][jj]; }
  }
  { const int g3 = tid >> 7, dist = tid & 127; bias[g3 * 192 + 32 + dist] = btv * 1.4426950408889634f;
    if (tid < 256) { const int g2 = tid >> 6, k = tid & 63; bias[g2 * 192 + (k < 32 ? k : 128 + k)] = 0.f; } }
  __syncthreads();
  _Pragma("unroll") for (int qq = 0; qq < 2; ++qq) {
    const int qt = (w & 1) * 2 + qq, qi = qt * 32 + r;
    u16* qrow = Z + (size_t)(lr0 + qi) * ZS + C_AQ + qh * 64;
    bf16x8 qf[4];
    _Pragma("unroll") for (int s = 0; s < 4; ++s) qf[s] = qall[qq][s];
    f32x16 O0 = zero16(), O1 = zero16();
    float m = sink * 1.4426950408889634f, lsum = 1.f;
    const int kt0 = (blk == 0) ? 4 : qt;
    _Pragma("unroll 1") for (int kt = kt0; kt <= qt + 4; ++kt) {
      f32x16 S = zero16();
      _Pragma("unroll") for (int s = 0; s < 4; ++s) { const bf16x8 kf = ld8(Ks + (kt * 32 + r) * 72 + 16 * s + 8 * h); S = MFMA32(kf, qf[s], S); }
      const float* bp = bias + g * 192 + 32 + (qi - 32 * kt + 128 - 4 * h);
      float mloc = -INFINITY;
      _Pragma("unroll") for (int i = 0; i < 16; ++i) S[i] = fmaf(S[i], 0.125f * 1.4426950408889634f, bp[-((i & 3) + 8 * (i >> 2))]);
      if (kt == qt) { _Pragma("unroll") for (int i = 0; i < 16; ++i) S[i] = (crow(i, h) > r) ? S[i] : -INFINITY; }
      if (kt == qt + 4) { _Pragma("unroll") for (int i = 0; i < 16; ++i) S[i] = (crow(i, h) <= r) ? S[i] : -INFINITY; }
      _Pragma("unroll") for (int i = 0; i < 16; ++i) mloc = fmaxf(mloc, S[i]);
      mloc = fmaxf(mloc, shx(mloc, 32, lane));
      const float mnew = fmaxf(m, mloc), alpha = __builtin_amdgcn_exp2f(m - mnew);
      float ps = 0.f;
      _Pragma("unroll") for (int i = 0; i < 16; ++i) { const float p = __builtin_amdgcn_exp2f(S[i] - mnew); S[i] = p; ps += p; }
      ps += shx(ps, 32, lane);
      lsum = lsum * alpha + ps; m = mnew;
      _Pragma("unroll") for (int i = 0; i < 16; ++i) { O0[i] *= alpha; O1[i] *= alpha; }
      const bf16x8 p0 = packP<0>(S), p1 = packP<1>(S);
      { const u16* vp = Vt + (r) * 268 + kt * 32 + 4 * h;
        O0 = MFMA32(cat4(*(const s16x4*)vp, *(const s16x4*)(vp + 8)), p0, O0);
        O0 = MFMA32(cat4(*(const s16x4*)(vp + 16), *(const s16x4*)(vp + 24)), p1, O0); }
      { const u16* vp = Vt + (32 + r) * 268 + kt * 32 + 4 * h;
        O1 = MFMA32(cat4(*(const s16x4*)vp, *(const s16x4*)(vp + 8)), p0, O1);
        O1 = MFMA32(cat4(*(const s16x4*)(vp + 16), *(const s16x4*)(vp + 24)), p1, O1); }
    }
    const float inv = 1.f / lsum;
    _Pragma("unroll") for (int gq = 0; gq < 4; ++gq) {
      st4bf(qrow + 8 * gq + 4 * h, O0[4 * gq] * inv, O0[4 * gq + 1] * inv, O0[4 * gq + 2] * inv, O0[4 * gq + 3] * inv);
      st4bf(qrow + 32 + 8 * gq + 4 * h, O1[4 * gq] * inv, O1[4 * gq + 1] * inv, O1[4 * gq + 2] * inv, O1[4 * gq + 3] * inv);
    }
  }
  if (blk == 15) {
    float* wk = P.out + O_WKP + (size_t)(l * 16 + b) * 128 * 256 + kvh * 64;
    float* wv = P.out + O_WVP + (size_t)(l * 16 + b) * 128 * 256 + kvh * 64;
    for (int idx = tid; idx < 128 * 64; idx += NT) { const int j = idx >> 6, d = idx & 63; wk[j * 256 + d] = bf2f(Ks[(128 + j) * 72 + d]); wv[j * 256 + d] = bf2f(Vt[d * 268 + 128 + j]); }
  }
}

DI void ret_prompt_item(char* shm, const Params& P, int l, int hf, int b, int hd) {
  u16* QQ = (u16*)shm;
  u16* KK = QQ + 128 * 72;
  u16* KKt = KK + 128 * 72;
  u16* Vt = KKt + 64 * 136;
  u16* St = Vt + 128 * 136;
  float* th = (float*)(St + 128 * 72);
  u16* Z = (u16*)(optr(P.ws) + WS_Z);
  const int tid = otid(), lane = tid & 63, w = tid >> 6, r = lane & 31, hh = lane >> 5;
  const float log2g = log2f(1.f - exp2f(-5.f - (float)hd));
  const float g128 = exp2f(log2g * 128.f);
  __syncthreads();
  for (int e = tid; e < 128 * 72; e += NT) St[e] = 0;
  if (tid < 32) th[tid] = 1.f / powf(10000.f, (float)tid / 31.f);
  f32x16 Sacc = zero16();
  const int lt = w & 3, eh = w >> 2;
  bf16x8 qv[2], kv[2], vv[4];
#define RET_ISSUE(cc) do { const int _lr = b * 2048 + (cc) * 128 - hf * HALF_ROWS; \
    _Pragma("unroll") for (int it = 0; it < 2; ++it) { const int idx = tid + it * NT, row = idx & 127, part = idx >> 7; \
      const u16* zr = Z + (size_t)(_lr + row) * ZS; qv[it] = ld8(zr + C_BQ + hd * 64 + part * 8); kv[it] = ld8(zr + C_BK + hd * 64 + part * 8); } \
    _Pragma("unroll") for (int it = 0; it < 4; ++it) { const int idx = tid + it * NT, row = idx & 127, part = idx >> 7; \
      vv[it] = ld8(Z + (size_t)(_lr + row) * ZS + C_BV + hd * 128 + part * 8); } } while (0)
  RET_ISSUE(0);
  _Pragma("unroll 1") for (int c = 0; c < 16; ++c) {
    const int tok0 = c * 128;
    const int lrow0 = b * 2048 + tok0 - hf * HALF_ROWS;
    __syncthreads();
    {
      _Pragma("unroll") for (int it = 0; it < 2; ++it) {
        const int idx = tid + it * NT, row = idx & 127, part = idx >> 7;
        const float pos = (float)(tok0 + row);
        const float gq = exp2f(log2g * (float)(row + 1)), gk = 0.125f * exp2f(-log2g * (float)(row + 1));
        float qo[8], ko[8];
        _Pragma("unroll") for (int pr = 0; pr < 4; ++pr) {
          float sn, cs; sincos_rev(pos * th[part * 4 + pr], sn, cs);
          const float q1 = bfs(qv[it][2 * pr]), q2 = bfs(qv[it][2 * pr + 1]), k1 = bfs(kv[it][2 * pr]), k2 = bfs(kv[it][2 * pr + 1]);
          qo[2 * pr] = (q1 * cs - q2 * sn) * gq; qo[2 * pr + 1] = (q1 * sn + q2 * cs) * gq;
          ko[2 * pr] = (k1 * cs - k2 * sn) * gk; ko[2 * pr + 1] = (k1 * sn + k2 * cs) * gk;
        }
        st8(QQ + row * 72 + part * 8, pack8(qo));
        st8(KK + row * 72 + part * 8, pack8(ko));
        _Pragma("unroll") for (int jj = 0; jj < 8; ++jj) KKt[(part * 8 + jj) * 136 + row] = f2bf(ko[jj]);
      }
      _Pragma("unroll") for (int it = 0; it < 4; ++it) { const int idx = tid + it * NT, row = idx & 127, part = idx >> 7;
        _Pragma("unroll") for (int jj = 0; jj < 8; ++jj) Vt[(part * 8 + jj) * 136 + row] = (u16)vv[it][jj]; }
    }
    if (c + 1 < 16) RET_ISSUE(c + 1);
    __syncthreads();
    bf16x8 qf[4];
    _Pragma("unroll") for (int s = 0; s < 4; ++s) qf[s] = ld8(QQ + (lt * 32 + r) * 72 + 16 * s + 8 * hh);
    f32x16 O0 = zero16(), O1 = zero16();
    _Pragma("unroll") for (int s = 0; s < 4; ++s) {
      O0 = MFMA32(ld8(St + ((2 * eh) * 32 + r) * 72 + 16 * s + 8 * hh), qf[s], O0);
      O1 = MFMA32(ld8(St + ((2 * eh + 1) * 32 + r) * 72 + 16 * s + 8 * hh), qf[s], O1);
    }
    _Pragma("unroll 1") for (int mk = 0; mk <= lt; ++mk) {
      f32x16 Aa = zero16();
      _Pragma("unroll") for (int s = 0; s < 4; ++s) Aa = MFMA32(ld8(KK + (mk * 32 + r) * 72 + 16 * s + 8 * hh), qf[s], Aa);
      if (mk == lt) _Pragma("unroll") for (int i = 0; i < 16; ++i) if (crow(i, hh) > r) Aa[i] = 0.f;
      const bf16x8 p0 = packP<0>(Aa), p1 = packP<1>(Aa);
      { const u16* vp = Vt + ((2 * eh) * 32 + r) * 136 + mk * 32 + 4 * hh;
        O0 = MFMA32(cat4(*(const s16x4*)vp, *(const s16x4*)(vp + 8)), p0, O0);
        O0 = MFMA32(cat4(*(const s16x4*)(vp + 16), *(const s16x4*)(vp + 24)), p1, O0); }
      { const u16* vp = Vt + ((2 * eh + 1) * 32 + r) * 136 + mk * 32 + 4 * hh;
        O1 = MFMA32(cat4(*(const s16x4*)vp, *(const s16x4*)(vp + 8)), p0, O1);
        O1 = MFMA32(cat4(*(const s16x4*)(vp + 16), *(const s16x4*)(vp + 24)), p1, O1); }
    }
    { u16* orow = Z + (size_t)(lrow0 + lt * 32 + r) * ZS + C_BV + hd * 128 + (2 * eh) * 32;
      _Pragma("unroll") for (int gq = 0; gq < 4; ++gq) {
        st4bf(orow + 8 * gq + 4 * hh, O0[4 * gq], O0[4 * gq + 1], O0[4 * gq + 2], O0[4 * gq + 3]);
        st4bf(orow + 32 + 8 * gq + 4 * hh, O1[4 * gq], O1[4 * gq + 1], O1[4 * gq + 2], O1[4 * gq + 3]);
      } }
    _Pragma("unroll") for (int s = 0; s < 8; ++s)
      Sacc = MFMA32(ld8(Vt + (lt * 32 + r) * 136 + 16 * s + 8 * hh), ld8(KKt + (eh * 32 + r) * 136 + 16 * s + 8 * hh), Sacc);
    _Pragma("unroll") for (int i = 0; i < 16; ++i) Sacc[i] *= g128;
    __syncthreads();
    _Pragma("unroll") for (int i = 0; i < 16; ++i) St[(lt * 32 + crow(i, hh)) * 72 + eh * 32 + r] = f2bf(Sacc[i]);
  }
  float* so = P.out + O_RETP + (size_t)((l * 16 + b) * 8 + hd) * 8192 + (size_t)(eh * 32 + r) * 128 + lt * 32;
  _Pragma("unroll") for (int gq = 0; gq < 4; ++gq) *reinterpret_cast<f32x4*>(so + 8 * gq + 4 * hh) = (f32x4){Sacc[4 * gq], Sacc[4 * gq + 1], Sacc[4 * gq + 2], Sacc[4 * gq + 3]};
}

DI void ssd_prompt_item(char* shm, const Params& P, int l, int hf, int b, int hc) {
  u16* Bm = (u16*)shm;
  u16* Cm = Bm + 128 * 136;
  u16* Xs = Cm + 128 * 136;
  u16* XwT = Xs + 64 * 136;
  u16* Hs = XwT + 64 * 136;
  float* acum = (float*)(Hs + 64 * 136);
  float* dtv = acum + 128;
  float* tot = dtv + 128;
  const u16* Z = (const u16*)(optr(P.ws) + WS_Z);
  u16* YC = (u16*)(optr(P.ws) + WS_YC);
  const u16* XBC = (const u16*)(optr(P.ws) + WS_XBC);
  const float* DT = (const float*)(optr(P.ws) + WS_DT);
  const int tid = otid(), lane = tid & 63, w = tid >> 6, r = lane & 31, hh = lane >> 5;
  const int g = hc >> 3;
  const float Aneg = -expf(P.A_log[l * 16 + hc]), dtb = P.dt_bias[l * 16 + hc], dsk = P.D_skip[l * 16 + hc];
  const float* cw = P.conv_w + (size_t)l * 4 * 1536;
  const float* cb = P.conv_b + (size_t)l * 1536;
  const int lrowb = b * 2048 - hf * HALF_ROWS;
  __syncthreads();
  for (int e = tid; e < 64 * 136; e += NT) Hs[e] = 0;
  f32x16 Hacc = zero16();
  const int pt = w >> 2, it = w & 3;
  bf16x8 pB[4], pC[4], pX[2]; float pdt = 0.f;
#define SSD_ISSUE(cc) do { const int _t0 = (cc) * 128; \
    _Pragma("unroll") for (int itr = 0; itr < 4; ++itr) { const int idx = tid + itr * NT, row = idx >> 4, part = idx & 15; \
      const u16* _p = XBC + (size_t)(lrowb + _t0 + row) * 1536 + g * 128 + part * 8; pB[itr] = ld8(_p + 1024); pC[itr] = ld8(_p + 1280); } \
    _Pragma("unroll") for (int itr = 0; itr < 2; ++itr) { const int idx = tid + itr * NT, row = idx & 127, part = idx >> 7; \
      pX[itr] = ld8(XBC + (size_t)(lrowb + _t0 + row) * 1536 + hc * 64 + part * 8); } \
    if (tid < 128) pdt = DT[(size_t)(lrowb + _t0 + tid) * 16 + hc]; } while (0)
  SSD_ISSUE(0);
  _Pragma("unroll 1") for (int c = 0; c < 16; ++c) {
    const int tok0 = c * 128;
    bf16x8 xr[2]; xr[0] = pX[0]; xr[1] = pX[1];
    if (tid < 128) {
      const float dt = pdt;
      float v = dt * Aneg;
      for (int o = 1; o < 64; o <<= 1) { const float t = shup(v, o, lane); if (lane >= o) v += t; }
      dtv[tid] = dt; acum[tid] = v;
      if (tid == 63) tot[0] = v;
    }
    _Pragma("unroll") for (int itr = 0; itr < 4; ++itr) { const int idx = tid + itr * NT, row = idx >> 4, part = idx & 15;
      st8(Bm + row * 136 + part * 8, pB[itr]); st8(Cm + row * 136 + part * 8, pC[itr]); }
    __syncthreads();
    if (tid >= 64 && tid < 128) acum[tid] += tot[0];
    __syncthreads();
    const float alast = acum[127];
    _Pragma("unroll") for (int itr = 0; itr < 2; ++itr) {
      const int idx = tid + itr * NT, row = idx & 127, part = idx >> 7;
      const float wj = __expf(alast - acum[row]) * dtv[row];
      _Pragma("unroll") for (int j = 0; j < 8; ++j) { const float xs = bfs(xr[itr][j]); Xs[(part * 8 + j) * 136 + row] = (u16)xr[itr][j]; XwT[(part * 8 + j) * 136 + row] = f2bf(xs * wj); }
    }
    if (c + 1 < 16) SSD_ISSUE(c + 1);
    __syncthreads();
    const u16* cfp = Cm + (it * 32 + r) * 136 + 8 * hh;
    f32x16 Y = zero16();
    _Pragma("unroll") for (int s = 0; s < 8; ++s) Y = MFMA32(ld8(Hs + (pt * 32 + r) * 136 + 16 * s + 8 * hh), ld8(cfp + 16 * s), Y);
    const float ai = acum[it * 32 + r];
    { const float ea = __expf(ai); _Pragma("unroll") for (int i = 0; i < 16; ++i) Y[i] *= ea; }
    _Pragma("unroll 1") for (int jt = 0; jt <= it; ++jt) {
      f32x16 Gm = zero16();
      _Pragma("unroll") for (int s = 0; s < 8; ++s) Gm = MFMA32(ld8(Bm + (jt * 32 + r) * 136 + 16 * s + 8 * hh), ld8(cfp + 16 * s), Gm);
      _Pragma("unroll") for (int i = 0; i < 16; ++i) {
        const int jl = crow(i, hh), j = jt * 32 + jl;
        const float v = Gm[i] * __expf(ai - acum[j]) * dtv[j];
        Gm[i] = (jt == it && jl > r) ? 0.f : v;
      }
      const bf16x8 p0 = packP<0>(Gm), p1 = packP<1>(Gm);
      const u16* xp = Xs + (pt * 32 + r) * 136 + jt * 32 + 4 * hh;
      Y = MFMA32(cat4(*(const s16x4*)xp, *(const s16x4*)(xp + 8)), p0, Y);
      Y = MFMA32(cat4(*(const s16x4*)(xp + 16), *(const s16x4*)(xp + 24)), p1, Y);
    }
    _Pragma("unroll") for (int i = 0; i < 16; ++i) Y[i] += dsk * bf2f(Xs[(pt * 32 + crow(i, hh)) * 136 + it * 32 + r]);
    { u16* yrow = YC + (size_t)(lrowb + tok0 + it * 32 + r) * D + hc * 64 + pt * 32;
      _Pragma("unroll") for (int gq = 0; gq < 4; ++gq) st4bf(yrow + 8 * gq + 4 * hh, Y[4 * gq], Y[4 * gq + 1], Y[4 * gq + 2], Y[4 * gq + 3]); }
    { const float dl = __expf(alast); _Pragma("unroll") for (int i = 0; i < 16; ++i) Hacc[i] *= dl; }
    _Pragma("unroll") for (int s = 0; s < 8; ++s) {
      const bf16x8 xf = ld8(XwT + (pt * 32 + r) * 136 + 16 * s + 8 * hh);
      const u16* bp = Bm + (16 * s + 8 * hh) * 136 + it * 32 + r;
      u32x4 pb;
      _Pragma("unroll") for (int q = 0; q < 4; ++q) pb[q] = (unsigned)bp[(2 * q) * 136] | ((unsigned)bp[(2 * q + 1) * 136] << 16);
      Hacc = MFMA32(xf, __builtin_bit_cast(bf16x8, pb), Hacc);
    }
    __syncthreads();
    _Pragma("unroll") for (int i = 0; i < 16; ++i) Hs[(pt * 32 + crow(i, hh)) * 136 + it * 32 + r] = f2bf(Hacc[i]);
  }
  { float* ho = P.out + O_SSMP + (size_t)((l * 16 + b) * 16 + hc) * 8192;
    _Pragma("unroll") for (int i = 0; i < 16; ++i) ho[(pt * 32 + crow(i, hh)) * 128 + it * 32 + r] = Hacc[i]; }
  { float* co = P.out + O_CONVP + (size_t)(l * 16 + b) * 3 * 1536;
    for (int e = tid; e < 3 * 64; e += NT) { const int i = e >> 6, ch = hc * 64 + (e & 63); co[i * 1536 + ch] = bf2f(Z[(size_t)(lrowb + 2045 + i) * ZS + C_CX + ch]); }
    if ((hc & 7) == 0) for (int e = tid; e < 3 * 256; e += NT) { const int i = e >> 8, q = e & 255; const int ch = (q < 128 ? 1024 : 1280 - 128) + g * 128 + q; co[i * 1536 + ch] = bf2f(Z[(size_t)(lrowb + 2045 + i) * ZS + C_CX + ch]); } }
}

DI void ssd_sample_item(char* shm, const Params& P, int l, int s, int g) {
  float* xs = (float*)shm;
  float* Bs = xs + 512;
  float* Cs = Bs + 128;
  float* dts = Cs + 128;
  const int tid = otid(), lane = tid & 63, w = tid >> 6;
  const int lr = MPROMPT + s - HALF_ROWS;
  const u16* zr = (const u16*)(optr(P.ws) + WS_Z) + (size_t)lr * ZS;
  u16* YC = (u16*)(optr(P.ws) + WS_YC) + (size_t)lr * D;
  const float* cw = P.conv_w + (size_t)l * 4 * 1536;
  const float* cb = P.conv_b + (size_t)l * 1536;
  const float* hist = P.state_conv + (size_t)(l * 128 + s) * 3 * 1536;
  float* cso = P.out + O_CONVS + (size_t)(l * 128 + s) * 3 * 1536;
  __syncthreads();
  for (int u = tid; u < 768; u += NT) {
    int ch; float* dst;
    if (u < 512) { ch = g * 512 + u; dst = xs + u; } else if (u < 640) { ch = 1024 + g * 128 + (u - 512); dst = Bs + (u - 512); } else { ch = 1280 + g * 128 + (u - 640); dst = Cs + (u - 640); }
    const float h0 = hist[ch], h1 = hist[1536 + ch], h2 = hist[2 * 1536 + ch], nw = bf2f(zr[C_CX + ch]);
    const float a = cb[ch] + cw[ch] * h0 + cw[1536 + ch] * h1 + cw[2 * 1536 + ch] * h2 + cw[3 * 1536 + ch] * nw;
    *dst = siluf(a);
    cso[ch] = h1; cso[1536 + ch] = h2; cso[2 * 1536 + ch] = nw;
  }
  if (tid < 8) { const int hc = g * 8 + tid; const float dt = softplusf(bf2f(zr[C_DT + hc]) + P.dt_bias[l * 16 + hc]); dts[tid] = dt; dts[8 + tid] = expf(dt * -expf(P.A_log[l * 16 + hc])); }
  __syncthreads();
  const int hc = g * 8 + w;
  const float dt = dts[w], dA = dts[8 + w], dsk = P.D_skip[l * 16 + hc];
  const float* hin = P.state_ssm + (size_t)((l * 128 + s) * 16 + hc) * 8192;
  float* hout = P.out + O_SSMS + (size_t)((l * 128 + s) * 16 + hc) * 8192;
  const int n4 = (lane & 31) * 4, psub = lane >> 5;
  const f32x4 Bv = *reinterpret_cast<const f32x4*>(Bs + n4), Cv = *reinterpret_cast<const f32x4*>(Cs + n4);
  {
    const int ib = 0;
    f32x4 hv[32];
    _Pragma("unroll") for (int k = 0; k < 32; ++k) hv[k] = __builtin_nontemporal_load(reinterpret_cast<const f32x4*>(hin + (k * 2 + psub) * 128 + n4));
    _Pragma("unroll") for (int k = 0; k < 32; ++k) {
      const int p = (ib * 16 + k) * 2 + psub;
      const float xv = xs[w * 64 + p];
      const f32x4 hn = hv[k] * dA + Bv * (dt * xv);
      __builtin_nontemporal_store(hn, reinterpret_cast<f32x4*>(hout + p * 128 + n4));
      float y = hn[0] * Cv[0] + hn[1] * Cv[1] + hn[2] * Cv[2] + hn[3] * Cv[3];
      for (int o = 16; o >= 1; o >>= 1) y += shx(y, o, lane);
      if ((lane & 31) == 0) YC[hc * 64 + p] = f2bf(y + dsk * xv);
    }
  }
}

DI void ret_sample_item(char* shm, const Params& P, int l, int s) {
  float* qk = (float*)shm;
  const int tid = otid(), lane = tid & 63, w = tid >> 6;
  const int lr = MPROMPT + s - HALF_ROWS;
  u16* zr = (u16*)(optr(P.ws) + WS_Z) + (size_t)lr * ZS;
  __syncthreads();
  const float gamma = 1.f - exp2f(-5.f - (float)w);
  if (lane < 32) {
    const float th = 1.f / powf(10000.f, (float)lane / 31.f);
    float sn, cs; sincos_rev(16384.f * th, sn, cs);
    const float q1 = bf2f(zr[C_BQ + w * 64 + 2 * lane]), q2 = bf2f(zr[C_BQ + w * 64 + 2 * lane + 1]);
    const float k1 = bf2f(zr[C_BK + w * 64 + 2 * lane]) * 0.125f, k2 = bf2f(zr[C_BK + w * 64 + 2 * lane + 1]) * 0.125f;
    qk[w * 128 + 2 * lane] = q1 * cs - q2 * sn; qk[w * 128 + 2 * lane + 1] = q1 * sn + q2 * cs;
    qk[w * 128 + 64 + 2 * lane] = k1 * cs - k2 * sn; qk[w * 128 + 64 + 2 * lane + 1] = k1 * sn + k2 * cs;
  }
  const int e4 = (lane & 31) * 4, dsub = lane >> 5;
  f32x4 v4;
  _Pragma("unroll") for (int j = 0; j < 4; ++j) v4[j] = bf2f(zr[C_BV + w * 128 + e4 + j]);
  __syncthreads();
  const float* Sin = P.state_ret + (size_t)((l * 128 + s) * 8 + w) * 8192;
  float* Sout = P.out + O_RETS + (size_t)((l * 128 + s) * 8 + w) * 8192;
  f32x4 o4 = (f32x4){0.f, 0.f, 0.f, 0.f};
  {
    const int ib = 0;
    f32x4 sv[32];
    _Pragma("unroll") for (int k = 0; k < 32; ++k) sv[k] = __builtin_nontemporal_load(reinterpret_cast<const f32x4*>(Sin + (k * 2 + dsub) * 128 + e4));
    _Pragma("unroll") for (int k = 0; k < 32; ++k) {
      const int d = (ib * 16 + k) * 2 + dsub;
      const f32x4 sn = sv[k] * gamma + v4 * qk[w * 128 + 64 + d];
      __builtin_nontemporal_store(sn, reinterpret_cast<f32x4*>(Sout + d * 128 + e4));
      o4 += sn * qk[w * 128 + d];
    }
  }
  _Pragma("unroll") for (int j = 0; j < 4; ++j) o4[j] += shx(o4[j], 32, lane);
  if (dsub == 0) st4bf(zr + C_BV + w * 128 + e4, o4[0], o4[1], o4[2], o4[3]);
}

DI void att_sample_item(char* shm, const Params& P, int l, int s) {
  float* Kc = (float*)shm;
  float* Vc = Kc + 129 * 65;
  float* qv = Vc + 129 * 65;
  float* sc = qv + 256;
  float* red = sc + 512;
  const int tid = otid(), lane = tid & 63, w = tid >> 6;
  const int lr = MPROMPT + s - HALF_ROWS;
  u16* zr = (u16*)(optr(P.ws) + WS_Z) + (size_t)lr * ZS;
  const float* bt = (const float*)(optr(P.ws) + WS_BT);
  const float* ck = P.cache_k + (size_t)(l * 128 + s) * 128 * 256;
  const float* cv = P.cache_v + (size_t)(l * 128 + s) * 128 * 256;
  float* ok = P.out + O_WKS + (size_t)(l * 128 + s) * 128 * 256;
  float* ov = P.out + O_WVS + (size_t)(l * 128 + s) * 128 * 256;
  _Pragma("unroll 1") for (int kvh = 0; kvh < 4; ++kvh) {
    __syncthreads();
    {
      const int d4 = (tid & 15) * 4;
      f32x4 kk[4], vv[4];
      _Pragma("unroll") for (int itr = 0; itr < 4; ++itr) { const int j = (tid >> 4) + 32 * itr;
        kk[itr] = __builtin_nontemporal_load(reinterpret_cast<const f32x4*>(ck + j * 256 + kvh * 64 + d4)); vv[itr] = __builtin_nontemporal_load(reinterpret_cast<const f32x4*>(cv + j * 256 + kvh * 64 + d4)); }
      _Pragma("unroll") for (int itr = 0; itr < 4; ++itr) { const int j = (tid >> 4) + 32 * itr;
        _Pragma("unroll") for (int q = 0; q < 4; ++q) { Kc[j * 65 + d4 + q] = kk[itr][q]; Vc[j * 65 + d4 + q] = vv[itr][q]; }
        if (j >= 1) { __builtin_nontemporal_store(kk[itr], reinterpret_cast<f32x4*>(ok + (j - 1) * 256 + kvh * 64 + d4)); __builtin_nontemporal_store(vv[itr], reinterpret_cast<f32x4*>(ov + (j - 1) * 256 + kvh * 64 + d4)); } }
    }
    if (tid < 64) { const float kn = bf2f(zr[C_AK + kvh * 64 + tid]), vn = bf2f(zr[C_AV + kvh * 64 + tid]); Kc[128 * 65 + tid] = kn; Vc[128 * 65 + tid] = vn; ok[127 * 256 + kvh * 64 + tid] = kn; ov[127 * 256 + kvh * 64 + tid] = vn; }
    if (tid < 256) qv[tid] = bf2f(zr[C_AQ + kvh * 256 + tid]);
    __syncthreads();
    const int g = tid >> 7, c = 1 + (tid & 127), qh = kvh * 4 + g;
    float dot = 0.f;
    _Pragma("unroll 1") for (int d = 0; d < 64; ++d) dot += qv[g * 64 + d] * Kc[c * 65 + d];
    const float score = dot * 0.125f + bt[(128 - c) * 16 + qh];
    float mx = score;
    for (int o = 32; o >= 1; o >>= 1) mx = fmaxf(mx, shx(mx, o, lane));
    if (lane == 0) red[w] = mx;
    __syncthreads();
    const float sink = P.sinks[l * 16 + qh];
    const float m = fmaxf(fmaxf(red[2 * g], red[2 * g + 1]), sink);
    const float e = __expf(score - m);
    float sm = e;
    for (int o = 32; o >= 1; o >>= 1) sm += shx(sm, o, lane);
    if (lane == 0) red[8 + w] = sm;
    __syncthreads();
    const float den = red[8 + 2 * g] + red[8 + 2 * g + 1] + __expf(sink - m);
    sc[g * 128 + (c - 1)] = e / den;
    __syncthreads();
    if (tid < 256) {
      const int g2 = tid >> 6, d = tid & 63; float o = 0.f;
      for (int cc = 1; cc <= 128; ++cc) o += sc[g2 * 128 + cc - 1] * Vc[cc * 65 + d];
      zr[C_AQ + (kvh * 4 + g2) * 64 + d] = f2bf(o);
    }
  }
}

DI void mixer_phase(char* shm, const Params& P, int l, int hf, int ph) {
  __shared__ int s_item;
  unsigned* ctr = (unsigned*)(optr(P.ws) + WS_CTR) + ph;
  const int nitems = 128 + 64 + 512 + (hf ? 512 : 0);
  for (;;) {
    __syncthreads();
    if (threadIdx.x == 0) s_item = (int)atomicAdd(ctr, 1u);
    __syncthreads();
    int it = s_item;
    if (it >= nitems) break;
    const int nsamp = hf ? 512 : 0;
    if (it < 128) { ssd_prompt_item(shm, P, l, hf, hf * 8 + (it >> 4), it & 15); }
    else if ((it -= 128) < 64) { ret_prompt_item(shm, P, l, hf, hf * 8 + (it >> 3), it & 7); }
    else if ((it -= 64) < nsamp) {
      if (it < 256) { ssd_sample_item(shm, P, l, it >> 1, it & 1); }
      else if ((it -= 256) < 128) { ret_sample_item(shm, P, l, it); }
      else { it -= 128; att_sample_item(shm, P, l, it); }
    }
    else { it -= nsamp; att_prompt_item(shm, P, l, hf, hf * 8 + (it >> 6), (it >> 2) & 15, it & 3); }
  }
}

#define SEQ0 0x87543210ull
#define LEN0 8
#define SEQ1 0x8754321ull
#define LEN1 7
constexpr int PH_G0 = 3;
constexpr int N_PHASES = PH_G0 + 2 * (LEN0 + LEN1) + 1;
#ifndef MAXPH
#define MAXPH N_PHASES
#endif
__global__ void __launch_bounds__(NT) fwd_kernel(Params P) {
  extern __shared__ __attribute__((aligned(16))) unsigned char lds[];
  char* shm = (char*)lds;
  cg::grid_group grid = cg::this_grid();
  unsigned char* ws = P.ws;
  const float* mod = (const float*)(ws + WS_MOD);
  for (int ph = P.ph_lo; ph < P.ph_hi; ++ph) {
    if (ph > P.ph_lo) grid.sync();
    if (ph == 0) { prep_phase(shm, P); continue; }
    if (ph == N_PHASES - 1) { final_norm_phase(P); continue; }
    const int q = (ph < PH_G0) ? 0 : ph - PH_G0, hf = q / (LEN0 + LEN1), qq = q % (LEN0 + LEN1), l = (qq >= LEN0) ? 1 : 0;
    const int sub = (ph == 1) ? 9 : (ph == 2) ? 10 : l ? (int)((SEQ1 >> (4 * (qq - LEN0))) & 15ull) : (int)((SEQ0 >> (4 * qq)) & 15ull);
    const int ntm = hf ? 65 : 64, RB = hf * HALF_ROWS, NV = hf ? 16512 : 16384;
    if (sub == 0) { norm_phase(P, l, hf, 0, l == 0); continue; }
    if (sub == 2) { conv_phase(P, l, hf); continue; }
    if (sub == 3) { mixer_phase(shm, P, l, hf, ph); continue; }
    if (sub == 4) { mix_phase(P, l, hf); continue; }
    Epi E{};
    const int Gd = gridDim.x;
    const int bxr = (Gd % 8 == 0) ? (int)((blockIdx.x % 8) * (Gd / 8) + blockIdx.x / 8) : (int)blockIdx.x;
    const int cw = (bxr < 41) ? 0 : (bxr < 57) ? 1 : 2;
    const bool first_res = (sub == 5 && l == 0);
    E.kind = (sub == 9) ? 3 : (sub == 10) ? 6 : (sub == 1) ? 0 : (sub == 7) ? 1 : 2;
    E.c16 = (u16*)(ws + WS_Z); E.ldc = (sub == 1) ? ZS : (sub == 10) ? (cw == 0 ? ZS : DFF) : DFF;
    E.rb = RB; E.nv = NV; E.xout = P.out; E.mod = mod; E.goff = l * 6144 + ((sub == 5) ? 2048 : 5120);
    E.res_p = first_res ? P.x_prompt : (const float*)P.out;
    E.res_s = first_res ? P.x_sample : (const float*)(P.out + (size_t)MPROMPT * D);
    E.modout = (float*)(ws + WS_MOD); E.ada_b = P.ada_b; E.shb = (u16*)(ws + WS_SHB);
    E.cout = (float*)(ws + ((cw == 0) ? WS_C1 : WS_C2 + (size_t)(cw - 1) * 144 * DFF * 4));
    E.fuse = (sub == 5 || (sub == 8 && l == 0)) ? 1 : 0;
    E.fw = (sub == 5) ? P.n2 + l * D : P.n1 + D;
    E.fsc = (sub == 5) ? l * 6144 + 4096 : 6144 + 1024;
    E.fa = (u16*)(ws + ((sub == 5) ? WS_XBC : WS_H));
    E.fss = (float*)(ws + ((sub == 5) ? WS_SS2 : WS_SS1));
    E.cons = (sub == 7 || (sub == 1 && l == 1)) ? 1 : 0;
    E.css = (const float*)(ws + ((sub == 7) ? WS_SS2 : WS_SS1));
    E.cc = (const float*)(ws + ((sub == 7) ? WS_C2 + (size_t)l * 144 * DFF * 4 : WS_C1));
    E.ccld = (sub == 7) ? DFF : ZS;
    const bf16* A = (const bf16*)(ws + ((sub == 9) ? WS_SC : (sub == 10) ? WS_SHB + (size_t)cw * 256 * D * 2 : (sub == 8) ? WS_Z : (sub == 7) ? WS_XBC : WS_H));
    const size_t boff = (sub == 9) ? WS_AWT : (sub == 10) ? (cw == 0 ? WS_WIN + (size_t)ZS * D * 2 : WS_WUP + (size_t)(cw - 1) * DFF * D * 2)
                      : (sub == 1) ? WS_WIN + (size_t)l * ZS * D * 2 : (sub == 5) ? WS_WOUT + (size_t)l * D * D * 2
                      : (sub == 7) ? WS_WUP + (size_t)l * DFF * D * 2 : WS_WDN + (size_t)l * D * DFF * 2;
    const bf16* Bt = (const bf16*)(ws + boff);
    const int K = (sub == 8) ? DFF : D;
    const int tm = (sub == 9 || sub == 10) ? 1 : ntm;
    const int tn = (sub == 9) ? 48 : (sub == 10) ? (cw == 0 ? 41 : 16) : (sub == 1) ? 41 : (sub == 7) ? 16 : 4;
    const int toff = (sub == 10) ? (cw == 0 ? 0 : cw == 1 ? 41 : 57) : 0;
    asm volatile("" : "+s"(E.xout), "+s"(E.res_p), "+s"(E.res_s), "+s"(E.mod), "+s"(A), "+s"(Bt), "+s"(E.fa), "+s"(E.fss), "+s"(E.css), "+s"(E.cc), "+s"(E.cout));
    gemm_phase(shm, A, Bt, K, tm, tn, E, (hf == 1 && sub == 8 && l == 1) ? 1 : 0, toff, (hf == 1 && sub != 9 && sub != 10) ? 1 : 0);
  }
}

extern "C" void kernel_launch(void* const* d_in, const int* in_sizes, int n_in, void* d_out, int out_size, void* d_ws, size_t ws_size, hipStream_t stream) {
  static int grid = 0;
  if (grid == 0) {
    if (n_in != 26 || ws_size < WS_END) { fprintf(stderr, "kernel_launch: bad inputs n_in=%d ws=%zu need %zu\n", n_in, ws_size, (size_t)WS_END); grid = -1; return; }
    int dev = 0, cus = 0, per_cu = 0;
    (void)hipGetDevice(&dev);
    (void)hipDeviceGetAttribute(&cus, hipDeviceAttributeMultiprocessorCount, dev);
    if (hipFuncSetAttribute((const void*)fwd_kernel, hipFuncAttributeMaxDynamicSharedMemorySize, LDS_BYTES) != hipSuccess) { fprintf(stderr, "hipFuncSetAttribute failed\n"); grid = -1; return; }
    (void)hipOccupancyMaxActiveBlocksPerMultiprocessor(&per_cu, (const void*)fwd_kernel, NT, LDS_BYTES);
    if (per_cu < 1) { fprintf(stderr, "occupancy query returned %d\n", per_cu); per_cu = 1; }
    (void)hipGetLastError();
    grid = cus * per_cu;
  }
  if (grid < 0) return;
  (void)hipMemsetAsync((char*)d_ws + WS_CTR, 0, 256, stream);
  Params p{};
  const float** pp = (const float**)&p;
  _Pragma("unroll") for (int i = 0; i < 26; ++i) pp[i] = (const float*)d_in[i];
  p.out = (float*)d_out; p.ws = (unsigned char*)d_ws;
#if FUSED
  p.ph_lo = 0; p.ph_hi = MAXPH;
  void* args[] = {&p};
  hipError_t e = hipLaunchCooperativeKernel((const void*)fwd_kernel, dim3(grid), dim3(NT), args, LDS_BYTES, stream);
  if (e != hipSuccess) fprintf(stderr, "cooperative launch failed: %s (grid %d)\n", hipGetErrorString(e), grid);
#else
  for (int ph = 0; ph < MAXPH; ++ph) {
    p.ph_lo = ph; p.ph_hi = ph + 1;
    hipLaunchKernelGGL(fwd_kernel, dim3(grid), dim3(NT), LDS_BYTES, stream, p);
  }
#endif
}
```

```cpp
#include <hip/hip_runtime.h>
#include <hip/hip_bf16.h>
#include <hip/hip_cooperative_groups.h>
#include <cstdio>
namespace cg = cooperative_groups;

#ifndef FUSED
#define FUSED 1
#endif

typedef unsigned short u16;
using bf16 = __hip_bfloat16;
using bf16x8 = __attribute__((ext_vector_type(8))) short;
using s16x4  = __attribute__((ext_vector_type(4))) short;
using f32x4  = __attribute__((ext_vector_type(4))) float;
using f32x16 = __attribute__((ext_vector_type(16))) float;
using u32x4  = __attribute__((ext_vector_type(4))) unsigned;
using u32x2  = __attribute__((ext_vector_type(2))) unsigned;
#define DI __device__ __forceinline__

constexpr int D = 1024, DIN = 10256, ZS = 10496, DFF = 4096;
constexpr int MPROMPT = 32768, MVALID = 32896;
constexpr int HALF_ROWS = 16384, ZROWS = 16640;
constexpr int C_AQ = 0, C_AK = 1024, C_AV = 1280, C_BQ = 1536, C_BK = 2048, C_BV = 2560, C_BG = 3584, C_CZ = 4608,
              C_CX = 5632, C_DT = 7168, C_GA = 7184, C_GB = 8208, C_GC = 9232;
constexpr int MODS = 12288;
constexpr float EPS = 1e-6f;
constexpr int NT = 512;

constexpr size_t O_YP = 0, O_YS = O_YP + 33554432, O_WKP = O_YS + 131072, O_WVP = O_WKP + 1048576, O_RETP = O_WVP + 1048576,
                 O_SSMP = O_RETP + 2097152, O_CONVP = O_SSMP + 4194304, O_WKS = O_CONVP + 147456, O_WVS = O_WKS + 8388608,
                 O_RETS = O_WVS + 8388608, O_SSMS = O_RETS + 16777216, O_CONVS = O_SSMS + 33554432;
constexpr size_t WS_CTR = 0, WS_BT = 256, WS_SC = 16384, WS_MOD = WS_SC + 524288, WS_AWT = WS_MOD + 7077888,
                 WS_WIN = WS_AWT + 25165824, WS_WOUT = WS_WIN + 42991616, WS_WUP = WS_WOUT + 4194304, WS_WDN = WS_WUP + 16777216,
                 WS_H = WS_WDN + 16777216, WS_YC = WS_H + 34078720, WS_Z = WS_YC + 34078720, WS_XBC = WS_Z + 349306880,
                 WS_DT = WS_XBC + 51118080, WS_SS1 = WS_DT + 1064960, WS_SS2 = WS_SS1 + 66560, WS_C1 = WS_SS2 + 66560,
                 WS_C2 = WS_C1 + 6045696, WS_SHB = WS_C2 + 4718592, WS_END = WS_SHB + 1572864;
constexpr int LDS_BYTES = 147456;

struct Params {
  const float *x_prompt, *x_sample, *cache_k, *cache_v, *state_ret, *state_ssm, *state_conv, *c_prompt, *c_sample, *rel, *sinks,
      *n1, *n2, *ada_w, *ada_b, *w_in, *conv_w, *conv_b, *dt_bias, *A_log, *D_skip, *snw, *w_out, *w_up, *w_down, *fnw;
  float* out; unsigned char* ws; int ph_lo, ph_hi;
};

typedef float f32x2v __attribute__((ext_vector_type(2)));
typedef __bf16 bf16x2v __attribute__((ext_vector_type(2)));
DI unsigned pack2(float a, float b) { f32x2v v = {a, b}; return __builtin_bit_cast(unsigned, __builtin_convertvector(v, bf16x2v)); }
DI u16 f2bf(float x) { return (u16)(pack2(x, 0.f) & 0xffffu); }
DI float bf2f(u16 h) { return __uint_as_float(((unsigned)h) << 16); }
DI float bfs(short h) { return __uint_as_float(((unsigned)(u16)h) << 16); }
DI bf16x8 ld8(const u16* p) { return *reinterpret_cast<const bf16x8*>(p); }
DI void st8(u16* p, bf16x8 v) { *reinterpret_cast<bf16x8*>(p) = v; }
DI bf16x8 cat4(s16x4 lo, s16x4 hi) { return __builtin_shufflevector(lo, hi, 0, 1, 2, 3, 4, 5, 6, 7); }
DI f32x16 zero16() { f32x16 v; _Pragma("unroll") for (int i = 0; i < 16; ++i) v[i] = 0.f; return v; }
DI int crow(int i, int h) { return (i & 3) + 8 * (i >> 2) + 4 * h; }
#define MFMA32(a, b, c) __builtin_amdgcn_mfma_f32_32x32x16_bf16((a), (b), (c), 0, 0, 0)
template <int S> DI bf16x8 packP(const f32x16& x) {
  u32x4 p; p[0] = pack2(x[8 * S], x[8 * S + 1]); p[1] = pack2(x[8 * S + 2], x[8 * S + 3]);
  p[2] = pack2(x[8 * S + 4], x[8 * S + 5]); p[3] = pack2(x[8 * S + 6], x[8 * S + 7]);
  return __builtin_bit_cast(bf16x8, p);
}
DI bf16x8 pack8(const float* v) {
  u32x4 p; p[0] = pack2(v[0], v[1]); p[1] = pack2(v[2], v[3]); p[2] = pack2(v[4], v[5]); p[3] = pack2(v[6], v[7]);
  return __builtin_bit_cast(bf16x8, p);
}
DI void st4bf(u16* p, float a, float b, float c, float d) { u32x2 v; v[0] = pack2(a, b); v[1] = pack2(c, d); *reinterpret_cast<u32x2*>(p) = v; }
DI float siluf(float x) { return x * __builtin_amdgcn_rcpf(1.f + __expf(-x)); }
DI float sigmf(float x) { return __builtin_amdgcn_rcpf(1.f + __expf(-x)); }
DI float softplusf(float x) { return x > 20.f ? x : log1pf(expf(x)); }
DI int otid() { int t = threadIdx.x; asm volatile("" : "+v"(t)); return t; }
template <class T> DI T* optr(T* p) { asm volatile("" : "+s"(p)); return p; }
DI float shx(float v, int m, int lane) { return __int_as_float(__builtin_amdgcn_ds_bpermute((lane ^ m) << 2, __float_as_int(v))); }
DI float shup(float v, int o, int lane) { return __int_as_float(__builtin_amdgcn_ds_bpermute((lane - o) << 2, __float_as_int(v))); }
DI int modrow(int r) { return r < MPROMPT ? (r >> 11) : 16 + (r - MPROMPT); }
DI void sincos_rev(float ang, float& s, float& c) {
  float k = rintf(ang * 0.15915494309189535f);
  float red = fmaf(-k, 6.28318548202514648f, ang);
  red = fmaf(-k, -1.7484555e-7f, red);
  float fr = red * 0.15915494309189535f;
  s = __builtin_amdgcn_sinf(fr); c = __builtin_amdgcn_cosf(fr);
}

constexpr int BM = 256, BK = 64, HALFT = 128, HT = HALFT * BK;
DI int lds_byte(int r, int c) { int st = (r >> 4) * 2 + (c >> 5), rr = r & 15, cc = c & 31, ob = rr * 64 + cc * 2; return st * 1024 + (ob ^ (((ob >> 9) & 1) << 5)); }
DI void stage_rc(int b, int& R, int& C) { int st = b / 1024, sb = b % 1024, swz = sb ^ (((sb >> 9) & 1) << 5); R = (st >> 1) * 16 + swz / 64; C = (st & 1) * 32 + (swz % 64) / 2; }

struct Epi {
  int kind;
  u16* c16; int ldc;
  int rb, nv;
  const float* res_p; const float* res_s;
  float* xout;
  const float* mod; int goff;
  float* modout; const float* ada_b;
  u16* shb;
  float* cout;
  int fuse;
  const float* fw; int fsc; u16* fa; float* fss;
  int cons;
  const float* css; const float* cc; int ccld;
};

#define LAS __attribute__((address_space(3)))
constexpr int HTB = HALFT * BK * 2;
DI void epilogue(const f32x4 (&acc)[2][2][4][2], const Epi& E, int brow, int bcol, int wr, int wc, int fr, int fq, int at) {
  const int col0 = bcol + wc * 32 + fq * 8;
  const int row0 = brow + wr * 64 + fr;
  const int lane = (fq << 4) | fr;
  const bool ptile = (E.rb + brow + 255) < MPROMPT;
  const int pb = (E.rb + brow) >> 11;
#define ECOL(j) (col0 + ((j) >> 1) * HALFT + ((j) & 1) * 4)
#define EROW(g) (row0 + ((g) >> 2) * HALFT + ((g) & 3) * 16)
#define EACC(g, j) acc[(g) >> 2][(j) >> 1][(g) & 3][(j) & 1]
  if (E.kind <= 1) {
    float ssv[8]; f32x4 cv[4];
    if (E.cons) {
      _Pragma("unroll") for (int g = 0; g < 8; ++g) ssv[g] = E.css[EROW(g)];
      if (ptile) { _Pragma("unroll") for (int j = 0; j < 4; ++j) cv[j] = *reinterpret_cast<const f32x4*>(E.cc + (size_t)pb * E.ccld + ECOL(j)); }
    }
    _Pragma("unroll") for (int g = 0; g < 8; ++g) {
      const int row = EROW(g);
      float rsv = 1.f;
      if (E.cons) {
        rsv = rsqrtf(ssv[g] * (1.f / D) + EPS);
        if (!ptile) { const int mrc = min(modrow(E.rb + row), 143);
          _Pragma("unroll") for (int j = 0; j < 4; ++j) cv[j] = *reinterpret_cast<const f32x4*>(E.cc + (size_t)mrc * E.ccld + ECOL(j)); }
      }
      _Pragma("unroll") for (int jb = 0; jb < 2; ++jb) {
        float o[8];
        _Pragma("unroll") for (int n = 0; n < 2; ++n) {
          f32x4 v = EACC(g, 2 * jb + n);
          if (E.cons) v = v * rsv + cv[2 * jb + n];
          if (E.kind == 1) { _Pragma("unroll") for (int q = 0; q < 4; ++q) { const float a = fmaxf(v[q], 0.f); v[q] = a * a; } }
          _Pragma("unroll") for (int q = 0; q < 4; ++q) o[4 * n + q] = v[q];
        }
        st8(E.c16 + (size_t)row * E.ldc + ECOL(2 * jb), pack8(o));
      }
    }
  } else if (E.kind == 2) {
    if (at) {
      _Pragma("unroll") for (int g = 0; g < 8; ++g) {
        const int row = EROW(g);
        if (row < E.nv) {
          const int r = E.rb + row;
          _Pragma("unroll") for (int j = 0; j < 4; ++j) {
            const f32x4 gg = *reinterpret_cast<const f32x4*>(E.mod + (size_t)modrow(r) * MODS + E.goff + ECOL(j));
            const f32x4 v = EACC(g, j);
            float* xp = E.xout + (size_t)r * D + ECOL(j);
            _Pragma("unroll") for (int q = 0; q < 4; ++q) unsafeAtomicAdd(xp + q, gg[q] * v[q]);
          }
        }
      }
    } else {
      f32x4 g4[4], w4[4], s4[4], xc[4], xq[4];
      const float* mrow0 = E.mod + (size_t)pb * MODS;
      if (ptile) { _Pragma("unroll") for (int j = 0; j < 4; ++j) { g4[j] = *reinterpret_cast<const f32x4*>(mrow0 + E.goff + ECOL(j));
          if (E.fuse) s4[j] = *reinterpret_cast<const f32x4*>(mrow0 + E.fsc + ECOL(j)); } }
      if (E.fuse) { _Pragma("unroll") for (int j = 0; j < 4; ++j) w4[j] = *reinterpret_cast<const f32x4*>(E.fw + ECOL(j)); }
#define LOADX(g, dst) do { const int _row = EROW(g); const int _r = E.rb + _row; \
        const float* _rs = (_r < MPROMPT) ? (E.res_p + (size_t)_r * D) : (E.res_s + (size_t)(_r - MPROMPT) * D); \
        _Pragma("unroll") for (int j = 0; j < 4; ++j) dst[j] = (_row < E.nv) ? *reinterpret_cast<const f32x4*>(_rs + ECOL(j)) : (f32x4){0.f, 0.f, 0.f, 0.f}; } while (0)
      LOADX(0, xc);
      _Pragma("unroll") for (int g = 0; g < 8; ++g) {
        const int row = EROW(g); const int r = E.rb + row; const bool ok = row < E.nv;
        if (g + 1 < 8) LOADX(g + 1, xq);
        if (!ptile && ok) { const float* mr = E.mod + (size_t)modrow(r) * MODS;
          _Pragma("unroll") for (int j = 0; j < 4; ++j) { g4[j] = *reinterpret_cast<const f32x4*>(mr + E.goff + ECOL(j)); if (E.fuse) s4[j] = *reinterpret_cast<const f32x4*>(mr + E.fsc + ECOL(j)); } }
        float ssq = 0.f;
        if (ok) {
          _Pragma("unroll") for (int j = 0; j < 4; ++j) {
            const f32x4 xn = xc[j] + g4[j] * EACC(g, j);
            *reinterpret_cast<f32x4*>(E.xout + (size_t)r * D + ECOL(j)) = xn;
            if (E.fuse) {
              const f32x4 a = xn * w4[j] * (s4[j] + 1.f);
              st4bf(E.fa + (size_t)row * D + ECOL(j), a[0], a[1], a[2], a[3]);
              ssq += xn[0] * xn[0] + xn[1] * xn[1] + xn[2] * xn[2] + xn[3] * xn[3];
            }
          }
        }
        if (E.fuse) {
          ssq += shx(ssq, 16, lane); ssq += shx(ssq, 32, lane);
          if (fq == 0 && ok) unsafeAtomicAdd(E.fss + row, ssq);
        }
        _Pragma("unroll") for (int j = 0; j < 4; ++j) xc[j] = xq[j];
      }
#undef LOADX
    }
  } else if (E.kind == 3) {
    _Pragma("unroll") for (int g = 0; g < 8; ++g) {
      const int row = EROW(g);
      if (row < 144) {
        _Pragma("unroll") for (int j = 0; j < 4; ++j) {
          const int col = ECOL(j);
          const f32x4 bb = *reinterpret_cast<const f32x4*>(E.ada_b + col);
          const f32x4 o = EACC(g, j) + bb;
          *reinterpret_cast<f32x4*>(E.modout + (size_t)row * MODS + col) = o;
          const int ch = col >> 10;
          const int sl = (ch == 6) ? 0 : (ch == 3) ? 1 : (ch == 9) ? 2 : -1;
          if (sl >= 0) st4bf(E.shb + ((size_t)sl * 256 + row) * D + (col & 1023), o[0], o[1], o[2], o[3]);
        }
      }
    }
  } else {
    _Pragma("unroll") for (int g = 0; g < 8; ++g) {
      const int row = EROW(g);
      if (row < 144) { _Pragma("unroll") for (int j = 0; j < 4; ++j) *reinterpret_cast<f32x4*>(E.cout + (size_t)row * E.ldc + ECOL(j)) = EACC(g, j); }
    }
  }
#undef ECOL
#undef EROW
#undef EACC
}

DI int perm32(int rho) { const int n = rho >> 4, i = rho & 15; return 8 * (i >> 2) + 4 * n + (i & 3); }
DI void tile_of(int tile, int ntm, int ntn, int& pm, int& pn) {
  const int nig = 8 * ntn, gid = tile / nig, fm = gid * 8, gsz = min(ntm - fm, 8);
  pm = fm + ((tile % nig) % gsz); pn = (tile % nig) / gsz;
}

DI void gemm_phase(char* shm_, const bf16* __restrict__ Ag, const bf16* __restrict__ Btg, int K, int ntm, int ntn, const Epi& E, int split, int toff, int shalf) {
  LAS unsigned char* lds = (LAS unsigned char*)shm_;
  const int tid = otid(), wid = __builtin_amdgcn_readfirstlane(tid >> 6), lane = tid & 63, wr = wid >> 2, wc = wid & 3, fr = lane & 15, fq = lane >> 4;
  const int ntk = K / BK;
  const int ntmf = split ? ntm - 1 : ntm, nfull = ntmf * ntn;
  const int G = gridDim.x, ntiles = nfull + (split ? ntn * (K / 256) : 0);
  const int bxr = (G % 8 == 0) ? (int)((blockIdx.x % 8) * (G / 8) + blockIdx.x / 8) : (int)blockIdx.x;
  unsigned voffA;
  { int R, C; stage_rc(tid * 16, R, C); voffA = (unsigned)(R * K + C) * 2u; }
  const size_t istep = (size_t)64 * K * 2;
  const size_t kstep = (size_t)(BK * 2), hstep = (size_t)HALFT * K * 2, tstep = 2 * hstep;
  const unsigned ldsw = (unsigned)wid * 1024u;
  const int aoff = lds_byte(wr * 64 + fr, fq * 8), boff = lds_byte(wc * 32 + fr, fq * 8);
#define PSA(b, h) (((b) * 2 + (h)) * HTB)
#define PSB(b, h) ((4 + (b) * 2 + (h)) * HTB)
#define PSTAGE(bufoff, gbase) PSTAGEX(bufoff, gbase, voffA)
#define PSTAGEB(bufoff, gbase) PSTAGEX(bufoff, gbase, voffA)
#define PSTAGEX(bufoff, gbase, VO) do { _Pragma("unroll") for (int _i = 0; _i < 2; ++_i) \
    __builtin_amdgcn_global_load_lds((const unsigned*)((const char*)(gbase) + (size_t)_i * istep + VO), (LAS unsigned*)(lds + (bufoff) + ldsw + _i * 8192), 16, 0, 0); } while (0)
#define PLDA(dst, b, h) do { _Pragma("unroll") for (int m = 0; m < 4; ++m) _Pragma("unroll") for (int k = 0; k < 2; ++k) dst[m][k] = *(const LAS bf16x8*)(lds + PSA(b, h) + aoff + m * 2048 + k * 1024); } while (0)
#define PLDB(dst, b, h) do { _Pragma("unroll") for (int n = 0; n < 2; ++n) _Pragma("unroll") for (int k = 0; k < 2; ++k) dst[n][k] = *(const LAS bf16x8*)(lds + PSB(b, h) + boff + n * 2048 + k * 1024); } while (0)
#define PMMA(ai, bj, At, Bq) do { __builtin_amdgcn_s_setprio(1); _Pragma("unroll") for (int m = 0; m < 4; ++m) _Pragma("unroll") for (int n = 0; n < 2; ++n) _Pragma("unroll") for (int k = 0; k < 2; ++k) \
    acc[ai][bj][m][n] = __builtin_amdgcn_mfma_f32_16x16x32_bf16(Bq[n][k], At[m][k], acc[ai][bj][m][n], 0, 0, 0); __builtin_amdgcn_s_setprio(0); } while (0)
#define WAIT_V(n) asm volatile("s_waitcnt vmcnt(" #n ")" ::: "memory")
#define WAIT_L(n) asm volatile("s_waitcnt lgkmcnt(" #n ")" ::: "memory")
#define BAR __builtin_amdgcn_s_barrier()
#define SCHED __builtin_amdgcn_sched_barrier(0)
  int tile = bxr - toff;
  if (tile < 0 || tile >= ntiles) return;
#define UNIT_OF(u, PM, PN, K0, NTU, AT, HL) do { if ((u) < nfull) { tile_of((u), ntmf, ntn, PM, PN); K0 = 0; NTU = ntk; AT = 0; } \
    else { const int _s = (u) - nfull; PN = _s % ntn; PM = ntmf; K0 = (_s / ntn) * 256; NTU = 4; AT = 1; } \
    HL = (shalf && PM == ntm - 1) ? 1 : 0; } while (0)
  int pm, pn, k0, nt, at, hl; UNIT_OF(tile, pm, pn, k0, nt, at, hl);
  f32x4 acc[2][2][4][2];
  _Pragma("unroll") for (int a = 0; a < 2; ++a) _Pragma("unroll") for (int b = 0; b < 2; ++b) _Pragma("unroll") for (int m = 0; m < 4; ++m) _Pragma("unroll") for (int n = 0; n < 2; ++n) acc[a][b][m][n] = (f32x4){0.f, 0.f, 0.f, 0.f};
  bf16x8 At[4][2], B0[2][2], B1[2][2];
  const char* cA = (const char*)Ag + (size_t)pm * tstep + (size_t)k0 * 2; const char* cB = (const char*)Btg + (size_t)pn * tstep + (size_t)k0 * 2;
  PSTAGEB(PSB(0, 0), cB); PSTAGE(PSA(0, 0), cA); PSTAGEB(PSB(0, 1), cB + hstep); PSTAGE(PSA(0, 1), cA + hstep);
  if (wr == 1) BAR;
  WAIT_V(4); BAR;
  PSTAGEB(PSB(1, 0), cB + kstep); PSTAGE(PSA(1, 0), cA + kstep); PSTAGEB(PSB(1, 1), cB + hstep + kstep);
  WAIT_V(6); BAR;
  for (;;) {
    const int ntile = tile + G;
    const bool has_next = ntile < ntiles;
    int npm = pm, npn = pn, nk0 = k0, nnt = nt, nat = at, nhl = hl; if (has_next) UNIT_OF(ntile, npm, npn, nk0, nnt, nat, nhl);
    const char* nA = has_next ? (const char*)Ag + (size_t)npm * tstep + (size_t)nk0 * 2 : cA; const char* nB = has_next ? (const char*)Btg + (size_t)npn * tstep + (size_t)nk0 * 2 : cB;
#define KLOOP(SK)     for (int t = 0; t < nt; t += 2) { \
      const bool last = (t == nt - 2); \
      const char* a1 = cA + (size_t)(t + 1) * kstep; \
      const char* a2 = last ? nA : cA + (size_t)(t + 2) * kstep; const char* b2 = last ? nB : cB + (size_t)(t + 2) * kstep; \
      const char* a3 = a2 + kstep; const char* b3 = b2 + kstep; \
      PLDB(B0, 0, 0); SCHED; PLDA(At, 0, 0); PSTAGE(PSA(1, 1), a1 + hstep); \
      WAIT_L(8); BAR; WAIT_L(0); PMMA(0, 0, At, B0); BAR; SCHED; \
      PLDB(B1, 0, 1); PSTAGEB(PSB(0, 0), b2); \
      BAR; WAIT_L(0); PMMA(0, 1, At, B1); BAR; \
      PLDA(At, 0, 1); PSTAGE(PSA(0, 0), a2); \
      BAR; WAIT_L(0); if (!(SK)) PMMA(1, 0, At, B0); BAR; SCHED; \
      PSTAGEB(PSB(0, 1), b2 + hstep); \
      WAIT_V(6); BAR; if (!(SK)) PMMA(1, 1, At, B1); BAR; \
      PLDB(B0, 1, 0); SCHED; PLDA(At, 1, 0); PSTAGE(PSA(0, 1), a2 + hstep); \
      WAIT_L(8); BAR; WAIT_L(0); PMMA(0, 0, At, B0); BAR; SCHED; \
      PLDB(B1, 1, 1); PSTAGEB(PSB(1, 0), b3); \
      BAR; WAIT_L(0); PMMA(0, 1, At, B1); BAR; \
      PLDA(At, 1, 1); PSTAGE(PSA(1, 0), a3); \
      BAR; WAIT_L(0); if (!(SK)) PMMA(1, 0, At, B0); BAR; SCHED; \
      PSTAGEB(PSB(1, 1), b3 + hstep); \
      WAIT_V(6); BAR; if (!(SK)) PMMA(1, 1, At, B1); BAR; \
    }
    if (hl) { KLOOP(1) } else { KLOOP(0) }
#undef KLOOP
    epilogue(acc, E, pm * BM, pn * BM, wr, wc, fr, fq, at);
    if (!has_next) break;
    _Pragma("unroll") for (int a = 0; a < 2; ++a) _Pragma("unroll") for (int b = 0; b < 2; ++b) _Pragma("unroll") for (int m = 0; m < 4; ++m) _Pragma("unroll") for (int n = 0; n < 2; ++n) acc[a][b][m][n] = (f32x4){0.f, 0.f, 0.f, 0.f};
    tile = ntile; pm = npm; pn = npn; k0 = nk0; nt = nnt; at = nat; hl = nhl; cA = nA; cB = nB;
  }
  WAIT_V(0);
  if (wr == 0) BAR;
  BAR;
}

struct TJob { const float* src; u16* dst; int K, N, tk, tn; };
DI TJob tjob_of(const Params& P, unsigned char* ws, int job) {
  TJob J; const int l = job / 6464; int j = job % 6464;
  if (j < 2624) { J.src = P.w_in + (size_t)l * D * DIN; J.dst = (u16*)(ws + WS_WIN) + (size_t)l * ZS * D; J.K = D; J.N = DIN; J.tk = j / 164; J.tn = j % 164; }
  else if ((j -= 2624) < 256) { J.src = P.w_out + (size_t)l * D * D; J.dst = (u16*)(ws + WS_WOUT) + (size_t)l * D * D; J.K = D; J.N = D; J.tk = j / 16; J.tn = j % 16; }
  else if ((j -= 256) < 1024) { J.src = P.w_up + (size_t)l * D * DFF; J.dst = (u16*)(ws + WS_WUP) + (size_t)l * DFF * D; J.K = D; J.N = DFF; J.tk = j / 64; J.tn = j % 64; }
  else if ((j -= 1024) < 1024) { J.src = P.w_down + (size_t)l * DFF * D; J.dst = (u16*)(ws + WS_WDN) + (size_t)l * D * DFF; J.K = DFF; J.N = D; J.tk = j / 16; J.tn = j % 16; }
  else { j -= 1024; J.src = P.ada_w + (size_t)l * D * 6144; J.dst = (u16*)(ws + WS_AWT) + (size_t)l * 6144 * D; J.K = D; J.N = 6144; J.tk = j / 96; J.tn = j % 96; }
  return J;
}
DI void tjob_load(const TJob& J, int tid, f32x4 (&v)[2]) {
  const int nn = (tid & 15) * 4, n = J.tn * 64 + nn;
  _Pragma("unroll") for (int i = 0; i < 2; ++i) { const int kk = (tid >> 4) + 32 * i;
    v[i] = (n < J.N) ? *reinterpret_cast<const f32x4*>(J.src + (size_t)(J.tk * 64 + kk) * J.N + n) : (f32x4){0.f, 0.f, 0.f, 0.f}; }
}

DI void prep_phase(char* shm, const Params& P) {
  float* tl = (float*)shm;
  unsigned char* ws = optr(P.ws);
  int bx_ = blockIdx.x; asm volatile("" : "+s"(bx_));
  int G_ = gridDim.x; asm volatile("" : "+s"(G_));
  const int G = G_, bx = bx_, tid = otid();
  const int njobs = 2 * 6464;
  if (bx < njobs) {
    f32x4 v[2];
    { const TJob J0 = tjob_of(P, ws, bx); tjob_load(J0, tid, v); }
    _Pragma("unroll 1") for (int job = bx; job < njobs; job += G) {
      __syncthreads();
      { const int nn = (tid & 15) * 4; _Pragma("unroll") for (int i = 0; i < 2; ++i) { const int kk = (tid >> 4) + 32 * i;
          _Pragma("unroll") for (int q = 0; q < 4; ++q) tl[kk * 65 + nn + q] = v[i][q]; } }
      if (job + G < njobs) { const TJob Jn = tjob_of(P, ws, job + G); tjob_load(Jn, tid, v); }
      __syncthreads();
      { const TJob Jc = tjob_of(P, ws, job);
        const int nn = tid >> 3, kp = tid & 7; float o[8]; _Pragma("unroll") for (int j = 0; j < 8; ++j) o[j] = tl[(kp * 8 + j) * 65 + nn];
        const int ncol = Jc.tn * 64 + nn, c5 = ncol & 31, slot = (ncol & ~31) + 16 * ((c5 >> 2) & 1) + 4 * (c5 >> 3) + (c5 & 3);
        st8(Jc.dst + (size_t)slot * Jc.K + Jc.tk * 64 + kp * 8, pack8(o)); }
    }
  }
  { unsigned* shb = (unsigned*)(ws + WS_SHB); _Pragma("unroll 1") for (int e = bx * NT + tid; e < 3 * 256 * 1024 / 2; e += G * NT) shb[e] = 0u; }
  u16* sc = (u16*)(ws + WS_SC);
  _Pragma("unroll 1") for (int e = bx * NT + tid; e < 256 * 1024; e += G * NT) {
    int row = e >> 10, c = e & 1023; float v = 0.f;
    if (row < 16) v = siluf(P.c_prompt[row * D + c]); else if (row < 144) v = siluf(P.c_sample[(row - 16) * D + c]);
    sc[e] = f2bf(v);
  }
  if (bx == 0) {
    float* bt = (float*)(ws + WS_BT);
    for (int e = tid; e < 128 * 16; e += NT) {
      int n = e >> 4, hd = e & 15; int bk;
      if (n < 16) bk = n; else { float nf = (float)n; int lg = 16 + (int)(logf(nf / 16.f) / 2.0794415416798357f * 16.f); bk = lg < 31 ? lg : 31; }
      bt[e] = P.rel[bk * 16 + hd];
    }
  }
}

DI void norm_phase(const Params& P, int l, int hf, int which  , bool from_input) {
  const int RB = hf * HALF_ROWS, NV = hf ? 16512 : 16384, NR = hf ? 16640 : 16384;
  const int tid = otid(); const int w = tid >> 6, lane = tid & 63;
  u16* H = (u16*)(optr(P.ws) + WS_H);
  const float* mod = (const float*)(optr(P.ws) + WS_MOD);
  const float* nw = (which ? P.n2 : P.n1) + l * D;
  const int stride = gridDim.x * 8;
  f32x4 nx[4];
#define NORM_SRC(lrow) (from_input ? ((RB + (lrow)) < MPROMPT ? P.x_prompt + (size_t)(RB + (lrow)) * D : P.x_sample + (size_t)(RB + (lrow) - MPROMPT) * D) : P.out + (size_t)(RB + (lrow)) * D)
  f32x4 nsh[4], nsc[4], nw4[4];
  _Pragma("unroll") for (int k = 0; k < 4; ++k) nw4[k] = *reinterpret_cast<const f32x4*>(nw + lane * 4 + 256 * k);
#define NORM_LOAD(lrow) do { const float* _xr = NORM_SRC(lrow); const float* _mr = mod + (size_t)modrow(RB + (lrow)) * MODS + l * 6144 + which * 3072; \
    _Pragma("unroll") for (int k = 0; k < 4; ++k) { nx[k] = *reinterpret_cast<const f32x4*>(_xr + lane * 4 + 256 * k); nsh[k] = *reinterpret_cast<const f32x4*>(_mr + lane * 4 + 256 * k); nsc[k] = *reinterpret_cast<const f32x4*>(_mr + 1024 + lane * 4 + 256 * k); } } while (0)
  int lr = blockIdx.x * 8 + w;
  if (lr < NV) NORM_LOAD(lr);
  _Pragma("unroll 1") for (; lr < NR; lr += stride) {
    u16* hrow = H + (size_t)lr * D;
    if (lr >= NV) { _Pragma("unroll") for (int k = 0; k < 4; ++k) st4bf(hrow + lane * 4 + 256 * k, 0.f, 0.f, 0.f, 0.f); continue; }
    const int r = RB + lr;
    f32x4 x[4], csh[4], csc[4]; float ss = 0.f;
    _Pragma("unroll") for (int k = 0; k < 4; ++k) { x[k] = nx[k]; csh[k] = nsh[k]; csc[k] = nsc[k]; ss += x[k][0] * x[k][0] + x[k][1] * x[k][1] + x[k][2] * x[k][2] + x[k][3] * x[k][3]; }
    if (lr + stride < NV) NORM_LOAD(lr + stride);
    for (int o = 32; o >= 1; o >>= 1) ss += shx(ss, o, lane);
    const float rs = rsqrtf(ss * (1.f / D) + EPS);
    if (from_input && r >= MPROMPT) { _Pragma("unroll") for (int k = 0; k < 4; ++k) *reinterpret_cast<f32x4*>(P.out + (size_t)r * D + lane * 4 + 256 * k) = x[k]; }
    _Pragma("unroll") for (int k = 0; k < 4; ++k) {
      const int c = lane * 4 + 256 * k;
      f32x4 y = x[k] * rs * nw4[k] * (csc[k] + 1.f) + csh[k];
      st4bf(hrow + c, y[0], y[1], y[2], y[3]);
    }
  }
}

DI void final_norm_phase(const Params& P) {
  const int tid = otid(); const int w = tid >> 6, lane = tid & 63;
  const int stride = gridDim.x * 8;
  f32x4 nx[4], fw4[4];
  _Pragma("unroll") for (int k = 0; k < 4; ++k) fw4[k] = *reinterpret_cast<const f32x4*>(P.fnw + lane * 4 + 256 * k);
  int r = blockIdx.x * 8 + w;
  if (r < MVALID) { _Pragma("unroll") for (int k = 0; k < 4; ++k) nx[k] = *reinterpret_cast<const f32x4*>(P.out + (size_t)r * D + lane * 4 + 256 * k); }
  _Pragma("unroll 1") for (; r < MVALID; r += stride) {
    float* xr = P.out + (size_t)r * D;
    f32x4 x[4]; float ss = 0.f;
    _Pragma("unroll") for (int k = 0; k < 4; ++k) { x[k] = nx[k]; ss += x[k][0] * x[k][0] + x[k][1] * x[k][1] + x[k][2] * x[k][2] + x[k][3] * x[k][3]; }
    if (r + stride < MVALID) { _Pragma("unroll") for (int k = 0; k < 4; ++k) nx[k] = *reinterpret_cast<const f32x4*>(P.out + (size_t)(r + stride) * D + lane * 4 + 256 * k); }
    for (int o = 32; o >= 1; o >>= 1) ss += shx(ss, o, lane);
    const float rs = rsqrtf(ss * (1.f / D) + EPS);
    _Pragma("unroll") for (int k = 0; k < 4; ++k) { const int c = lane * 4 + 256 * k; *reinterpret_cast<f32x4*>(xr + c) = x[k] * rs * fw4[k]; }
  }
}

DI void conv_phase(const Params& P, int l, int hf) {
  const int tid = otid();
  const u16* Z = (const u16*)(optr(P.ws) + WS_Z);
  u16* XBC = (u16*)(optr(P.ws) + WS_XBC);
  float* DT = (float*)(optr(P.ws) + WS_DT);
  const float* cw = P.conv_w + (size_t)l * 4 * 1536;
  const float* cb = P.conv_b + (size_t)l * 1536;
  const int nstrips = 16384 / 32;
  for (int sp = blockIdx.x * 2; sp < nstrips; sp += gridDim.x * 2) {
    if (tid < 384) {
      const int part = tid % 192, strip = sp + tid / 192, ch0 = part * 8;
      const int lr0 = strip * 32;
      float w[4][8], bias[8];
      _Pragma("unroll") for (int i = 0; i < 4; ++i) { const f32x4 a = *reinterpret_cast<const f32x4*>(cw + i * 1536 + ch0), b = *reinterpret_cast<const f32x4*>(cw + i * 1536 + ch0 + 4);
        _Pragma("unroll") for (int j = 0; j < 4; ++j) { w[i][j] = a[j]; w[i][4 + j] = b[j]; } }
      { const f32x4 a = *reinterpret_cast<const f32x4*>(cb + ch0), b = *reinterpret_cast<const f32x4*>(cb + ch0 + 4);
        _Pragma("unroll") for (int j = 0; j < 4; ++j) { bias[j] = a[j]; bias[4 + j] = b[j]; } }
      bf16x8 h0, h1, h2;
      const u16* zp = Z + (size_t)lr0 * ZS + C_CX + ch0;
      if ((lr0 & 2047) == 0) { _Pragma("unroll") for (int j = 0; j < 8; ++j) { h0[j] = 0; h1[j] = 0; h2[j] = 0; } }
      else { h0 = ld8(zp - 3 * (size_t)ZS); h1 = ld8(zp - 2 * (size_t)ZS); h2 = ld8(zp - (size_t)ZS); }
      u16* xo = XBC + (size_t)lr0 * 1536 + ch0;
      _Pragma("unroll 1") for (int rb = 0; rb < 32; rb += 8) {
        bf16x8 cur[8];
        _Pragma("unroll") for (int k = 0; k < 8; ++k) cur[k] = ld8(zp + (size_t)(rb + k) * ZS);
        _Pragma("unroll") for (int k = 0; k < 8; ++k) {
          float a[8];
          _Pragma("unroll") for (int j = 0; j < 8; ++j) a[j] = siluf(bias[j] + w[0][j] * bfs(h0[j]) + w[1][j] * bfs(h1[j]) + w[2][j] * bfs(h2[j]) + w[3][j] * bfs(cur[k][j]));
          st8(xo + (size_t)(rb + k) * 1536, pack8(a));
          h0 = h1; h1 = h2; h2 = cur[k];
        }
      }
    } else {
      const int t = tid - 384;
      u16 zv[8];
      _Pragma("unroll") for (int k = 0; k < 8; ++k) { const int u = t + 128 * k; zv[k] = Z[(size_t)(sp * 32 + (u >> 4)) * ZS + C_DT + (u & 15)]; }
      const float dtb = P.dt_bias[l * 16 + (t & 15)];
      _Pragma("unroll") for (int k = 0; k < 8; ++k) { const int u = t + 128 * k; DT[(size_t)(sp * 32 + (u >> 4)) * 16 + (u & 15)] = softplusf(bf2f(zv[k]) + dtb); }
    }
  }
}

DI void mix_phase(const Params& P, int l, int hf) {
  const int NV = hf ? 16512 : 16384, NR = hf ? 16640 : 16384;
  const int tid = otid(); const int w = tid >> 6, lane = tid & 63;
  u16* H = (u16*)(optr(P.ws) + WS_H);
  const u16* Z = (const u16*)(optr(P.ws) + WS_Z);
  const u16* YC = (const u16*)(optr(P.ws) + WS_YC);
  const float* snw = P.snw + l * D;
  bf16x8 nob[2], ny[2], ncz[2], noa[2], nbg[2], nga[2], ngb[2], ngc[2];
#define MIX_LOAD(row) do { const u16* zr = Z + (size_t)(row) * ZS + lane * 8; const u16* yr = YC + (size_t)(row) * D + lane * 8; \
    _Pragma("unroll") for (int k = 0; k < 2; ++k) { \
      nob[k] = ld8(zr + C_BV + 512 * k); ny[k] = ld8(yr + 512 * k); ncz[k] = ld8(zr + C_CZ + 512 * k); noa[k] = ld8(zr + C_AQ + 512 * k); \
      nbg[k] = ld8(zr + C_BG + 512 * k); nga[k] = ld8(zr + C_GA + 512 * k); ngb[k] = ld8(zr + C_GB + 512 * k); ngc[k] = ld8(zr + C_GC + 512 * k); } } while (0)
  const int stride = gridDim.x * 8;
  f32x4 snv[2][2];
  _Pragma("unroll") for (int k = 0; k < 2; ++k) { snv[k][0] = *reinterpret_cast<const f32x4*>(snw + lane * 8 + 512 * k); snv[k][1] = *reinterpret_cast<const f32x4*>(snw + lane * 8 + 512 * k + 4); }
  int lr = blockIdx.x * 8 + w;
  if (lr < NV) MIX_LOAD(lr);
  float* SS1 = (float*)(optr(P.ws) + WS_SS1); float* SS2 = (float*)(optr(P.ws) + WS_SS2);
  _Pragma("unroll 1") for (; lr < NR; lr += stride) {
    u16* hrow = H + (size_t)lr * D + lane * 8;
    if (lane == 0) { SS1[lr] = 0.f; SS2[lr] = 0.f; }
    if (lr >= NV) { _Pragma("unroll") for (int k = 0; k < 2; ++k) { st4bf(hrow + 512 * k, 0.f, 0.f, 0.f, 0.f); st4bf(hrow + 512 * k + 4, 0.f, 0.f, 0.f, 0.f); } continue; }
    bf16x8 vob[2], vy[2], vcz[2], voa[2], vbg[2], vga[2], vgb[2], vgc[2];
    _Pragma("unroll") for (int k = 0; k < 2; ++k) { vob[k] = nob[k]; vy[k] = ny[k]; vcz[k] = ncz[k]; voa[k] = noa[k]; vbg[k] = nbg[k]; vga[k] = nga[k]; vgb[k] = ngb[k]; vgc[k] = ngc[k]; }
    if (lr + stride < NV) MIX_LOAD(lr + stride);
    _Pragma("unroll") for (int k = 0; k < 2; ++k) {
      float ob[8], yg[8], so = 0.f, sy = 0.f;
      _Pragma("unroll") for (int j = 0; j < 8; ++j) { float o = bfs(vob[k][j]); ob[j] = o; so += o * o; float t = bfs(vy[k][j]) * siluf(bfs(vcz[k][j])); yg[j] = t; sy += t * t; }
      so += shx(so, 1, lane); so += shx(so, 2, lane); so += shx(so, 4, lane); so += shx(so, 8, lane);
      for (int o = 32; o >= 1; o >>= 1) sy += shx(sy, o, lane);
      const float ro = rsqrtf(so * (1.f / 128.f) + EPS), ry = rsqrtf(sy * (1.f / 512.f) + EPS);
      float m[8];
      const f32x4 s0 = snv[k][0], s1 = snv[k][1];
      _Pragma("unroll") for (int j = 0; j < 8; ++j) {
        const float obn = ob[j] * ro * siluf(bfs(vbg[k][j]));
        const float ocn = yg[j] * ry * (j < 4 ? s0[j & 3] : s1[j & 3]);
        m[j] = sigmf(bfs(vga[k][j])) * bfs(voa[k][j]) + sigmf(bfs(vgb[k][j])) * obn + sigmf(bfs(vgc[k][j])) * ocn;
      }
      st8(hrow + 512 * k, pack8(m));
    }
  }
}

DI void att_prompt_item(char* shm, const Params& P, int l, int hf, int b, int blk, int kvh) {
  u16* Ks = (u16*)shm;
  u16* Vt = Ks + 256 * 72;
  float* bias = (float*)(Vt + 64 * 268);
  u16* Z = (u16*)(optr(P.ws) + WS_Z);
  const float* bt = (const float*)(optr(P.ws) + WS_BT);
  const int tid = otid(), lane = tid & 63, w = tid >> 6;
  const int lr0 = b * 2048 + blk * 128 - hf * HALF_ROWS;
  const int g = w >> 1, qh = kvh * 4 + g, r = lane & 31, h = lane >> 5;
  bf16x8 qall[2][4];
  _Pragma("unroll") for (int qq = 0; qq < 2; ++qq) { const u16* qp = Z + (size_t)(lr0 + ((w & 1) * 2 + qq) * 32 + r) * ZS + C_AQ + qh * 64;
    _Pragma("unroll") for (int s = 0; s < 4; ++s) qall[qq][s] = ld8(qp + 16 * s + 8 * h); }
  const float sink = P.sinks[l * 16 + qh];
  const float btv = bt[(tid & 127) * 16 + kvh * 4 + (tid >> 7)];
  __syncthreads();
  {
    bf16x8 kr[4], vr[4];
    _Pragma("unroll") for (int it = 0; it < 4; ++it) { const int c = tid + it * NT, key = c >> 3, part = c & 7;
      if (blk > 0 || key >= 128) { const u16* src = Z + (size_t)(lr0 - 128 + key) * ZS; kr[it] = ld8(src + C_AK + kvh * 64 + part * 8); vr[it] = ld8(src + C_AV + kvh * 64 + part * 8); }
      else { _Pragma("unroll") for (int j = 0; j < 8; ++j) { kr[it][j] = 0; vr[it][j] = 0; } } }
    _Pragma("unroll") for (int it = 0; it < 4; ++it) { const int c = tid + it * NT, key = c >> 3, part = c & 7;
      st8(Ks + key * 72 + part * 8, kr[it]);
      _Pragma("unroll") for (int jj = 0; jj < 8; ++jj) Vt[(part * 8 + jj) * 268 + key] = (u16)vr[it][jj]; }
  }
  { const int g3 = tid >> 7, dist = tid & 127; bias[g3 * 192 + 32 + dist] = btv * 1.4426950408889634f;
    if (tid < 256) { const int g2 = tid >> 6, k = tid & 63; bias[g2 * 192 + (k < 32 ? k : 128 + k)] = 0.f; } }
  __syncthreads();
  _Pragma("unroll") for (int qq = 0; qq < 2; ++qq) {
    const int qt = (w & 1) * 2 + qq, qi = qt * 32 + r;
    u16* qrow = Z + (size_t)(lr0 + qi) * ZS + C_AQ + qh * 64;
    bf16x8 qf[4];
    _Pragma("unroll") for (int s = 0; s < 4; ++s) qf[s] = qall[qq][s];
    f32x16 O0 = zero16(), O1 = zero16();
    float m = sink * 1.4426950408889634f, lsum = 1.f;
    const int kt0 = (blk == 0) ? 4 : qt;
    _Pragma("unroll 1") for (int kt = kt0; kt <= qt + 4; ++kt) {
      f32x16 S = zero16();
      _Pragma("unroll") for (int s = 0; s < 4; ++s) { const bf16x8 kf = ld8(Ks + (kt * 32 + r) * 72 + 16 * s + 8 * h); S = MFMA32(kf, qf[s], S); }
      const float* bp = bias + g * 192 + 32 + (qi - 32 * kt + 128 - 4 * h);
      float mloc = -INFINITY;
      _Pragma("unroll") for (int i = 0; i < 16; ++i) S[i] = fmaf(S[i], 0.125f * 1.4426950408889634f, bp[-((i & 3) + 8 * (i >> 2))]);
      if (kt == qt) { _Pragma("unroll") for (int i = 0; i < 16; ++i) S[i] = (crow(i, h) > r) ? S[i] : -INFINITY; }
      if (kt == qt + 4) { _Pragma("unroll") for (int i = 0; i < 16; ++i) S[i] = (crow(i, h) <= r) ? S[i] : -INFINITY; }
      _Pragma("unroll") for (int i = 0; i < 16; ++i) mloc = fmaxf(mloc, S[i]);
      mloc = fmaxf(mloc, shx(mloc, 32, lane));
      const float mnew = fmaxf(m, mloc), alpha = __builtin_amdgcn_exp2f(m - mnew);
      float ps = 0.f;
      _Pragma("unroll") for (int i = 0; i < 16; ++i) { const float p = __builtin_amdgcn_exp2f(S[i] - mnew); S[i] = p; ps += p; }
      ps += shx(ps, 32, lane);
      lsum = lsum * alpha + ps; m = mnew;
      _Pragma("unroll") for (int i = 0; i < 16; ++i) { O0[i] *= alpha; O1[i] *= alpha; }
      const bf16x8 p0 = packP<0>(S), p1 = packP<1>(S);
      { const u16* vp = Vt + (r) * 268 + kt * 32 + 4 * h;
        O0 = MFMA32(cat4(*(const s16x4*)vp, *(const s16x4*)(vp + 8)), p0, O0);
        O0 = MFMA32(cat4(*(const s16x4*)(vp + 16), *(const s16x4*)(vp + 24)), p1, O0); }
      { const u16* vp = Vt + (32 + r) * 268 + kt * 32 + 4 * h;
        O1 = MFMA32(cat4(*(const s16x4*)vp, *(const s16x4*)(vp + 8)), p0, O1);
        O1 = MFMA32(cat4(*(const s16x4*)(vp + 16), *(const s16x4*)(vp + 24)), p1, O1); }
    }
    const float inv = __builtin_amdgcn_rcpf(lsum);
    _Pragma("unroll") for (int gq = 0; gq < 4; ++gq) {
      st4bf(qrow + 8 * gq + 4 * h, O0[4 * gq] * inv, O0[4 * gq + 1] * inv, O0[4 * gq + 2] * inv, O0[4 * gq + 3] * inv);
      st4bf(qrow + 32 + 8 * gq + 4 * h, O1[4 * gq] * inv, O1[4 * gq + 1] * inv, O1[4 * gq + 2] * inv, O1[4 * gq + 3] * inv);
    }
  }
  if (blk == 15) {
    float* wk = P.out + O_WKP + (size_t)(l * 16 + b) * 128 * 256 + kvh * 64;
    float* wv = P.out + O_WVP + (size_t)(l * 16 + b) * 128 * 256 + kvh * 64;
    for (int idx = tid; idx < 128 * 64; idx += NT) { const int j = idx >> 6, d = idx & 63; wk[j * 256 + d] = bf2f(Ks[(128 + j) * 72 + d]); wv[j * 256 + d] = bf2f(Vt[d * 268 + 128 + j]); }
  }
}

DI void ret_prompt_item(char* shm, const Params& P, int l, int hf, int b, int hd) {
  u16* QQ = (u16*)shm;
  u16* KK = QQ + 128 * 72;
  u16* KKt = KK + 128 * 72;
  u16* Vt = KKt + 64 * 136;
  u16* St = Vt + 128 * 136;
  float* th = (float*)(St + 128 * 72);
  u16* Z = (u16*)(optr(P.ws) + WS_Z);
  const int tid = otid(), lane = tid & 63, w = tid >> 6, r = lane & 31, hh = lane >> 5;
  const float log2g = log2f(1.f - exp2f(-5.f - (float)hd));
  const float g128 = exp2f(log2g * 128.f);
  __syncthreads();
  for (int e = tid; e < 128 * 72; e += NT) St[e] = 0;
  if (tid < 32) th[tid] = 1.f / powf(10000.f, (float)tid / 31.f);
  f32x16 Sacc = zero16();
  const int lt = w & 3, eh = w >> 2;
  bf16x8 qv[2], kv[2], vv[4];
#define RET_ISSUE(cc) do { const int _lr = b * 2048 + (cc) * 128 - hf * HALF_ROWS; \
    _Pragma("unroll") for (int it = 0; it < 2; ++it) { const int idx = tid + it * NT, row = idx & 127, part = idx >> 7; \
      const u16* zr = Z + (size_t)(_lr + row) * ZS; qv[it] = ld8(zr + C_BQ + hd * 64 + part * 8); kv[it] = ld8(zr + C_BK + hd * 64 + part * 8); } \
    _Pragma("unroll") for (int it = 0; it < 4; ++it) { const int idx = tid + it * NT, row = idx & 127, part = idx >> 7; \
      vv[it] = ld8(Z + (size_t)(_lr + row) * ZS + C_BV + hd * 128 + part * 8); } } while (0)
  RET_ISSUE(0);
  _Pragma("unroll 1") for (int c = 0; c < 16; ++c) {
    const int tok0 = c * 128;
    const int lrow0 = b * 2048 + tok0 - hf * HALF_ROWS;
    __syncthreads();
    {
      _Pragma("unroll") for (int it = 0; it < 2; ++it) {
        const int idx = tid + it * NT, row = idx & 127, part = idx >> 7;
        const float pos = (float)(tok0 + row);
        const float gq = exp2f(log2g * (float)(row + 1)), gk = 0.125f * exp2f(-log2g * (float)(row + 1));
        float qo[8], ko[8];
        _Pragma("unroll") for (int pr = 0; pr < 4; ++pr) {
          float sn, cs; sincos_rev(pos * th[part * 4 + pr], sn, cs);
          const float q1 = bfs(qv[it][2 * pr]), q2 = bfs(qv[it][2 * pr + 1]), k1 = bfs(kv[it][2 * pr]), k2 = bfs(kv[it][2 * pr + 1]);
          qo[2 * pr] = (q1 * cs - q2 * sn) * gq; qo[2 * pr + 1] = (q1 * sn + q2 * cs) * gq;
          ko[2 * pr] = (k1 * cs - k2 * sn) * gk; ko[2 * pr + 1] = (k1 * sn + k2 * cs) * gk;
        }
        st8(QQ + row * 72 + part * 8, pack8(qo));
        st8(KK + row * 72 + part * 8, pack8(ko));
        _Pragma("unroll") for (int jj = 0; jj < 8; ++jj) KKt[(part * 8 + jj) * 136 + row] = f2bf(ko[jj]);
      }
      _Pragma("unroll") for (int it = 0; it < 4; ++it) { const int idx = tid + it * NT, row = idx & 127, part = idx >> 7;
        _Pragma("unroll") for (int jj = 0; jj < 8; ++jj) Vt[(part * 8 + jj) * 136 + row] = (u16)vv[it][jj]; }
    }
    if (c + 1 < 16) RET_ISSUE(c + 1);
    __syncthreads();
    bf16x8 qf[4];
    _Pragma("unroll") for (int s = 0; s < 4; ++s) qf[s] = ld8(QQ + (lt * 32 + r) * 72 + 16 * s + 8 * hh);
    f32x16 O0 = zero16(), O1 = zero16();
    _Pragma("unroll") for (int s = 0; s < 4; ++s) {
      O0 = MFMA32(ld8(St + ((2 * eh) * 32 + r) * 72 + 16 * s + 8 * hh), qf[s], O0);
      O1 = MFMA32(ld8(St + ((2 * eh + 1) * 32 + r) * 72 + 16 * s + 8 * hh), qf[s], O1);
    }
    _Pragma("unroll 1") for (int mk = 0; mk <= lt; ++mk) {
      f32x16 Aa = zero16();
      _Pragma("unroll") for (int s = 0; s < 4; ++s) Aa = MFMA32(ld8(KK + (mk * 32 + r) * 72 + 16 * s + 8 * hh), qf[s], Aa);
      if (mk == lt) _Pragma("unroll") for (int i = 0; i < 16; ++i) if (crow(i, hh) > r) Aa[i] = 0.f;
      const bf16x8 p0 = packP<0>(Aa), p1 = packP<1>(Aa);
      { const u16* vp = Vt + ((2 * eh) * 32 + r) * 136 + mk * 32 + 4 * hh;
        O0 = MFMA32(cat4(*(const s16x4*)vp, *(const s16x4*)(vp + 8)), p0, O0);
        O0 = MFMA32(cat4(*(const s16x4*)(vp + 16), *(const s16x4*)(vp + 24)), p1, O0); }
      { const u16* vp = Vt + ((2 * eh + 1) * 32 + r) * 136 + mk * 32 + 4 * hh;
        O1 = MFMA32(cat4(*(const s16x4*)vp, *(const s16x4*)(vp + 8)), p0, O1);
        O1 = MFMA32(cat4(*(const s16x4*)(vp + 16), *(const s16x4*)(vp + 24)), p1, O1); }
    }
    { u16* orow = Z + (size_t)(lrow0 + lt * 32 + r) * ZS + C_BV + hd * 128 + (2 * eh) * 32;
      _Pragma("unroll") for (int gq = 0; gq < 4; ++gq) {
        st4bf(orow + 8 * gq + 4 * hh, O0[4 * gq], O0[4 * gq + 1], O0[4 * gq + 2], O0[4 * gq + 3]);
        st4bf(orow + 32 + 8 * gq + 4 * hh, O1[4 * gq], O1[4 * gq + 1], O1[4 * gq + 2], O1[4 * gq + 3]);
      } }
    _Pragma("unroll") for (int s = 0; s < 8; ++s)
      Sacc = MFMA32(ld8(Vt + (lt * 32 + r) * 136 + 16 * s + 8 * hh), ld8(KKt + (eh * 32 + r) * 136 + 16 * s + 8 * hh), Sacc);
    _Pragma("unroll") for (int i = 0; i < 16; ++i) Sacc[i] *= g128;
    __syncthreads();
    _Pragma("unroll") for (int i = 0; i < 16; ++i) St[(lt * 32 + crow(i, hh)) * 72 + eh * 32 + r] = f2bf(Sacc[i]);
  }
  float* so = P.out + O_RETP + (size_t)((l * 16 + b) * 8 + hd) * 8192 + (size_t)(eh * 32 + r) * 128 + lt * 32;
  _Pragma("unroll") for (int gq = 0; gq < 4; ++gq) *reinterpret_cast<f32x4*>(so + 8 * gq + 4 * hh) = (f32x4){Sacc[4 * gq], Sacc[4 * gq + 1], Sacc[4 * gq + 2], Sacc[4 * gq + 3]};
}

DI void ssd_prompt_item(char* shm, const Params& P, int l, int hf, int b, int hc) {
  u16* Bm = (u16*)shm;
  u16* Cm = Bm + 128 * 136;
  u16* Xs = Cm + 128 * 136;
  u16* XwT = Xs + 64 * 136;
  u16* Hs = XwT + 64 * 136;
  float* acum = (float*)(Hs + 64 * 136);
  float* dtv = acum + 128;
  float* tot = dtv + 128;
  const u16* Z = (const u16*)(optr(P.ws) + WS_Z);
  u16* YC = (u16*)(optr(P.ws) + WS_YC);
  const u16* XBC = (const u16*)(optr(P.ws) + WS_XBC);
  const float* DT = (const float*)(optr(P.ws) + WS_DT);
  const int tid = otid(), lane = tid & 63, w = tid >> 6, r = lane & 31, hh = lane >> 5;
  const int g = hc >> 3;
  const float Aneg = -expf(P.A_log[l * 16 + hc]), dtb = P.dt_bias[l * 16 + hc], dsk = P.D_skip[l * 16 + hc];
  const float* cw = P.conv_w + (size_t)l * 4 * 1536;
  const float* cb = P.conv_b + (size_t)l * 1536;
  const int lrowb = b * 2048 - hf * HALF_ROWS;
  __syncthreads();
  for (int e = tid; e < 64 * 136; e += NT) Hs[e] = 0;
  f32x16 Hacc = zero16();
  const int pt = w >> 2, it = w & 3;
  bf16x8 pB[4], pC[4], pX[2]; float pdt = 0.f;
#define SSD_ISSUE(cc) do { const int _t0 = (cc) * 128; \
    _Pragma("unroll") for (int itr = 0; itr < 4; ++itr) { const int idx = tid + itr * NT, row = idx >> 4, part = idx & 15; \
      const u16* _p = XBC + (size_t)(lrowb + _t0 + row) * 1536 + g * 128 + part * 8; pB[itr] = ld8(_p + 1024); pC[itr] = ld8(_p + 1280); } \
    _Pragma("unroll") for (int itr = 0; itr < 2; ++itr) { const int idx = tid + itr * NT, row = idx & 127, part = idx >> 7; \
      pX[itr] = ld8(XBC + (size_t)(lrowb + _t0 + row) * 1536 + hc * 64 + part * 8); } \
    if (tid < 128) pdt = DT[(size_t)(lrowb + _t0 + tid) * 16 + hc]; } while (0)
  SSD_ISSUE(0);
  _Pragma("unroll 1") for (int c = 0; c < 16; ++c) {
    const int tok0 = c * 128;
    bf16x8 xr[2]; xr[0] = pX[0]; xr[1] = pX[1];
    if (tid < 128) {
      const float dt = pdt;
      float v = dt * Aneg;
      for (int o = 1; o < 64; o <<= 1) { const float t = shup(v, o, lane); if (lane >= o) v += t; }
      dtv[tid] = dt; acum[tid] = v;
      if (tid == 63) tot[0] = v;
    }
    _Pragma("unroll") for (int itr = 0; itr < 4; ++itr) { const int idx = tid + itr * NT, row = idx >> 4, part = idx & 15;
      st8(Bm + row * 136 + part * 8, pB[itr]); st8(Cm + row * 136 + part * 8, pC[itr]); }
    __syncthreads();
    if (tid >= 64 && tid < 128) acum[tid] += tot[0];
    __syncthreads();
    const float alast = acum[127];
    _Pragma("unroll") for (int itr = 0; itr < 2; ++itr) {
      const int idx = tid + itr * NT, row = idx & 127, part = idx >> 7;
      const float wj = __expf(alast - acum[row]) * dtv[row];
      _Pragma("unroll") for (int j = 0; j < 8; ++j) { const float xs = bfs(xr[itr][j]); Xs[(part * 8 + j) * 136 + row] = (u16)xr[itr][j]; XwT[(part * 8 + j) * 136 + row] = f2bf(xs * wj); }
    }
    if (c + 1 < 16) SSD_ISSUE(c + 1);
    __syncthreads();
    const u16* cfp = Cm + (it * 32 + r) * 136 + 8 * hh;
    f32x16 Y = zero16();
    _Pragma("unroll") for (int s = 0; s < 8; ++s) Y = MFMA32(ld8(Hs + (pt * 32 + r) * 136 + 16 * s + 8 * hh), ld8(cfp + 16 * s), Y);
    const float ai = acum[it * 32 + r];
    { const float ea = __expf(ai); _Pragma("unroll") for (int i = 0; i < 16; ++i) Y[i] *= ea; }
    _Pragma("unroll 1") for (int jt = 0; jt <= it; ++jt) {
      f32x16 Gm = zero16();
      _Pragma("unroll") for (int s = 0; s < 8; ++s) Gm = MFMA32(ld8(Bm + (jt * 32 + r) * 136 + 16 * s + 8 * hh), ld8(cfp + 16 * s), Gm);
      _Pragma("unroll") for (int i = 0; i < 16; ++i) {
        const int jl = crow(i, hh), j = jt * 32 + jl;
        const float v = Gm[i] * __expf(ai - acum[j]) * dtv[j];
        Gm[i] = (jt == it && jl > r) ? 0.f : v;
      }
      const bf16x8 p0 = packP<0>(Gm), p1 = packP<1>(Gm);
      const u16* xp = Xs + (pt * 32 + r) * 136 + jt * 32 + 4 * hh;
      Y = MFMA32(cat4(*(const s16x4*)xp, *(const s16x4*)(xp + 8)), p0, Y);
      Y = MFMA32(cat4(*(const s16x4*)(xp + 16), *(const s16x4*)(xp + 24)), p1, Y);
    }
    _Pragma("unroll") for (int i = 0; i < 16; ++i) Y[i] += dsk * bf2f(Xs[(pt * 32 + crow(i, hh)) * 136 + it * 32 + r]);
    { u16* yrow = YC + (size_t)(lrowb + tok0 + it * 32 + r) * D + hc * 64 + pt * 32;
      _Pragma("unroll") for (int gq = 0; gq < 4; ++gq) st4bf(yrow + 8 * gq + 4 * hh, Y[4 * gq], Y[4 * gq + 1], Y[4 * gq + 2], Y[4 * gq + 3]); }
    { const float dl = __expf(alast); _Pragma("unroll") for (int i = 0; i < 16; ++i) Hacc[i] *= dl; }
    _Pragma("unroll") for (int s = 0; s < 8; ++s) {
      const bf16x8 xf = ld8(XwT + (pt * 32 + r) * 136 + 16 * s + 8 * hh);
      const u16* bp = Bm + (16 * s + 8 * hh) * 136 + it * 32 + r;
      u32x4 pb;
      _Pragma("unroll") for (int q = 0; q < 4; ++q) pb[q] = (unsigned)bp[(2 * q) * 136] | ((unsigned)bp[(2 * q + 1) * 136] << 16);
      Hacc = MFMA32(xf, __builtin_bit_cast(bf16x8, pb), Hacc);
    }
    __syncthreads();
    _Pragma("unroll") for (int i = 0; i < 16; ++i) Hs[(pt * 32 + crow(i, hh)) * 136 + it * 32 + r] = f2bf(Hacc[i]);
  }
  { float* ho = P.out + O_SSMP + (size_t)((l * 16 + b) * 16 + hc) * 8192;
    _Pragma("unroll") for (int i = 0; i < 16; ++i) ho[(pt * 32 + crow(i, hh)) * 128 + it * 32 + r] = Hacc[i]; }
  { float* co = P.out + O_CONVP + (size_t)(l * 16 + b) * 3 * 1536;
    for (int e = tid; e < 3 * 64; e += NT) { const int i = e >> 6, ch = hc * 64 + (e & 63); co[i * 1536 + ch] = bf2f(Z[(size_t)(lrowb + 2045 + i) * ZS + C_CX + ch]); }
    if ((hc & 7) == 0) for (int e = tid; e < 3 * 256; e += NT) { const int i = e >> 8, q = e & 255; const int ch = (q < 128 ? 1024 : 1280 - 128) + g * 128 + q; co[i * 1536 + ch] = bf2f(Z[(size_t)(lrowb + 2045 + i) * ZS + C_CX + ch]); } }
}

DI void ssd_sample_item(char* shm, const Params& P, int l, int s, int g) {
  float* xs = (float*)shm;
  float* Bs = xs + 512;
  float* Cs = Bs + 128;
  float* dts = Cs + 128;
  const int tid = otid(), lane = tid & 63, w = tid >> 6;
  const int lr = MPROMPT + s - HALF_ROWS;
  const u16* zr = (const u16*)(optr(P.ws) + WS_Z) + (size_t)lr * ZS;
  u16* YC = (u16*)(optr(P.ws) + WS_YC) + (size_t)lr * D;
  const float* cw = P.conv_w + (size_t)l * 4 * 1536;
  const float* cb = P.conv_b + (size_t)l * 1536;
  const float* hist = P.state_conv + (size_t)(l * 128 + s) * 3 * 1536;
  float* cso = P.out + O_CONVS + (size_t)(l * 128 + s) * 3 * 1536;
  __syncthreads();
  for (int u = tid; u < 768; u += NT) {
    int ch; float* dst;
    if (u < 512) { ch = g * 512 + u; dst = xs + u; } else if (u < 640) { ch = 1024 + g * 128 + (u - 512); dst = Bs + (u - 512); } else { ch = 1280 + g * 128 + (u - 640); dst = Cs + (u - 640); }
    const float h0 = hist[ch], h1 = hist[1536 + ch], h2 = hist[2 * 1536 + ch], nw = bf2f(zr[C_CX + ch]);
    const float a = cb[ch] + cw[ch] * h0 + cw[1536 + ch] * h1 + cw[2 * 1536 + ch] * h2 + cw[3 * 1536 + ch] * nw;
    *dst = siluf(a);
    cso[ch] = h1; cso[1536 + ch] = h2; cso[2 * 1536 + ch] = nw;
  }
  if (tid < 8) { const int hc = g * 8 + tid; const float dt = softplusf(bf2f(zr[C_DT + hc]) + P.dt_bias[l * 16 + hc]); dts[tid] = dt; dts[8 + tid] = expf(dt * -expf(P.A_log[l * 16 + hc])); }
  __syncthreads();
  const int hc = g * 8 + w;
  const float dt = dts[w], dA = dts[8 + w], dsk = P.D_skip[l * 16 + hc];
  const float* hin = P.state_ssm + (size_t)((l * 128 + s) * 16 + hc) * 8192;
  float* hout = P.out + O_SSMS + (size_t)((l * 128 + s) * 16 + hc) * 8192;
  const int n4 = (lane & 31) * 4, psub = lane >> 5;
  const f32x4 Bv = *reinterpret_cast<const f32x4*>(Bs + n4), Cv = *reinterpret_cast<const f32x4*>(Cs + n4);
  {
    const int ib = 0;
    f32x4 hv[32];
    _Pragma("unroll") for (int k = 0; k < 32; ++k) hv[k] = __builtin_nontemporal_load(reinterpret_cast<const f32x4*>(hin + (k * 2 + psub) * 128 + n4));
    _Pragma("unroll") for (int k = 0; k < 32; ++k) {
      const int p = (ib * 16 + k) * 2 + psub;
      const float xv = xs[w * 64 + p];
      const f32x4 hn = hv[k] * dA + Bv * (dt * xv);
      __builtin_nontemporal_store(hn, reinterpret_cast<f32x4*>(hout + p * 128 + n4));
      float y = hn[0] * Cv[0] + hn[1] * Cv[1] + hn[2] * Cv[2] + hn[3] * Cv[3];
      for (int o = 16; o >= 1; o >>= 1) y += shx(y, o, lane);
      if ((lane & 31) == 0) YC[hc * 64 + p] = f2bf(y + dsk * xv);
    }
  }
}

DI void ret_sample_item(char* shm, const Params& P, int l, int s) {
  float* qk = (float*)shm;
  const int tid = otid(), lane = tid & 63, w = tid >> 6;
  const int lr = MPROMPT + s - HALF_ROWS;
  u16* zr = (u16*)(optr(P.ws) + WS_Z) + (size_t)lr * ZS;
  __syncthreads();
  const float gamma = 1.f - exp2f(-5.f - (float)w);
  if (lane < 32) {
    const float th = 1.f / powf(10000.f, (float)lane / 31.f);
    float sn, cs; sincos_rev(16384.f * th, sn, cs);
    const float q1 = bf2f(zr[C_BQ + w * 64 + 2 * lane]), q2 = bf2f(zr[C_BQ + w * 64 + 2 * lane + 1]);
    const float k1 = bf2f(zr[C_BK + w * 64 + 2 * lane]) * 0.125f, k2 = bf2f(zr[C_BK + w * 64 + 2 * lane + 1]) * 0.125f;
    qk[w * 128 + 2 * lane] = q1 * cs - q2 * sn; qk[w * 128 + 2 * lane + 1] = q1 * sn + q2 * cs;
    qk[w * 128 + 64 + 2 * lane] = k1 * cs - k2 * sn; qk[w * 128 + 64 + 2 * lane + 1] = k1 * sn + k2 * cs;
  }
  const int e4 = (lane & 31) * 4, dsub = lane >> 5;
  f32x4 v4;
  _Pragma("unroll") for (int j = 0; j < 4; ++j) v4[j] = bf2f(zr[C_BV + w * 128 + e4 + j]);
  __syncthreads();
  const float* Sin = P.state_ret + (size_t)((l * 128 + s) * 8 + w) * 8192;
  float* Sout = P.out + O_RETS + (size_t)((l * 128 + s) * 8 + w) * 8192;
  f32x4 o4 = (f32x4){0.f, 0.f, 0.f, 0.f};
  {
    const int ib = 0;
    f32x4 sv[32];
    _Pragma("unroll") for (int k = 0; k < 32; ++k) sv[k] = __builtin_nontemporal_load(reinterpret_cast<const f32x4*>(Sin + (k * 2 + dsub) * 128 + e4));
    _Pragma("unroll") for (int k = 0; k < 32; ++k) {
      const int d = (ib * 16 + k) * 2 + dsub;
      const f32x4 sn = sv[k] * gamma + v4 * qk[w * 128 + 64 + d];
      __builtin_nontemporal_store(sn, reinterpret_cast<f32x4*>(Sout + d * 128 + e4));
      o4 += sn * qk[w * 128 + d];
    }
  }
  _Pragma("unroll") for (int j = 0; j < 4; ++j) o4[j] += shx(o4[j], 32, lane);
  if (dsub == 0) st4bf(zr + C_BV + w * 128 + e4, o4[0], o4[1], o4[2], o4[3]);
}

DI void att_sample_item(char* shm, const Params& P, int l, int s) {
  float* Kc = (float*)shm;
  float* Vc = Kc + 129 * 65;
  float* qv = Vc + 129 * 65;
  float* sc = qv + 256;
  float* red = sc + 512;
  const int tid = otid(), lane = tid & 63, w = tid >> 6;
  const int lr = MPROMPT + s - HALF_ROWS;
  u16* zr = (u16*)(optr(P.ws) + WS_Z) + (size_t)lr * ZS;
  const float* bt = (const float*)(optr(P.ws) + WS_BT);
  const float* ck = P.cache_k + (size_t)(l * 128 + s) * 128 * 256;
  const float* cv = P.cache_v + (size_t)(l * 128 + s) * 128 * 256;
  float* ok = P.out + O_WKS + (size_t)(l * 128 + s) * 128 * 256;
  float* ov = P.out + O_WVS + (size_t)(l * 128 + s) * 128 * 256;
  _Pragma("unroll 1") for (int kvh = 0; kvh < 4; ++kvh) {
    __syncthreads();
    {
      const int d4 = (tid & 15) * 4;
      f32x4 kk[4], vv[4];
      _Pragma("unroll") for (int itr = 0; itr < 4; ++itr) { const int j = (tid >> 4) + 32 * itr;
        kk[itr] = __builtin_nontemporal_load(reinterpret_cast<const f32x4*>(ck + j * 256 + kvh * 64 + d4)); vv[itr] = __builtin_nontemporal_load(reinterpret_cast<const f32x4*>(cv + j * 256 + kvh * 64 + d4)); }
      _Pragma("unroll") for (int itr = 0; itr < 4; ++itr) { const int j = (tid >> 4) + 32 * itr;
        _Pragma("unroll") for (int q = 0; q < 4; ++q) { Kc[j * 65 + d4 + q] = kk[itr][q]; Vc[j * 65 + d4 + q] = vv[itr][q]; }
        if (j >= 1) { __builtin_nontemporal_store(kk[itr], reinterpret_cast<f32x4*>(ok + (j - 1) * 256 + kvh * 64 + d4)); __builtin_nontemporal_store(vv[itr], reinterpret_cast<f32x4*>(ov + (j - 1) * 256 + kvh * 64 + d4)); } }
    }
    if (tid < 64) { const float kn = bf2f(zr[C_AK + kvh * 64 + tid]), vn = bf2f(zr[C_AV + kvh * 64 + tid]); Kc[128 * 65 + tid] = kn; Vc[128 * 65 + tid] = vn; ok[127 * 256 + kvh * 64 + tid] = kn; ov[127 * 256 + kvh * 64 + tid] = vn; }
    if (tid < 256) qv[tid] = bf2f(zr[C_AQ + kvh * 256 + tid]);
    __syncthreads();
    const int g = tid >> 7, c = 1 + (tid & 127), qh = kvh * 4 + g;
    float dot = 0.f;
    _Pragma("unroll 1") for (int d = 0; d < 64; ++d) dot += qv[g * 64 + d] * Kc[c * 65 + d];
    const float score = dot * 0.125f + bt[(128 - c) * 16 + qh];
    float mx = score;
    for (int o = 32; o >= 1; o >>= 1) mx = fmaxf(mx, shx(mx, o, lane));
    if (lane == 0) red[w] = mx;
    __syncthreads();
    const float sink = P.sinks[l * 16 + qh];
    const float m = fmaxf(fmaxf(red[2 * g], red[2 * g + 1]), sink);
    const float e = __expf(score - m);
    float sm = e;
    for (int o = 32; o >= 1; o >>= 1) sm += shx(sm, o, lane);
    if (lane == 0) red[8 + w] = sm;
    __syncthreads();
    const float den = red[8 + 2 * g] + red[8 + 2 * g + 1] + __expf(sink - m);
    sc[g * 128 + (c - 1)] = e * __builtin_amdgcn_rcpf(den);
    __syncthreads();
    if (tid < 256) {
      const int g2 = tid >> 6, d = tid & 63; float o = 0.f;
      for (int cc = 1; cc <= 128; ++cc) o += sc[g2 * 128 + cc - 1] * Vc[cc * 65 + d];
      zr[C_AQ + (kvh * 4 + g2) * 64 + d] = f2bf(o);
    }
  }
}

DI void mixer_phase(char* shm, const Params& P, int l, int hf, int ph) {
  __shared__ int s_item;
  unsigned* ctr = (unsigned*)(optr(P.ws) + WS_CTR) + ph;
  const int nitems = 128 + 64 + 512 + (hf ? 512 : 0);
  for (;;) {
    __syncthreads();
    if (threadIdx.x == 0) s_item = (int)atomicAdd(ctr, 1u);
    __syncthreads();
    int it = s_item;
    if (it >= nitems) break;
    const int nsamp = hf ? 512 : 0;
    if (it < 128) { ssd_prompt_item(shm, P, l, hf, hf * 8 + (it >> 4), it & 15); }
    else if ((it -= 128) < 64) { ret_prompt_item(shm, P, l, hf, hf * 8 + (it >> 3), it & 7); }
    else if ((it -= 64) < nsamp) {
      if (it < 256) { ssd_sample_item(shm, P, l, it >> 1, it & 1); }
      else if ((it -= 256) < 128) { ret_sample_item(shm, P, l, it); }
      else { it -= 128; att_sample_item(shm, P, l, it); }
    }
    else { it -= nsamp; att_prompt_item(shm, P, l, hf, hf * 8 + (it >> 6), (it >> 2) & 15, it & 3); }
  }
}

#define SEQ0 0x87543210ull
#define LEN0 8
#define SEQ1 0x8754321ull
#define LEN1 7
constexpr int PH_G0 = 3;
constexpr int N_PHASES = PH_G0 + 2 * (LEN0 + LEN1) + 1;
#ifndef MAXPH
#define MAXPH N_PHASES
#endif
__global__ void __launch_bounds__(NT) fwd_kernel(Params P) {
  extern __shared__ __attribute__((aligned(16))) unsigned char lds[];
  char* shm = (char*)lds;
  cg::grid_group grid = cg::this_grid();
  unsigned char* ws = P.ws;
  const float* mod = (const float*)(ws + WS_MOD);
  for (int ph = P.ph_lo; ph < P.ph_hi; ++ph) {
    if (ph > P.ph_lo) grid.sync();
    if (ph == 0) { prep_phase(shm, P); continue; }
    if (ph == N_PHASES - 1) { final_norm_phase(P); continue; }
    const int q = (ph < PH_G0) ? 0 : ph - PH_G0, hf = q / (LEN0 + LEN1), qq = q % (LEN0 + LEN1), l = (qq >= LEN0) ? 1 : 0;
    const int sub = (ph == 1) ? 9 : (ph == 2) ? 10 : l ? (int)((SEQ1 >> (4 * (qq - LEN0))) & 15ull) : (int)((SEQ0 >> (4 * qq)) & 15ull);
    const int ntm = hf ? 65 : 64, RB = hf * HALF_ROWS, NV = hf ? 16512 : 16384;
    if (sub == 0) { norm_phase(P, l, hf, 0, l == 0); continue; }
    if (sub == 2) { conv_phase(P, l, hf); continue; }
    if (sub == 3) { mixer_phase(shm, P, l, hf, ph); continue; }
    if (sub == 4) { mix_phase(P, l, hf); continue; }
    Epi E{};
    const int Gd = gridDim.x;
    const int bxr = (Gd % 8 == 0) ? (int)((blockIdx.x % 8) * (Gd / 8) + blockIdx.x / 8) : (int)blockIdx.x;
    const int cw = (bxr < 41) ? 0 : (bxr < 57) ? 1 : 2;
    const bool first_res = (sub == 5 && l == 0);
    E.kind = (sub == 9) ? 3 : (sub == 10) ? 6 : (sub == 1) ? 0 : (sub == 7) ? 1 : 2;
    E.c16 = (u16*)(ws + WS_Z); E.ldc = (sub == 1) ? ZS : (sub == 10) ? (cw == 0 ? ZS : DFF) : DFF;
    E.rb = RB; E.nv = NV; E.xout = P.out; E.mod = mod; E.goff = l * 6144 + ((sub == 5) ? 2048 : 5120);
    E.res_p = first_res ? P.x_prompt : (const float*)P.out;
    E.res_s = first_res ? P.x_sample : (const float*)(P.out + (size_t)MPROMPT * D);
    E.modout = (float*)(ws + WS_MOD); E.ada_b = P.ada_b; E.shb = (u16*)(ws + WS_SHB);
    E.cout = (float*)(ws + ((cw == 0) ? WS_C1 : WS_C2 + (size_t)(cw - 1) * 144 * DFF * 4));
    E.fuse = (sub == 5 || (sub == 8 && l == 0)) ? 1 : 0;
    E.fw = (sub == 5) ? P.n2 + l * D : P.n1 + D;
    E.fsc = (sub == 5) ? l * 6144 + 4096 : 6144 + 1024;
    E.fa = (u16*)(ws + ((sub == 5) ? WS_XBC : WS_H));
    E.fss = (float*)(ws + ((sub == 5) ? WS_SS2 : WS_SS1));
    E.cons = (sub == 7 || (sub == 1 && l == 1)) ? 1 : 0;
    E.css = (const float*)(ws + ((sub == 7) ? WS_SS2 : WS_SS1));
    E.cc = (const float*)(ws + ((sub == 7) ? WS_C2 + (size_t)l * 144 * DFF * 4 : WS_C1));
    E.ccld = (sub == 7) ? DFF : ZS;
    const bf16* A = (const bf16*)(ws + ((sub == 9) ? WS_SC : (sub == 10) ? WS_SHB + (size_t)cw * 256 * D * 2 : (sub == 8) ? WS_Z : (sub == 7) ? WS_XBC : WS_H));
    const size_t boff = (sub == 9) ? WS_AWT : (sub == 10) ? (cw == 0 ? WS_WIN + (size_t)ZS * D * 2 : WS_WUP + (size_t)(cw - 1) * DFF * D * 2)
                      : (sub == 1) ? WS_WIN + (size_t)l * ZS * D * 2 : (sub == 5) ? WS_WOUT + (size_t)l * D * D * 2
                      : (sub == 7) ? WS_WUP + (size_t)l * DFF * D * 2 : WS_WDN + (size_t)l * D * DFF * 2;
    const bf16* Bt = (const bf16*)(ws + boff);
    const int K = (sub == 8) ? DFF : D;
    const int tm = (sub == 9 || sub == 10) ? 1 : ntm;
    const int tn = (sub == 9) ? 48 : (sub == 10) ? (cw == 0 ? 41 : 16) : (sub == 1) ? 41 : (sub == 7) ? 16 : 4;
    const int toff = (sub == 10) ? (cw == 0 ? 0 : cw == 1 ? 41 : 57) : 0;
    asm volatile("" : "+s"(E.xout), "+s"(E.res_p), "+s"(E.res_s), "+s"(E.mod), "+s"(A), "+s"(Bt), "+s"(E.fa), "+s"(E.fss), "+s"(E.css), "+s"(E.cc), "+s"(E.cout));
    gemm_phase(shm, A, Bt, K, tm, tn, E, (hf == 1 && sub == 8 && l == 1) ? 1 : 0, toff, (hf == 1 && sub != 9 && sub != 10) ? 1 : 0);
  }
}

extern "C" void kernel_launch(void* const* d_in, const int* in_sizes, int n_in, void* d_out, int out_size, void* d_ws, size_t ws_size, hipStream_t stream) {
  static int grid = 0;
  if (grid == 0) {
    if (n_in != 26 || ws_size < WS_END) { fprintf(stderr, "kernel_launch: bad inputs n_in=%d ws=%zu need %zu\n", n_in, ws_size, (size_t)WS_END); grid = -1; return; }
    int dev = 0, cus = 0, per_cu = 0;
    (void)hipGetDevice(&dev);
    (void)hipDeviceGetAttribute(&cus, hipDeviceAttributeMultiprocessorCount, dev);
    if (hipFuncSetAttribute((const void*)fwd_kernel, hipFuncAttributeMaxDynamicSharedMemorySize, LDS_BYTES) != hipSuccess) { fprintf(stderr, "hipFuncSetAttribute failed\n"); grid = -1; return; }
    (void)hipOccupancyMaxActiveBlocksPerMultiprocessor(&per_cu, (const void*)fwd_kernel, NT, LDS_BYTES);
    if (per_cu < 1) { fprintf(stderr, "occupancy query returned %d\n", per_cu); per_cu = 1; }
    (void)hipGetLastError();
    grid = cus * per_cu;
  }
  if (grid < 0) return;
  (void)hipMemsetAsync((char*)d_ws + WS_CTR, 0, 256, stream);
  Params p{};
  const float** pp = (const float**)&p;
  _Pragma("unroll") for (int i = 0; i < 26; ++i) pp[i] = (const float*)d_in[i];
  p.out = (float*)d_out; p.ws = (unsigned char*)d_ws;
#if FUSED
  p.ph_lo = 0; p.ph_hi = MAXPH;
  void* args[] = {&p};
  hipError_t e = hipLaunchCooperativeKernel((const void*)fwd_kernel, dim3(grid), dim3(NT), args, LDS_BYTES, stream);
  if (e != hipSuccess) fprintf(stderr, "cooperative launch failed: %s (grid %d)\n", hipGetErrorString(e), grid);
#else
  for (int ph = 0; ph < MAXPH; ++ph) {
    p.ph_lo = ph; p.ph_hi = ph + 1;
    hipLaunchKernelGGL(fwd_kernel, dim3(grid), dim3(NT), LDS_BYTES, stream, p);
  }
#endif
}
```

```cpp
#include <hip/hip_runtime.h>
#include <hip/hip_bf16.h>
#include <hip/hip_cooperative_groups.h>
#include <cstdio>
namespace cg = cooperative_groups;

#ifndef FUSED
#define FUSED 1
#endif

typedef unsigned short u16;
using bf16 = __hip_bfloat16;
using bf16x8 = __attribute__((ext_vector_type(8))) short;
using s16x4  = __attribute__((ext_vector_type(4))) short;
using f32x4  = __attribute__((ext_vector_type(4))) float;
using f32x16 = __attribute__((ext_vector_type(16))) float;
using u32x4  = __attribute__((ext_vector_type(4))) unsigned;
using u32x2  = __attribute__((ext_vector_type(2))) unsigned;
#define DI __device__ __forceinline__

constexpr int D = 1024, DIN = 10256, ZS = 10496, DFF = 4096;
constexpr int MPROMPT = 32768, MVALID = 32896;
constexpr int HALF_ROWS = 16384, ZROWS = 16640;
constexpr int C_AQ = 0, C_AK = 1024, C_AV = 1280, C_BQ = 1536, C_BK = 2048, C_BV = 2560, C_BG = 3584, C_CZ = 4608,
              C_CX = 5632, C_DT = 7168, C_GA = 7184, C_GB = 8208, C_GC = 9232;
constexpr int MODS = 12288;
constexpr float EPS = 1e-6f;
constexpr int NT = 512;

constexpr size_t O_YP = 0, O_YS = O_YP + 33554432, O_WKP = O_YS + 131072, O_WVP = O_WKP + 1048576, O_RETP = O_WVP + 1048576,
                 O_SSMP = O_RETP + 2097152, O_CONVP = O_SSMP + 4194304, O_WKS = O_CONVP + 147456, O_WVS = O_WKS + 8388608,
                 O_RETS = O_WVS + 8388608, O_SSMS = O_RETS + 16777216, O_CONVS = O_SSMS + 33554432;
constexpr size_t WS_CTR = 0, WS_BT = 256, WS_SC = 16384, WS_MOD = WS_SC + 524288, WS_AWT = WS_MOD + 7077888,
                 WS_WIN = WS_AWT + 25165824, WS_WOUT = WS_WIN + 42991616, WS_WUP = WS_WOUT + 4194304, WS_WDN = WS_WUP + 16777216,
                 WS_H = WS_WDN + 16777216, WS_YC = WS_H + 34078720, WS_Z = WS_YC + 34078720, WS_XBC = WS_Z + 349306880,
                 WS_DT = WS_XBC + 51118080, WS_SS1 = WS_DT + 1064960, WS_SS2 = WS_SS1 + 66560, WS_C1 = WS_SS2 + 66560,
                 WS_C2 = WS_C1 + 6045696, WS_SHB = WS_C2 + 4718592, WS_END = WS_SHB + 1572864;
constexpr int LDS_BYTES = 147456;

struct Params {
  const float *x_prompt, *x_sample, *cache_k, *cache_v, *state_ret, *state_ssm, *state_conv, *c_prompt, *c_sample, *rel, *sinks,
      *n1, *n2, *ada_w, *ada_b, *w_in, *conv_w, *conv_b, *dt_bias, *A_log, *D_skip, *snw, *w_out, *w_up, *w_down, *fnw;
  float* out; unsigned char* ws; int ph_lo, ph_hi;
};

typedef float f32x2v __attribute__((ext_vector_type(2)));
typedef __bf16 bf16x2v __attribute__((ext_vector_type(2)));
DI unsigned pack2(float a, float b) { f32x2v v = {a, b}; return __builtin_bit_cast(unsigned, __builtin_convertvector(v, bf16x2v)); }
DI u16 f2bf(float x) { return (u16)(pack2(x, 0.f) & 0xffffu); }
DI float bf2f(u16 h) { return __uint_as_float(((unsigned)h) << 16); }
DI float bfs(short h) { return __uint_as_float(((unsigned)(u16)h) << 16); }
DI bf16x8 ld8(const u16* p) { return *reinterpret_cast<const bf16x8*>(p); }
DI void st8(u16* p, bf16x8 v) { *reinterpret_cast<bf16x8*>(p) = v; }
DI bf16x8 cat4(s16x4 lo, s16x4 hi) { return __builtin_shufflevector(lo, hi, 0, 1, 2, 3, 4, 5, 6, 7); }
DI f32x16 zero16() { f32x16 v; _Pragma("unroll") for (int i = 0; i < 16; ++i) v[i] = 0.f; return v; }
DI int crow(int i, int h) { return (i & 3) + 8 * (i >> 2) + 4 * h; }
#define MFMA32(a, b, c) __builtin_amdgcn_mfma_f32_32x32x16_bf16((a), (b), (c), 0, 0, 0)
template <int S> DI bf16x8 packP(const f32x16& x) {
  u32x4 p; p[0] = pack2(x[8 * S], x[8 * S + 1]); p[1] = pack2(x[8 * S + 2], x[8 * S + 3]);
  p[2] = pack2(x[8 * S + 4], x[8 * S + 5]); p[3] = pack2(x[8 * S + 6], x[8 * S + 7]);
  return __builtin_bit_cast(bf16x8, p);
}
DI bf16x8 pack8(const float* v) {
  u32x4 p; p[0] = pack2(v[0], v[1]); p[1] = pack2(v[2], v[3]); p[2] = pack2(v[4], v[5]); p[3] = pack2(v[6], v[7]);
  return __builtin_bit_cast(bf16x8, p);
}
DI void st4bf(u16* p, float a, float b, float c, float d) { u32x2 v; v[0] = pack2(a, b); v[1] = pack2(c, d); *reinterpret_cast<u32x2*>(p) = v; }
DI float siluf(float x) { return x * __builtin_amdgcn_rcpf(1.f + __expf(-x)); }
DI float sigmf(float x) { return __builtin_amdgcn_rcpf(1.f + __expf(-x)); }
DI float softplusf(float x) { return x > 20.f ? x : log1pf(expf(x)); }
DI int otid() { int t = threadIdx.x; asm volatile("" : "+v"(t)); return t; }
#define GAS __attribute__((address_space(1)))
template <class T> DI T* gptr(T* p) { return (T*)(GAS T*)(unsigned long long)p; }
template <class T> DI T* optr(T* p) { unsigned long long v = (unsigned long long)p; asm volatile("" : "+s"(v)); return (T*)(GAS T*)v; }
DI float shx(float v, int m, int lane) { return __int_as_float(__builtin_amdgcn_ds_bpermute((lane ^ m) << 2, __float_as_int(v))); }
DI float shup(float v, int o, int lane) { return __int_as_float(__builtin_amdgcn_ds_bpermute((lane - o) << 2, __float_as_int(v))); }
DI int modrow(int r) { return r < MPROMPT ? (r >> 11) : 16 + (r - MPROMPT); }
DI void sincos_rev(float ang, float& s, float& c) {
  float k = rintf(ang * 0.15915494309189535f);
  float red = fmaf(-k, 6.28318548202514648f, ang);
  red = fmaf(-k, -1.7484555e-7f, red);
  float fr = red * 0.15915494309189535f;
  s = __builtin_amdgcn_sinf(fr); c = __builtin_amdgcn_cosf(fr);
}

constexpr int BM = 256, BK = 64, HALFT = 128, HT = HALFT * BK;
DI int lds_byte(int r, int c) { int st = (r >> 4) * 2 + (c >> 5), rr = r & 15, cc = c & 31, ob = rr * 64 + cc * 2; return st * 1024 + (ob ^ (((ob >> 9) & 1) << 5)); }
DI void stage_rc(int b, int& R, int& C) { int st = b / 1024, sb = b % 1024, swz = sb ^ (((sb >> 9) & 1) << 5); R = (st >> 1) * 16 + swz / 64; C = (st & 1) * 32 + (swz % 64) / 2; }

struct Epi {
  int kind;
  u16* c16; int ldc;
  int rb, nv;
  const float* res_p; const float* res_s;
  float* xout;
  const float* mod; int goff;
  float* modout; const float* ada_b;
  u16* shb;
  float* cout;
  int fuse;
  const float* fw; int fsc; u16* fa; float* fss;
  int cons;
  const float* css; const float* cc; int ccld;
};

#define LAS __attribute__((address_space(3)))
constexpr int HTB = HALFT * BK * 2;
DI void epilogue(const f32x4 (&acc)[2][2][4][2], const Epi& E, int brow, int bcol, int wr, int wc, int fr, int fq, int at) {
  const int col0 = bcol + wc * 32 + fq * 8;
  const int row0 = brow + wr * 64 + fr;
  const int lane = (fq << 4) | fr;
  const bool ptile = (E.rb + brow + 255) < MPROMPT;
  const int pb = (E.rb + brow) >> 11;
#define ECOL(j) (col0 + ((j) >> 1) * HALFT + ((j) & 1) * 4)
#define EROW(g) (row0 + ((g) >> 2) * HALFT + ((g) & 3) * 16)
#define EACC(g, j) acc[(g) >> 2][(j) >> 1][(g) & 3][(j) & 1]
  if (E.kind <= 1) {
    float ssv[8]; f32x4 cv[4];
    if (E.cons) {
      _Pragma("unroll") for (int g = 0; g < 8; ++g) ssv[g] = E.css[EROW(g)];
      if (ptile) { _Pragma("unroll") for (int j = 0; j < 4; ++j) cv[j] = *reinterpret_cast<const f32x4*>(E.cc + (size_t)pb * E.ccld + ECOL(j)); }
    }
    _Pragma("unroll") for (int g = 0; g < 8; ++g) {
      const int row = EROW(g);
      float rsv = 1.f;
      if (E.cons) {
        rsv = rsqrtf(ssv[g] * (1.f / D) + EPS);
        if (!ptile) { const int mrc = min(modrow(E.rb + row), 143);
          _Pragma("unroll") for (int j = 0; j < 4; ++j) cv[j] = *reinterpret_cast<const f32x4*>(E.cc + (size_t)mrc * E.ccld + ECOL(j)); }
      }
      _Pragma("unroll") for (int jb = 0; jb < 2; ++jb) {
        float o[8];
        _Pragma("unroll") for (int n = 0; n < 2; ++n) {
          f32x4 v = EACC(g, 2 * jb + n);
          if (E.cons) v = v * rsv + cv[2 * jb + n];
          if (E.kind == 1) { _Pragma("unroll") for (int q = 0; q < 4; ++q) { const float a = fmaxf(v[q], 0.f); v[q] = a * a; } }
          _Pragma("unroll") for (int q = 0; q < 4; ++q) o[4 * n + q] = v[q];
        }
        st8(E.c16 + (size_t)row * E.ldc + ECOL(2 * jb), pack8(o));
      }
    }
  } else if (E.kind == 2) {
    if (at) {
      _Pragma("unroll") for (int g = 0; g < 8; ++g) {
        const int row = EROW(g);
        if (row < E.nv) {
          const int r = E.rb + row;
          _Pragma("unroll") for (int j = 0; j < 4; ++j) {
            const f32x4 gg = *reinterpret_cast<const f32x4*>(E.mod + (size_t)modrow(r) * MODS + E.goff + ECOL(j));
            const f32x4 v = EACC(g, j);
            float* xp = E.xout + (size_t)r * D + ECOL(j);
            _Pragma("unroll") for (int q = 0; q < 4; ++q) unsafeAtomicAdd(xp + q, gg[q] * v[q]);
          }
        }
      }
    } else {
      f32x4 g4[4], w4[4], s4[4], xc[4], xq[4];
      const float* mrow0 = E.mod + (size_t)pb * MODS;
      if (ptile) { _Pragma("unroll") for (int j = 0; j < 4; ++j) { g4[j] = *reinterpret_cast<const f32x4*>(mrow0 + E.goff + ECOL(j));
          if (E.fuse) s4[j] = *reinterpret_cast<const f32x4*>(mrow0 + E.fsc + ECOL(j)); } }
      if (E.fuse) { _Pragma("unroll") for (int j = 0; j < 4; ++j) w4[j] = *reinterpret_cast<const f32x4*>(E.fw + ECOL(j)); }
#define LOADX(g, dst) do { const int _row = EROW(g); const int _r = E.rb + _row; \
        const float* _rs = (_r < MPROMPT) ? (E.res_p + (size_t)_r * D) : (E.res_s + (size_t)(_r - MPROMPT) * D); \
        _Pragma("unroll") for (int j = 0; j < 4; ++j) dst[j] = (_row < E.nv) ? *reinterpret_cast<const f32x4*>(_rs + ECOL(j)) : (f32x4){0.f, 0.f, 0.f, 0.f}; } while (0)
      LOADX(0, xc);
      _Pragma("unroll") for (int g = 0; g < 8; ++g) {
        const int row = EROW(g); const int r = E.rb + row; const bool ok = row < E.nv;
        if (g + 1 < 8) LOADX(g + 1, xq);
        if (!ptile && ok) { const float* mr = E.mod + (size_t)modrow(r) * MODS;
          _Pragma("unroll") for (int j = 0; j < 4; ++j) { g4[j] = *reinterpret_cast<const f32x4*>(mr + E.goff + ECOL(j)); if (E.fuse) s4[j] = *reinterpret_cast<const f32x4*>(mr + E.fsc + ECOL(j)); } }
        float ssq = 0.f;
        if (ok) {
          _Pragma("unroll") for (int j = 0; j < 4; ++j) {
            const f32x4 xn = xc[j] + g4[j] * EACC(g, j);
            *reinterpret_cast<f32x4*>(E.xout + (size_t)r * D + ECOL(j)) = xn;
            if (E.fuse) {
              const f32x4 a = xn * w4[j] * (s4[j] + 1.f);
              st4bf(E.fa + (size_t)row * D + ECOL(j), a[0], a[1], a[2], a[3]);
              ssq += xn[0] * xn[0] + xn[1] * xn[1] + xn[2] * xn[2] + xn[3] * xn[3];
            }
          }
        }
        if (E.fuse) {
          ssq += shx(ssq, 16, lane); ssq += shx(ssq, 32, lane);
          if (fq == 0 && ok) unsafeAtomicAdd(E.fss + row, ssq);
        }
        _Pragma("unroll") for (int j = 0; j < 4; ++j) xc[j] = xq[j];
      }
#undef LOADX
    }
  } else if (E.kind == 3) {
    _Pragma("unroll") for (int g = 0; g < 8; ++g) {
      const int row = EROW(g);
      if (row < 144) {
        _Pragma("unroll") for (int j = 0; j < 4; ++j) {
          const int col = ECOL(j);
          const f32x4 bb = *reinterpret_cast<const f32x4*>(E.ada_b + col);
          const f32x4 o = EACC(g, j) + bb;
          *reinterpret_cast<f32x4*>(E.modout + (size_t)row * MODS + col) = o;
          const int ch = col >> 10;
          const int sl = (ch == 6) ? 0 : (ch == 3) ? 1 : (ch == 9) ? 2 : -1;
          if (sl >= 0) st4bf(E.shb + ((size_t)sl * 256 + row) * D + (col & 1023), o[0], o[1], o[2], o[3]);
        }
      }
    }
  } else {
    _Pragma("unroll") for (int g = 0; g < 8; ++g) {
      const int row = EROW(g);
      if (row < 144) { _Pragma("unroll") for (int j = 0; j < 4; ++j) *reinterpret_cast<f32x4*>(E.cout + (size_t)row * E.ldc + ECOL(j)) = EACC(g, j); }
    }
  }
#undef ECOL
#undef EROW
#undef EACC
}

DI int perm32(int rho) { const int n = rho >> 4, i = rho & 15; return 8 * (i >> 2) + 4 * n + (i & 3); }
DI void tile_of(int tile, int ntm, int ntn, int& pm, int& pn) {
  const int nig = 8 * ntn, gid = tile / nig, fm = gid * 8, gsz = min(ntm - fm, 8);
  pm = fm + ((tile % nig) % gsz); pn = (tile % nig) / gsz;
}

DI void gemm_phase(char* shm_, const bf16* __restrict__ Ag, const bf16* __restrict__ Btg, int K, int ntm, int ntn, const Epi& E, int split, int toff, int shalf) {
  LAS unsigned char* lds = (LAS unsigned char*)shm_;
  const int tid = otid(), wid = __builtin_amdgcn_readfirstlane(tid >> 6), lane = tid & 63, wr = wid >> 2, wc = wid & 3, fr = lane & 15, fq = lane >> 4;
  const int ntk = K / BK;
  const int ntmf = split ? ntm - 1 : ntm, nfull = ntmf * ntn;
  const int G = gridDim.x, ntiles = nfull + (split ? ntn * (K / 256) : 0);
  const int bxr = (G % 8 == 0) ? (int)((blockIdx.x % 8) * (G / 8) + blockIdx.x / 8) : (int)blockIdx.x;
  unsigned voffA;
  { int R, C; stage_rc(tid * 16, R, C); voffA = (unsigned)(R * K + C) * 2u; }
  const size_t istep = (size_t)64 * K * 2;
  const size_t kstep = (size_t)(BK * 2), hstep = (size_t)HALFT * K * 2, tstep = 2 * hstep;
  const unsigned ldsw = (unsigned)wid * 1024u;
  const int aoff = lds_byte(wr * 64 + fr, fq * 8), boff = lds_byte(wc * 32 + fr, fq * 8);
#define PSA(b, h) (((b) * 2 + (h)) * HTB)
#define PSB(b, h) ((4 + (b) * 2 + (h)) * HTB)
#define PSTAGE(bufoff, gbase) PSTAGEX(bufoff, gbase, voffA)
#define PSTAGEB(bufoff, gbase) PSTAGEX(bufoff, gbase, voffA)
#define PSTAGEX(bufoff, gbase, VO) do { _Pragma("unroll") for (int _i = 0; _i < 2; ++_i) \
    __builtin_amdgcn_global_load_lds((const unsigned*)((const char*)(gbase) + (size_t)_i * istep + VO), (LAS unsigned*)(lds + (bufoff) + ldsw + _i * 8192), 16, 0, 0); } while (0)
#define PLDA(dst, b, h) do { _Pragma("unroll") for (int m = 0; m < 4; ++m) _Pragma("unroll") for (int k = 0; k < 2; ++k) dst[m][k] = *(const LAS bf16x8*)(lds + PSA(b, h) + aoff + m * 2048 + k * 1024); } while (0)
#define PLDB(dst, b, h) do { _Pragma("unroll") for (int n = 0; n < 2; ++n) _Pragma("unroll") for (int k = 0; k < 2; ++k) dst[n][k] = *(const LAS bf16x8*)(lds + PSB(b, h) + boff + n * 2048 + k * 1024); } while (0)
#define PMMA(ai, bj, At, Bq) do { __builtin_amdgcn_s_setprio(1); _Pragma("unroll") for (int m = 0; m < 4; ++m) _Pragma("unroll") for (int n = 0; n < 2; ++n) _Pragma("unroll") for (int k = 0; k < 2; ++k) \
    acc[ai][bj][m][n] = __builtin_amdgcn_mfma_f32_16x16x32_bf16(Bq[n][k], At[m][k], acc[ai][bj][m][n], 0, 0, 0); __builtin_amdgcn_s_setprio(0); } while (0)
#define WAIT_V(n) asm volatile("s_waitcnt vmcnt(" #n ")" ::: "memory")
#define WAIT_L(n) asm volatile("s_waitcnt lgkmcnt(" #n ")" ::: "memory")
#define BAR __builtin_amdgcn_s_barrier()
#define SCHED __builtin_amdgcn_sched_barrier(0)
  int tile = bxr - toff;
  if (tile < 0 || tile >= ntiles) return;
#define UNIT_OF(u, PM, PN, K0, NTU, AT, HL) do { if ((u) < nfull) { tile_of((u), ntmf, ntn, PM, PN); K0 = 0; NTU = ntk; AT = 0; } \
    else { const int _s = (u) - nfull; PN = _s % ntn; PM = ntmf; K0 = (_s / ntn) * 256; NTU = 4; AT = 1; } \
    HL = (shalf && PM == ntm - 1) ? 1 : 0; } while (0)
  int pm, pn, k0, nt, at, hl; UNIT_OF(tile, pm, pn, k0, nt, at, hl);
  f32x4 acc[2][2][4][2];
  _Pragma("unroll") for (int a = 0; a < 2; ++a) _Pragma("unroll") for (int b = 0; b < 2; ++b) _Pragma("unroll") for (int m = 0; m < 4; ++m) _Pragma("unroll") for (int n = 0; n < 2; ++n) acc[a][b][m][n] = (f32x4){0.f, 0.f, 0.f, 0.f};
  bf16x8 At[4][2], B0[2][2], B1[2][2];
  const char* cA = (const char*)Ag + (size_t)pm * tstep + (size_t)k0 * 2; const char* cB = (const char*)Btg + (size_t)pn * tstep + (size_t)k0 * 2;
  PSTAGEB(PSB(0, 0), cB); PSTAGE(PSA(0, 0), cA); PSTAGEB(PSB(0, 1), cB + hstep); PSTAGE(PSA(0, 1), cA + hstep);
  if (wr == 1) BAR;
  WAIT_V(4); BAR;
  PSTAGEB(PSB(1, 0), cB + kstep); PSTAGE(PSA(1, 0), cA + kstep); PSTAGEB(PSB(1, 1), cB + hstep + kstep);
  WAIT_V(6); BAR;
  for (;;) {
    const int ntile = tile + G;
    const bool has_next = ntile < ntiles;
    int npm = pm, npn = pn, nk0 = k0, nnt = nt, nat = at, nhl = hl; if (has_next) UNIT_OF(ntile, npm, npn, nk0, nnt, nat, nhl);
    const char* nA = has_next ? (const char*)Ag + (size_t)npm * tstep + (size_t)nk0 * 2 : cA; const char* nB = has_next ? (const char*)Btg + (size_t)npn * tstep + (size_t)nk0 * 2 : cB;
#define KLOOP(SK)     for (int t = 0; t < nt; t += 2) { \
      const bool last = (t == nt - 2); \
      const char* a1 = cA + (size_t)(t + 1) * kstep; \
      const char* a2 = last ? nA : cA + (size_t)(t + 2) * kstep; const char* b2 = last ? nB : cB + (size_t)(t + 2) * kstep; \
      const char* a3 = a2 + kstep; const char* b3 = b2 + kstep; \
      PLDB(B0, 0, 0); SCHED; PLDA(At, 0, 0); PSTAGE(PSA(1, 1), a1 + hstep); \
      WAIT_L(8); BAR; WAIT_L(0); PMMA(0, 0, At, B0); BAR; SCHED; \
      PLDB(B1, 0, 1); PSTAGEB(PSB(0, 0), b2); \
      BAR; WAIT_L(0); PMMA(0, 1, At, B1); BAR; \
      PLDA(At, 0, 1); PSTAGE(PSA(0, 0), a2); \
      BAR; WAIT_L(0); if (!(SK)) PMMA(1, 0, At, B0); BAR; SCHED; \
      PSTAGEB(PSB(0, 1), b2 + hstep); \
      WAIT_V(6); BAR; if (!(SK)) PMMA(1, 1, At, B1); BAR; \
      PLDB(B0, 1, 0); SCHED; PLDA(At, 1, 0); PSTAGE(PSA(0, 1), a2 + hstep); \
      WAIT_L(8); BAR; WAIT_L(0); PMMA(0, 0, At, B0); BAR; SCHED; \
      PLDB(B1, 1, 1); PSTAGEB(PSB(1, 0), b3); \
      BAR; WAIT_L(0); PMMA(0, 1, At, B1); BAR; \
      PLDA(At, 1, 1); PSTAGE(PSA(1, 0), a3); \
      BAR; WAIT_L(0); if (!(SK)) PMMA(1, 0, At, B0); BAR; SCHED; \
      PSTAGEB(PSB(1, 1), b3 + hstep); \
      WAIT_V(6); BAR; if (!(SK)) PMMA(1, 1, At, B1); BAR; \
    }
    if (hl) { KLOOP(1) } else { KLOOP(0) }
#undef KLOOP
    epilogue(acc, E, pm * BM, pn * BM, wr, wc, fr, fq, at);
    if (!has_next) break;
    _Pragma("unroll") for (int a = 0; a < 2; ++a) _Pragma("unroll") for (int b = 0; b < 2; ++b) _Pragma("unroll") for (int m = 0; m < 4; ++m) _Pragma("unroll") for (int n = 0; n < 2; ++n) acc[a][b][m][n] = (f32x4){0.f, 0.f, 0.f, 0.f};
    tile = ntile; pm = npm; pn = npn; k0 = nk0; nt = nnt; at = nat; hl = nhl; cA = nA; cB = nB;
  }
  WAIT_V(0);
  if (wr == 0) BAR;
  BAR;
}

struct TJob { const float* src; u16* dst; int K, N, tk, tn; };
DI TJob tjob_of(const Params& P, unsigned char* ws, int job) {
  TJob J; const int l = job / 6464; int j = job % 6464;
  if (j < 2624) { J.src = P.w_in + (size_t)l * D * DIN; J.dst = (u16*)(ws + WS_WIN) + (size_t)l * ZS * D; J.K = D; J.N = DIN; J.tk = j / 164; J.tn = j % 164; }
  else if ((j -= 2624) < 256) { J.src = P.w_out + (size_t)l * D * D; J.dst = (u16*)(ws + WS_WOUT) + (size_t)l * D * D; J.K = D; J.N = D; J.tk = j / 16; J.tn = j % 16; }
  else if ((j -= 256) < 1024) { J.src = P.w_up + (size_t)l * D * DFF; J.dst = (u16*)(ws + WS_WUP) + (size_t)l * DFF * D; J.K = D; J.N = DFF; J.tk = j / 64; J.tn = j % 64; }
  else if ((j -= 1024) < 1024) { J.src = P.w_down + (size_t)l * DFF * D; J.dst = (u16*)(ws + WS_WDN) + (size_t)l * D * DFF; J.K = DFF; J.N = D; J.tk = j / 16; J.tn = j % 16; }
  else { j -= 1024; J.src = P.ada_w + (size_t)l * D * 6144; J.dst = (u16*)(ws + WS_AWT) + (size_t)l * 6144 * D; J.K = D; J.N = 6144; J.tk = j / 96; J.tn = j % 96; }
  return J;
}
DI void tjob_load(const TJob& J, int tid, f32x4 (&v)[2]) {
  const int nn = (tid & 15) * 4, n = J.tn * 64 + nn;
  _Pragma("unroll") for (int i = 0; i < 2; ++i) { const int kk = (tid >> 4) + 32 * i;
    v[i] = (n < J.N) ? *reinterpret_cast<const f32x4*>(J.src + (size_t)(J.tk * 64 + kk) * J.N + n) : (f32x4){0.f, 0.f, 0.f, 0.f}; }
}

DI void prep_phase(char* shm, const Params& P) {
  float* tl = (float*)shm;
  unsigned char* ws = optr(P.ws);
  int bx_ = blockIdx.x; asm volatile("" : "+s"(bx_));
  int G_ = gridDim.x; asm volatile("" : "+s"(G_));
  const int G = G_, bx = bx_, tid = otid();
  const int njobs = 2 * 6464;
  if (bx < njobs) {
    f32x4 v[2];
    { const TJob J0 = tjob_of(P, ws, bx); tjob_load(J0, tid, v); }
    _Pragma("unroll 1") for (int job = bx; job < njobs; job += G) {
      __syncthreads();
      { const int nn = (tid & 15) * 4; _Pragma("unroll") for (int i = 0; i < 2; ++i) { const int kk = (tid >> 4) + 32 * i;
          _Pragma("unroll") for (int q = 0; q < 4; ++q) tl[kk * 65 + nn + q] = v[i][q]; } }
      if (job + G < njobs) { const TJob Jn = tjob_of(P, ws, job + G); tjob_load(Jn, tid, v); }
      __syncthreads();
      { const TJob Jc = tjob_of(P, ws, job);
        const int nn = tid >> 3, kp = tid & 7; float o[8]; _Pragma("unroll") for (int j = 0; j < 8; ++j) o[j] = tl[(kp * 8 + j) * 65 + nn];
        const int ncol = Jc.tn * 64 + nn, c5 = ncol & 31, slot = (ncol & ~31) + 16 * ((c5 >> 2) & 1) + 4 * (c5 >> 3) + (c5 & 3);
        st8(Jc.dst + (size_t)slot * Jc.K + Jc.tk * 64 + kp * 8, pack8(o)); }
    }
  }
  { unsigned* shb = (unsigned*)(ws + WS_SHB); _Pragma("unroll 1") for (int e = bx * NT + tid; e < 3 * 256 * 1024 / 2; e += G * NT) shb[e] = 0u; }
  u16* sc = (u16*)(ws + WS_SC);
  _Pragma("unroll 1") for (int e = bx * NT + tid; e < 256 * 1024; e += G * NT) {
    int row = e >> 10, c = e & 1023; float v = 0.f;
    if (row < 16) v = siluf(P.c_prompt[row * D + c]); else if (row < 144) v = siluf(P.c_sample[(row - 16) * D + c]);
    sc[e] = f2bf(v);
  }
  if (bx == 0) {
    float* bt = (float*)(ws + WS_BT);
    for (int e = tid; e < 128 * 16; e += NT) {
      int n = e >> 4, hd = e & 15; int bk;
      if (n < 16) bk = n; else { float nf = (float)n; int lg = 16 + (int)(logf(nf / 16.f) / 2.0794415416798357f * 16.f); bk = lg < 31 ? lg : 31; }
      bt[e] = P.rel[bk * 16 + hd];
    }
  }
}

DI void norm_phase(const Params& P, int l, int hf, int which  , bool from_input) {
  const int RB = hf * HALF_ROWS, NV = hf ? 16512 : 16384, NR = hf ? 16640 : 16384;
  const int tid = otid(); const int w = tid >> 6, lane = tid & 63;
  u16* H = (u16*)(optr(P.ws) + WS_H);
  const float* mod = (const float*)(optr(P.ws) + WS_MOD);
  const float* nw = (which ? P.n2 : P.n1) + l * D;
  const int stride = gridDim.x * 8;
  f32x4 nx[4];
#define NORM_SRC(lrow) (from_input ? ((RB + (lrow)) < MPROMPT ? P.x_prompt + (size_t)(RB + (lrow)) * D : P.x_sample + (size_t)(RB + (lrow) - MPROMPT) * D) : P.out + (size_t)(RB + (lrow)) * D)
  f32x4 nsh[4], nsc[4], nw4[4];
  _Pragma("unroll") for (int k = 0; k < 4; ++k) nw4[k] = *reinterpret_cast<const f32x4*>(nw + lane * 4 + 256 * k);
#define NORM_LOAD(lrow) do { const float* _xr = NORM_SRC(lrow); const float* _mr = mod + (size_t)modrow(RB + (lrow)) * MODS + l * 6144 + which * 3072; \
    _Pragma("unroll") for (int k = 0; k < 4; ++k) { nx[k] = *reinterpret_cast<const f32x4*>(_xr + lane * 4 + 256 * k); nsh[k] = *reinterpret_cast<const f32x4*>(_mr + lane * 4 + 256 * k); nsc[k] = *reinterpret_cast<const f32x4*>(_mr + 1024 + lane * 4 + 256 * k); } } while (0)
  int lr = blockIdx.x * 8 + w;
  if (lr < NV) NORM_LOAD(lr);
  _Pragma("unroll 1") for (; lr < NR; lr += stride) {
    u16* hrow = H + (size_t)lr * D;
    if (lr >= NV) { _Pragma("unroll") for (int k = 0; k < 4; ++k) st4bf(hrow + lane * 4 + 256 * k, 0.f, 0.f, 0.f, 0.f); continue; }
    const int r = RB + lr;
    f32x4 x[4], csh[4], csc[4]; float ss = 0.f;
    _Pragma("unroll") for (int k = 0; k < 4; ++k) { x[k] = nx[k]; csh[k] = nsh[k]; csc[k] = nsc[k]; ss += x[k][0] * x[k][0] + x[k][1] * x[k][1] + x[k][2] * x[k][2] + x[k][3] * x[k][3]; }
    if (lr + stride < NV) NORM_LOAD(lr + stride);
    for (int o = 32; o >= 1; o >>= 1) ss += shx(ss, o, lane);
    const float rs = rsqrtf(ss * (1.f / D) + EPS);
    if (from_input && r >= MPROMPT) { _Pragma("unroll") for (int k = 0; k < 4; ++k) *reinterpret_cast<f32x4*>(P.out + (size_t)r * D + lane * 4 + 256 * k) = x[k]; }
    _Pragma("unroll") for (int k = 0; k < 4; ++k) {
      const int c = lane * 4 + 256 * k;
      f32x4 y = x[k] * rs * nw4[k] * (csc[k] + 1.f) + csh[k];
      st4bf(hrow + c, y[0], y[1], y[2], y[3]);
    }
  }
}

DI void final_norm_phase(const Params& P) {
  const int tid = otid(); const int w = tid >> 6, lane = tid & 63;
  const int stride = gridDim.x * 8;
  f32x4 nx[4], fw4[4];
  _Pragma("unroll") for (int k = 0; k < 4; ++k) fw4[k] = *reinterpret_cast<const f32x4*>(P.fnw + lane * 4 + 256 * k);
  int r = blockIdx.x * 8 + w;
  if (r < MVALID) { _Pragma("unroll") for (int k = 0; k < 4; ++k) nx[k] = *reinterpret_cast<const f32x4*>(P.out + (size_t)r * D + lane * 4 + 256 * k); }
  _Pragma("unroll 1") for (; r < MVALID; r += stride) {
    float* xr = P.out + (size_t)r * D;
    f32x4 x[4]; float ss = 0.f;
    _Pragma("unroll") for (int k = 0; k < 4; ++k) { x[k] = nx[k]; ss += x[k][0] * x[k][0] + x[k][1] * x[k][1] + x[k][2] * x[k][2] + x[k][3] * x[k][3]; }
    if (r + stride < MVALID) { _Pragma("unroll") for (int k = 0; k < 4; ++k) nx[k] = *reinterpret_cast<const f32x4*>(P.out + (size_t)(r + stride) * D + lane * 4 + 256 * k); }
    for (int o = 32; o >= 1; o >>= 1) ss += shx(ss, o, lane);
    const float rs = rsqrtf(ss * (1.f / D) + EPS);
    _Pragma("unroll") for (int k = 0; k < 4; ++k) { const int c = lane * 4 + 256 * k; *reinterpret_cast<f32x4*>(xr + c) = x[k] * rs * fw4[k]; }
  }
}

DI void conv_phase(const Params& P, int l, int hf) {
  const int tid = otid();
  const u16* Z = (const u16*)(optr(P.ws) + WS_Z);
  u16* XBC = (u16*)(optr(P.ws) + WS_XBC);
  float* DT = (float*)(optr(P.ws) + WS_DT);
  const float* cw = P.conv_w + (size_t)l * 4 * 1536;
  const float* cb = P.conv_b + (size_t)l * 1536;
  const int nstrips = 16384 / 32;
  for (int sp = blockIdx.x * 2; sp < nstrips; sp += gridDim.x * 2) {
    if (tid < 384) {
      const int part = tid % 192, strip = sp + tid / 192, ch0 = part * 8;
      const int lr0 = strip * 32;
      float w[4][8], bias[8];
      _Pragma("unroll") for (int i = 0; i < 4; ++i) { const f32x4 a = *reinterpret_cast<const f32x4*>(cw + i * 1536 + ch0), b = *reinterpret_cast<const f32x4*>(cw + i * 1536 + ch0 + 4);
        _Pragma("unroll") for (int j = 0; j < 4; ++j) { w[i][j] = a[j]; w[i][4 + j] = b[j]; } }
      { const f32x4 a = *reinterpret_cast<const f32x4*>(cb + ch0), b = *reinterpret_cast<const f32x4*>(cb + ch0 + 4);
        _Pragma("unroll") for (int j = 0; j < 4; ++j) { bias[j] = a[j]; bias[4 + j] = b[j]; } }
      bf16x8 h0, h1, h2;
      const u16* zp = Z + (size_t)lr0 * ZS + C_CX + ch0;
      if ((lr0 & 2047) == 0) { _Pragma("unroll") for (int j = 0; j < 8; ++j) { h0[j] = 0; h1[j] = 0; h2[j] = 0; } }
      else { h0 = ld8(zp - 3 * (size_t)ZS); h1 = ld8(zp - 2 * (size_t)ZS); h2 = ld8(zp - (size_t)ZS); }
      u16* xo = XBC + (size_t)lr0 * 1536 + ch0;
      _Pragma("unroll 1") for (int rb = 0; rb < 32; rb += 8) {
        bf16x8 cur[8];
        _Pragma("unroll") for (int k = 0; k < 8; ++k) cur[k] = ld8(zp + (size_t)(rb + k) * ZS);
        _Pragma("unroll") for (int k = 0; k < 8; ++k) {
          float a[8];
          _Pragma("unroll") for (int j = 0; j < 8; ++j) a[j] = siluf(bias[j] + w[0][j] * bfs(h0[j]) + w[1][j] * bfs(h1[j]) + w[2][j] * bfs(h2[j]) + w[3][j] * bfs(cur[k][j]));
          st8(xo + (size_t)(rb + k) * 1536, pack8(a));
          h0 = h1; h1 = h2; h2 = cur[k];
        }
      }
    } else {
      const int t = tid - 384;
      u16 zv[8];
      _Pragma("unroll") for (int k = 0; k < 8; ++k) { const int u = t + 128 * k; zv[k] = Z[(size_t)(sp * 32 + (u >> 4)) * ZS + C_DT + (u & 15)]; }
      const float dtb = P.dt_bias[l * 16 + (t & 15)];
      _Pragma("unroll") for (int k = 0; k < 8; ++k) { const int u = t + 128 * k; DT[(size_t)(sp * 32 + (u >> 4)) * 16 + (u & 15)] = softplusf(bf2f(zv[k]) + dtb); }
    }
  }
}

DI void mix_phase(const Params& P, int l, int hf) {
  const int NV = hf ? 16512 : 16384, NR = hf ? 16640 : 16384;
  const int tid = otid(); const int w = tid >> 6, lane = tid & 63;
  u16* H = (u16*)(optr(P.ws) + WS_H);
  const u16* Z = (const u16*)(optr(P.ws) + WS_Z);
  const u16* YC = (const u16*)(optr(P.ws) + WS_YC);
  const float* snw = P.snw + l * D;
  bf16x8 nob[2], ny[2], ncz[2], noa[2], nbg[2], nga[2], ngb[2], ngc[2];
#define MIX_LOAD(row) do { const u16* zr = Z + (size_t)(row) * ZS + lane * 8; const u16* yr = YC + (size_t)(row) * D + lane * 8; \
    _Pragma("unroll") for (int k = 0; k < 2; ++k) { \
      nob[k] = ld8(zr + C_BV + 512 * k); ny[k] = ld8(yr + 512 * k); ncz[k] = ld8(zr + C_CZ + 512 * k); noa[k] = ld8(zr + C_AQ + 512 * k); \
      nbg[k] = ld8(zr + C_BG + 512 * k); nga[k] = ld8(zr + C_GA + 512 * k); ngb[k] = ld8(zr + C_GB + 512 * k); ngc[k] = ld8(zr + C_GC + 512 * k); } } while (0)
  const int stride = gridDim.x * 8;
  f32x4 snv[2][2];
  _Pragma("unroll") for (int k = 0; k < 2; ++k) { snv[k][0] = *reinterpret_cast<const f32x4*>(snw + lane * 8 + 512 * k); snv[k][1] = *reinterpret_cast<const f32x4*>(snw + lane * 8 + 512 * k + 4); }
  int lr = blockIdx.x * 8 + w;
  if (lr < NV) MIX_LOAD(lr);
  float* SS1 = (float*)(optr(P.ws) + WS_SS1); float* SS2 = (float*)(optr(P.ws) + WS_SS2);
  _Pragma("unroll 1") for (; lr < NR; lr += stride) {
    u16* hrow = H + (size_t)lr * D + lane * 8;
    if (lane == 0) { SS1[lr] = 0.f; SS2[lr] = 0.f; }
    if (lr >= NV) { _Pragma("unroll") for (int k = 0; k < 2; ++k) { st4bf(hrow + 512 * k, 0.f, 0.f, 0.f, 0.f); st4bf(hrow + 512 * k + 4, 0.f, 0.f, 0.f, 0.f); } continue; }
    bf16x8 vob[2], vy[2], vcz[2], voa[2], vbg[2], vga[2], vgb[2], vgc[2];
    _Pragma("unroll") for (int k = 0; k < 2; ++k) { vob[k] = nob[k]; vy[k] = ny[k]; vcz[k] = ncz[k]; voa[k] = noa[k]; vbg[k] = nbg[k]; vga[k] = nga[k]; vgb[k] = ngb[k]; vgc[k] = ngc[k]; }
    if (lr + stride < NV) MIX_LOAD(lr + stride);
    _Pragma("unroll") for (int k = 0; k < 2; ++k) {
      float ob[8], yg[8], so = 0.f, sy = 0.f;
      _Pragma("unroll") for (int j = 0; j < 8; ++j) { float o = bfs(vob[k][j]); ob[j] = o; so += o * o; float t = bfs(vy[k][j]) * siluf(bfs(vcz[k][j])); yg[j] = t; sy += t * t; }
      so += shx(so, 1, lane); so += shx(so, 2, lane); so += shx(so, 4, lane); so += shx(so, 8, lane);
      for (int o = 32; o >= 1; o >>= 1) sy += shx(sy, o, lane);
      const float ro = rsqrtf(so * (1.f / 128.f) + EPS), ry = rsqrtf(sy * (1.f / 512.f) + EPS);
      float m[8];
      const f32x4 s0 = snv[k][0], s1 = snv[k][1];
      _Pragma("unroll") for (int j = 0; j < 8; ++j) {
        const float obn = ob[j] * ro * siluf(bfs(vbg[k][j]));
        const float ocn = yg[j] * ry * (j < 4 ? s0[j & 3] : s1[j & 3]);
        m[j] = sigmf(bfs(vga[k][j])) * bfs(voa[k][j]) + sigmf(bfs(vgb[k][j])) * obn + sigmf(bfs(vgc[k][j])) * ocn;
      }
      st8(hrow + 512 * k, pack8(m));
    }
  }
}

DI void att_prompt_item(char* shm, const Params& P, int l, int hf, int b, int blk, int kvh) {
  u16* Ks = (u16*)shm;
  u16* Vt = Ks + 256 * 72;
  float* bias = (float*)(Vt + 64 * 268);
  u16* Z = (u16*)(optr(P.ws) + WS_Z);
  const float* bt = (const float*)(optr(P.ws) + WS_BT);
  const int tid = otid(), lane = tid & 63, w = tid >> 6;
  const int lr0 = b * 2048 + blk * 128 - hf * HALF_ROWS;
  const int g = w >> 1, qh = kvh * 4 + g, r = lane & 31, h = lane >> 5;
  bf16x8 qall[2][4];
  _Pragma("unroll") for (int qq = 0; qq < 2; ++qq) { const u16* qp = Z + (size_t)(lr0 + ((w & 1) * 2 + qq) * 32 + r) * ZS + C_AQ + qh * 64;
    _Pragma("unroll") for (int s = 0; s < 4; ++s) qall[qq][s] = ld8(qp + 16 * s + 8 * h); }
  const float sink = P.sinks[l * 16 + qh];
  const float btv = bt[(tid & 127) * 16 + kvh * 4 + (tid >> 7)];
  __syncthreads();
  {
    bf16x8 kr[4], vr[4];
    _Pragma("unroll") for (int it = 0; it < 4; ++it) { const int c = tid + it * NT, key = c >> 3, part = c & 7;
      if (blk > 0 || key >= 128) { const u16* src = Z + (size_t)(lr0 - 128 + key) * ZS; kr[it] = ld8(src + C_AK + kvh * 64 + part * 8); vr[it] = ld8(src + C_AV + kvh * 64 + part * 8); }
      else { _Pragma("unroll") for (int j = 0; j < 8; ++j) { kr[it][j] = 0; vr[it][j] = 0; } } }
    _Pragma("unroll") for (int it = 0; it < 4; ++it) { const int c = tid + it * NT, key = c >> 3, part = c & 7;
      st8(Ks + key * 72 + part * 8, kr[it]);
      _Pragma("unroll") for (int jj = 0; jj < 8; ++jj) Vt[(part * 8 + jj) * 268 + key] = (u16)vr[it][jj]; }
  }
  { const int g3 = tid >> 7, dist = tid & 127; bias[g3 * 192 + 32 + dist] = btv * 1.4426950408889634f;
    if (tid < 256) { const int g2 = tid >> 6, k = tid & 63; bias[g2 * 192 + (k < 32 ? k : 128 + k)] = 0.f; } }
  __syncthreads();
  _Pragma("unroll") for (int qq = 0; qq < 2; ++qq) {
    const int qt = (w & 1) * 2 + qq, qi = qt * 32 + r;
    u16* qrow = Z + (size_t)(lr0 + qi) * ZS + C_AQ + qh * 64;
    bf16x8 qf[4];
    _Pragma("unroll") for (int s = 0; s < 4; ++s) qf[s] = qall[qq][s];
    f32x16 O0 = zero16(), O1 = zero16();
    float m = sink * 1.4426950408889634f, lsum = 1.f;
    const int kt0 = (blk == 0) ? 4 : qt;
    _Pragma("unroll 1") for (int kt = kt0; kt <= qt + 4; ++kt) {
      f32x16 S = zero16();
      _Pragma("unroll") for (int s = 0; s < 4; ++s) { const bf16x8 kf = ld8(Ks + (kt * 32 + r) * 72 + 16 * s + 8 * h); S = MFMA32(kf, qf[s], S); }
      const float* bp = bias + g * 192 + 32 + (qi - 32 * kt + 128 - 4 * h);
      float mloc = -INFINITY;
      _Pragma("unroll") for (int i = 0; i < 16; ++i) S[i] = fmaf(S[i], 0.125f * 1.4426950408889634f, bp[-((i & 3) + 8 * (i >> 2))]);
      if (kt == qt) { _Pragma("unroll") for (int i = 0; i < 16; ++i) S[i] = (crow(i, h) > r) ? S[i] : -INFINITY; }
      if (kt == qt + 4) { _Pragma("unroll") for (int i = 0; i < 16; ++i) S[i] = (crow(i, h) <= r) ? S[i] : -INFINITY; }
      _Pragma("unroll") for (int i = 0; i < 16; ++i) mloc = fmaxf(mloc, S[i]);
      mloc = fmaxf(mloc, shx(mloc, 32, lane));
      const float mnew = fmaxf(m, mloc), alpha = __builtin_amdgcn_exp2f(m - mnew);
      float ps = 0.f;
      _Pragma("unroll") for (int i = 0; i < 16; ++i) { const float p = __builtin_amdgcn_exp2f(S[i] - mnew); S[i] = p; ps += p; }
      ps += shx(ps, 32, lane);
      lsum = lsum * alpha + ps; m = mnew;
      _Pragma("unroll") for (int i = 0; i < 16; ++i) { O0[i] *= alpha; O1[i] *= alpha; }
      const bf16x8 p0 = packP<0>(S), p1 = packP<1>(S);
      { const u16* vp = Vt + (r) * 268 + kt * 32 + 4 * h;
        O0 = MFMA32(cat4(*(const s16x4*)vp, *(const s16x4*)(vp + 8)), p0, O0);
        O0 = MFMA32(cat4(*(const s16x4*)(vp + 16), *(const s16x4*)(vp + 24)), p1, O0); }
      { const u16* vp = Vt + (32 + r) * 268 + kt * 32 + 4 * h;
        O1 = MFMA32(cat4(*(const s16x4*)vp, *(const s16x4*)(vp + 8)), p0, O1);
        O1 = MFMA32(cat4(*(const s16x4*)(vp + 16), *(const s16x4*)(vp + 24)), p1, O1); }
    }
    const float inv = __builtin_amdgcn_rcpf(lsum);
    _Pragma("unroll") for (int gq = 0; gq < 4; ++gq) {
      st4bf(qrow + 8 * gq + 4 * h, O0[4 * gq] * inv, O0[4 * gq + 1] * inv, O0[4 * gq + 2] * inv, O0[4 * gq + 3] * inv);
      st4bf(qrow + 32 + 8 * gq + 4 * h, O1[4 * gq] * inv, O1[4 * gq + 1] * inv, O1[4 * gq + 2] * inv, O1[4 * gq + 3] * inv);
    }
  }
  if (blk == 15) {
    float* wk = P.out + O_WKP + (size_t)(l * 16 + b) * 128 * 256 + kvh * 64;
    float* wv = P.out + O_WVP + (size_t)(l * 16 + b) * 128 * 256 + kvh * 64;
    for (int idx = tid; idx < 128 * 64; idx += NT) { const int j = idx >> 6, d = idx & 63; wk[j * 256 + d] = bf2f(Ks[(128 + j) * 72 + d]); wv[j * 256 + d] = bf2f(Vt[d * 268 + 128 + j]); }
  }
}

DI void ret_prompt_item(char* shm, const Params& P, int l, int hf, int b, int hd) {
  u16* QQ = (u16*)shm;
  u16* KK = QQ + 128 * 72;
  u16* KKt = KK + 128 * 72;
  u16* Vt = KKt + 64 * 136;
  u16* St = Vt + 128 * 136;
  float* th = (float*)(St + 128 * 72);
  u16* Z = (u16*)(optr(P.ws) + WS_Z);
  const int tid = otid(), lane = tid & 63, w = tid >> 6, r = lane & 31, hh = lane >> 5;
  const float log2g = log2f(1.f - exp2f(-5.f - (float)hd));
  const float g128 = exp2f(log2g * 128.f);
  __syncthreads();
  for (int e = tid; e < 128 * 72; e += NT) St[e] = 0;
  if (tid < 32) th[tid] = 1.f / powf(10000.f, (float)tid / 31.f);
  f32x16 Sacc = zero16();
  const int lt = w & 3, eh = w >> 2;
  bf16x8 qv[2], kv[2], vv[4];
#define RET_ISSUE(cc) do { const int _lr = b * 2048 + (cc) * 128 - hf * HALF_ROWS; \
    _Pragma("unroll") for (int it = 0; it < 2; ++it) { const int idx = tid + it * NT, row = idx & 127, part = idx >> 7; \
      const u16* zr = Z + (size_t)(_lr + row) * ZS; qv[it] = ld8(zr + C_BQ + hd * 64 + part * 8); kv[it] = ld8(zr + C_BK + hd * 64 + part * 8); } \
    _Pragma("unroll") for (int it = 0; it < 4; ++it) { const int idx = tid + it * NT, row = idx & 127, part = idx >> 7; \
      vv[it] = ld8(Z + (size_t)(_lr + row) * ZS + C_BV + hd * 128 + part * 8); } } while (0)
  RET_ISSUE(0);
  _Pragma("unroll 1") for (int c = 0; c < 16; ++c) {
    const int tok0 = c * 128;
    const int lrow0 = b * 2048 + tok0 - hf * HALF_ROWS;
    __syncthreads();
    {
      _Pragma("unroll") for (int it = 0; it < 2; ++it) {
        const int idx = tid + it * NT, row = idx & 127, part = idx >> 7;
        const float pos = (float)(tok0 + row);
        const float gq = exp2f(log2g * (float)(row + 1)), gk = 0.125f * exp2f(-log2g * (float)(row + 1));
        float qo[8], ko[8];
        _Pragma("unroll") for (int pr = 0; pr < 4; ++pr) {
          float sn, cs; sincos_rev(pos * th[part * 4 + pr], sn, cs);
          const float q1 = bfs(qv[it][2 * pr]), q2 = bfs(qv[it][2 * pr + 1]), k1 = bfs(kv[it][2 * pr]), k2 = bfs(kv[it][2 * pr + 1]);
          qo[2 * pr] = (q1 * cs - q2 * sn) * gq; qo[2 * pr + 1] = (q1 * sn + q2 * cs) * gq;
          ko[2 * pr] = (k1 * cs - k2 * sn) * gk; ko[2 * pr + 1] = (k1 * sn + k2 * cs) * gk;
        }
        st8(QQ + row * 72 + part * 8, pack8(qo));
        st8(KK + row * 72 + part * 8, pack8(ko));
        _Pragma("unroll") for (int jj = 0; jj < 8; ++jj) KKt[(part * 8 + jj) * 136 + row] = f2bf(ko[jj]);
      }
      _Pragma("unroll") for (int it = 0; it < 4; ++it) { const int idx = tid + it * NT, row = idx & 127, part = idx >> 7;
        _Pragma("unroll") for (int jj = 0; jj < 8; ++jj) Vt[(part * 8 + jj) * 136 + row] = (u16)vv[it][jj]; }
    }
    if (c + 1 < 16) RET_ISSUE(c + 1);
    __syncthreads();
    bf16x8 qf[4];
    _Pragma("unroll") for (int s = 0; s < 4; ++s) qf[s] = ld8(QQ + (lt * 32 + r) * 72 + 16 * s + 8 * hh);
    f32x16 O0 = zero16(), O1 = zero16();
    _Pragma("unroll") for (int s = 0; s < 4; ++s) {
      O0 = MFMA32(ld8(St + ((2 * eh) * 32 + r) * 72 + 16 * s + 8 * hh), qf[s], O0);
      O1 = MFMA32(ld8(St + ((2 * eh + 1) * 32 + r) * 72 + 16 * s + 8 * hh), qf[s], O1);
    }
    _Pragma("unroll 1") for (int mk = 0; mk <= lt; ++mk) {
      f32x16 Aa = zero16();
      _Pragma("unroll") for (int s = 0; s < 4; ++s) Aa = MFMA32(ld8(KK + (mk * 32 + r) * 72 + 16 * s + 8 * hh), qf[s], Aa);
      if (mk == lt) _Pragma("unroll") for (int i = 0; i < 16; ++i) if (crow(i, hh) > r) Aa[i] = 0.f;
      const bf16x8 p0 = packP<0>(Aa), p1 = packP<1>(Aa);
      { const u16* vp = Vt + ((2 * eh) * 32 + r) * 136 + mk * 32 + 4 * hh;
        O0 = MFMA32(cat4(*(const s16x4*)vp, *(const s16x4*)(vp + 8)), p0, O0);
        O0 = MFMA32(cat4(*(const s16x4*)(vp + 16), *(const s16x4*)(vp + 24)), p1, O0); }
      { const u16* vp = Vt + ((2 * eh + 1) * 32 + r) * 136 + mk * 32 + 4 * hh;
        O1 = MFMA32(cat4(*(const s16x4*)vp, *(const s16x4*)(vp + 8)), p0, O1);
        O1 = MFMA32(cat4(*(const s16x4*)(vp + 16), *(const s16x4*)(vp + 24)), p1, O1); }
    }
    { u16* orow = Z + (size_t)(lrow0 + lt * 32 + r) * ZS + C_BV + hd * 128 + (2 * eh) * 32;
      _Pragma("unroll") for (int gq = 0; gq < 4; ++gq) {
        st4bf(orow + 8 * gq + 4 * hh, O0[4 * gq], O0[4 * gq + 1], O0[4 * gq + 2], O0[4 * gq + 3]);
        st4bf(orow + 32 + 8 * gq + 4 * hh, O1[4 * gq], O1[4 * gq + 1], O1[4 * gq + 2], O1[4 * gq + 3]);
      } }
    _Pragma("unroll") for (int s = 0; s < 8; ++s)
      Sacc = MFMA32(ld8(Vt + (lt * 32 + r) * 136 + 16 * s + 8 * hh), ld8(KKt + (eh * 32 + r) * 136 + 16 * s + 8 * hh), Sacc);
    _Pragma("unroll") for (int i = 0; i < 16; ++i) Sacc[i] *= g128;
    __syncthreads();
    _Pragma("unroll") for (int i = 0; i < 16; ++i) St[(lt * 32 + crow(i, hh)) * 72 + eh * 32 + r] = f2bf(Sacc[i]);
  }
  float* so = P.out + O_RETP + (size_t)((l * 16 + b) * 8 + hd) * 8192 + (size_t)(eh * 32 + r) * 128 + lt * 32;
  _Pragma("unroll") for (int gq = 0; gq < 4; ++gq) *reinterpret_cast<f32x4*>(so + 8 * gq + 4 * hh) = (f32x4){Sacc[4 * gq], Sacc[4 * gq + 1], Sacc[4 * gq + 2], Sacc[4 * gq + 3]};
}

DI void ssd_prompt_item(char* shm, const Params& P, int l, int hf, int b, int hc) {
  u16* Bm = (u16*)shm;
  u16* Cm = Bm + 128 * 136;
  u16* Xs = Cm + 128 * 136;
  u16* XwT = Xs + 64 * 136;
  u16* Hs = XwT + 64 * 136;
  float* acum = (float*)(Hs + 64 * 136);
  float* dtv = acum + 128;
  float* tot = dtv + 128;
  const u16* Z = (const u16*)(optr(P.ws) + WS_Z);
  u16* YC = (u16*)(optr(P.ws) + WS_YC);
  const u16* XBC = (const u16*)(optr(P.ws) + WS_XBC);
  const float* DT = (const float*)(optr(P.ws) + WS_DT);
  const int tid = otid(), lane = tid & 63, w = tid >> 6, r = lane & 31, hh = lane >> 5;
  const int g = hc >> 3;
  const float Aneg = -expf(P.A_log[l * 16 + hc]), dtb = P.dt_bias[l * 16 + hc], dsk = P.D_skip[l * 16 + hc];
  const float* cw = P.conv_w + (size_t)l * 4 * 1536;
  const float* cb = P.conv_b + (size_t)l * 1536;
  const int lrowb = b * 2048 - hf * HALF_ROWS;
  __syncthreads();
  for (int e = tid; e < 64 * 136; e += NT) Hs[e] = 0;
  f32x16 Hacc = zero16();
  const int pt = w >> 2, it = w & 3;
  bf16x8 pB[4], pC[4], pX[2]; float pdt = 0.f;
#define SSD_ISSUE(cc) do { const int _t0 = (cc) * 128; \
    _Pragma("unroll") for (int itr = 0; itr < 4; ++itr) { const int idx = tid + itr * NT, row = idx >> 4, part = idx & 15; \
      const u16* _p = XBC + (size_t)(lrowb + _t0 + row) * 1536 + g * 128 + part * 8; pB[itr] = ld8(_p + 1024); pC[itr] = ld8(_p + 1280); } \
    _Pragma("unroll") for (int itr = 0; itr < 2; ++itr) { const int idx = tid + itr * NT, row = idx & 127, part = idx >> 7; \
      pX[itr] = ld8(XBC + (size_t)(lrowb + _t0 + row) * 1536 + hc * 64 + part * 8); } \
    if (tid < 128) pdt = DT[(size_t)(lrowb + _t0 + tid) * 16 + hc]; } while (0)
  SSD_ISSUE(0);
  _Pragma("unroll 1") for (int c = 0; c < 16; ++c) {
    const int tok0 = c * 128;
    bf16x8 xr[2]; xr[0] = pX[0]; xr[1] = pX[1];
    if (tid < 128) {
      const float dt = pdt;
      float v = dt * Aneg;
      for (int o = 1; o < 64; o <<= 1) { const float t = shup(v, o, lane); if (lane >= o) v += t; }
      dtv[tid] = dt; acum[tid] = v;
      if (tid == 63) tot[0] = v;
    }
    _Pragma("unroll") for (int itr = 0; itr < 4; ++itr) { const int idx = tid + itr * NT, row = idx >> 4, part = idx & 15;
      st8(Bm + row * 136 + part * 8, pB[itr]); st8(Cm + row * 136 + part * 8, pC[itr]); }
    __syncthreads();
    if (tid >= 64 && tid < 128) acum[tid] += tot[0];
    __syncthreads();
    const float alast = acum[127];
    _Pragma("unroll") for (int itr = 0; itr < 2; ++itr) {
      const int idx = tid + itr * NT, row = idx & 127, part = idx >> 7;
      const float wj = __expf(alast - acum[row]) * dtv[row];
      _Pragma("unroll") for (int j = 0; j < 8; ++j) { const float xs = bfs(xr[itr][j]); Xs[(part * 8 + j) * 136 + row] = (u16)xr[itr][j]; XwT[(part * 8 + j) * 136 + row] = f2bf(xs * wj); }
    }
    if (c + 1 < 16) SSD_ISSUE(c + 1);
    __syncthreads();
    const u16* cfp = Cm + (it * 32 + r) * 136 + 8 * hh;
    f32x16 Y = zero16();
    _Pragma("unroll") for (int s = 0; s < 8; ++s) Y = MFMA32(ld8(Hs + (pt * 32 + r) * 136 + 16 * s + 8 * hh), ld8(cfp + 16 * s), Y);
    const float ai = acum[it * 32 + r];
    { const float ea = __expf(ai); _Pragma("unroll") for (int i = 0; i < 16; ++i) Y[i] *= ea; }
    _Pragma("unroll 1") for (int jt = 0; jt <= it; ++jt) {
      f32x16 Gm = zero16();
      _Pragma("unroll") for (int s = 0; s < 8; ++s) Gm = MFMA32(ld8(Bm + (jt * 32 + r) * 136 + 16 * s + 8 * hh), ld8(cfp + 16 * s), Gm);
      _Pragma("unroll") for (int i = 0; i < 16; ++i) {
        const int jl = crow(i, hh), j = jt * 32 + jl;
        const float v = Gm[i] * __expf(ai - acum[j]) * dtv[j];
        Gm[i] = (jt == it && jl > r) ? 0.f : v;
      }
      const bf16x8 p0 = packP<0>(Gm), p1 = packP<1>(Gm);
      const u16* xp = Xs + (pt * 32 + r) * 136 + jt * 32 + 4 * hh;
      Y = MFMA32(cat4(*(const s16x4*)xp, *(const s16x4*)(xp + 8)), p0, Y);
      Y = MFMA32(cat4(*(const s16x4*)(xp + 16), *(const s16x4*)(xp + 24)), p1, Y);
    }
    _Pragma("unroll") for (int i = 0; i < 16; ++i) Y[i] += dsk * bf2f(Xs[(pt * 32 + crow(i, hh)) * 136 + it * 32 + r]);
    { u16* yrow = YC + (size_t)(lrowb + tok0 + it * 32 + r) * D + hc * 64 + pt * 32;
      _Pragma("unroll") for (int gq = 0; gq < 4; ++gq) st4bf(yrow + 8 * gq + 4 * hh, Y[4 * gq], Y[4 * gq + 1], Y[4 * gq + 2], Y[4 * gq + 3]); }
    { const float dl = __expf(alast); _Pragma("unroll") for (int i = 0; i < 16; ++i) Hacc[i] *= dl; }
    _Pragma("unroll") for (int s = 0; s < 8; ++s) {
      const bf16x8 xf = ld8(XwT + (pt * 32 + r) * 136 + 16 * s + 8 * hh);
      const u16* bp = Bm + (16 * s + 8 * hh) * 136 + it * 32 + r;
      u32x4 pb;
      _Pragma("unroll") for (int q = 0; q < 4; ++q) pb[q] = (unsigned)bp[(2 * q) * 136] | ((unsigned)bp[(2 * q + 1) * 136] << 16);
      Hacc = MFMA32(xf, __builtin_bit_cast(bf16x8, pb), Hacc);
    }
    __syncthreads();
    _Pragma("unroll") for (int i = 0; i < 16; ++i) Hs[(pt * 32 + crow(i, hh)) * 136 + it * 32 + r] = f2bf(Hacc[i]);
  }
  { float* ho = P.out + O_SSMP + (size_t)((l * 16 + b) * 16 + hc) * 8192;
    _Pragma("unroll") for (int i = 0; i < 16; ++i) ho[(pt * 32 + crow(i, hh)) * 128 + it * 32 + r] = Hacc[i]; }
  { float* co = P.out + O_CONVP + (size_t)(l * 16 + b) * 3 * 1536;
    for (int e = tid; e < 3 * 64; e += NT) { const int i = e >> 6, ch = hc * 64 + (e & 63); co[i * 1536 + ch] = bf2f(Z[(size_t)(lrowb + 2045 + i) * ZS + C_CX + ch]); }
    if ((hc & 7) == 0) for (int e = tid; e < 3 * 256; e += NT) { const int i = e >> 8, q = e & 255; const int ch = (q < 128 ? 1024 : 1280 - 128) + g * 128 + q; co[i * 1536 + ch] = bf2f(Z[(size_t)(lrowb + 2045 + i) * ZS + C_CX + ch]); } }
}

DI void ssd_sample_item(char* shm, const Params& P, int l, int s, int g) {
  float* xs = (float*)shm;
  float* Bs = xs + 512;
  float* Cs = Bs + 128;
  float* dts = Cs + 128;
  const int tid = otid(), lane = tid & 63, w = tid >> 6;
  const int lr = MPROMPT + s - HALF_ROWS;
  const u16* zr = (const u16*)(optr(P.ws) + WS_Z) + (size_t)lr * ZS;
  u16* YC = (u16*)(optr(P.ws) + WS_YC) + (size_t)lr * D;
  const float* cw = P.conv_w + (size_t)l * 4 * 1536;
  const float* cb = P.conv_b + (size_t)l * 1536;
  const float* hist = P.state_conv + (size_t)(l * 128 + s) * 3 * 1536;
  float* cso = P.out + O_CONVS + (size_t)(l * 128 + s) * 3 * 1536;
  __syncthreads();
  for (int u = tid; u < 768; u += NT) {
    int ch; float* dst;
    if (u < 512) { ch = g * 512 + u; dst = xs + u; } else if (u < 640) { ch = 1024 + g * 128 + (u - 512); dst = Bs + (u - 512); } else { ch = 1280 + g * 128 + (u - 640); dst = Cs + (u - 640); }
    const float h0 = hist[ch], h1 = hist[1536 + ch], h2 = hist[2 * 1536 + ch], nw = bf2f(zr[C_CX + ch]);
    const float a = cb[ch] + cw[ch] * h0 + cw[1536 + ch] * h1 + cw[2 * 1536 + ch] * h2 + cw[3 * 1536 + ch] * nw;
    *dst = siluf(a);
    cso[ch] = h1; cso[1536 + ch] = h2; cso[2 * 1536 + ch] = nw;
  }
  if (tid < 8) { const int hc = g * 8 + tid; const float dt = softplusf(bf2f(zr[C_DT + hc]) + P.dt_bias[l * 16 + hc]); dts[tid] = dt; dts[8 + tid] = expf(dt * -expf(P.A_log[l * 16 + hc])); }
  __syncthreads();
  const int hc = g * 8 + w;
  const float dt = dts[w], dA = dts[8 + w], dsk = P.D_skip[l * 16 + hc];
  const float* hin = P.state_ssm + (size_t)((l * 128 + s) * 16 + hc) * 8192;
  float* hout = P.out + O_SSMS + (size_t)((l * 128 + s) * 16 + hc) * 8192;
  const int n4 = (lane & 31) * 4, psub = lane >> 5;
  const f32x4 Bv = *reinterpret_cast<const f32x4*>(Bs + n4), Cv = *reinterpret_cast<const f32x4*>(Cs + n4);
  {
    const int ib = 0;
    f32x4 hv[32];
    _Pragma("unroll") for (int k = 0; k < 32; ++k) hv[k] = __builtin_nontemporal_load(reinterpret_cast<const f32x4*>(hin + (k * 2 + psub) * 128 + n4));
    _Pragma("unroll") for (int k = 0; k < 32; ++k) {
      const int p = (ib * 16 + k) * 2 + psub;
      const float xv = xs[w * 64 + p];
      const f32x4 hn = hv[k] * dA + Bv * (dt * xv);
      __builtin_nontemporal_store(hn, reinterpret_cast<f32x4*>(hout + p * 128 + n4));
      float y = hn[0] * Cv[0] + hn[1] * Cv[1] + hn[2] * Cv[2] + hn[3] * Cv[3];
      for (int o = 16; o >= 1; o >>= 1) y += shx(y, o, lane);
      if ((lane & 31) == 0) YC[hc * 64 + p] = f2bf(y + dsk * xv);
    }
  }
}

DI void ret_sample_item(char* shm, const Params& P, int l, int s) {
  float* qk = (float*)shm;
  const int tid = otid(), lane = tid & 63, w = tid >> 6;
  const int lr = MPROMPT + s - HALF_ROWS;
  u16* zr = (u16*)(optr(P.ws) + WS_Z) + (size_t)lr * ZS;
  __syncthreads();
  const float gamma = 1.f - exp2f(-5.f - (float)w);
  if (lane < 32) {
    const float th = 1.f / powf(10000.f, (float)lane / 31.f);
    float sn, cs; sincos_rev(16384.f * th, sn, cs);
    const float q1 = bf2f(zr[C_BQ + w * 64 + 2 * lane]), q2 = bf2f(zr[C_BQ + w * 64 + 2 * lane + 1]);
    const float k1 = bf2f(zr[C_BK + w * 64 + 2 * lane]) * 0.125f, k2 = bf2f(zr[C_BK + w * 64 + 2 * lane + 1]) * 0.125f;
    qk[w * 128 + 2 * lane] = q1 * cs - q2 * sn; qk[w * 128 + 2 * lane + 1] = q1 * sn + q2 * cs;
    qk[w * 128 + 64 + 2 * lane] = k1 * cs - k2 * sn; qk[w * 128 + 64 + 2 * lane + 1] = k1 * sn + k2 * cs;
  }
  const int e4 = (lane & 31) * 4, dsub = lane >> 5;
  f32x4 v4;
  _Pragma("unroll") for (int j = 0; j < 4; ++j) v4[j] = bf2f(zr[C_BV + w * 128 + e4 + j]);
  __syncthreads();
  const float* Sin = P.state_ret + (size_t)((l * 128 + s) * 8 + w) * 8192;
  float* Sout = P.out + O_RETS + (size_t)((l * 128 + s) * 8 + w) * 8192;
  f32x4 o4 = (f32x4){0.f, 0.f, 0.f, 0.f};
  {
    const int ib = 0;
    f32x4 sv[32];
    _Pragma("unroll") for (int k = 0; k < 32; ++k) sv[k] = __builtin_nontemporal_load(reinterpret_cast<const f32x4*>(Sin + (k * 2 + dsub) * 128 + e4));
    _Pragma("unroll") for (int k = 0; k < 32; ++k) {
      const int d = (ib * 16 + k) * 2 + dsub;
      const f32x4 sn = sv[k] * gamma + v4 * qk[w * 128 + 64 + d];
      __builtin_nontemporal_store(sn, reinterpret_cast<f32x4*>(Sout + d * 128 + e4));
      o4 += sn * qk[w * 128 + d];
    }
  }
  _Pragma("unroll") for (int j = 0; j < 4; ++j) o4[j] += shx(o4[j], 32, lane);
  if (dsub == 0) st4bf(zr + C_BV + w * 128 + e4, o4[0], o4[1], o4[2], o4[3]);
}

DI void att_sample_item(char* shm, const Params& P, int l, int s) {
  float* Kc = (float*)shm;
  float* Vc = Kc + 129 * 65;
  float* qv = Vc + 129 * 65;
  float* sc = qv + 256;
  float* red = sc + 512;
  const int tid = otid(), lane = tid & 63, w = tid >> 6;
  const int lr = MPROMPT + s - HALF_ROWS;
  u16* zr = (u16*)(optr(P.ws) + WS_Z) + (size_t)lr * ZS;
  const float* bt = (const float*)(optr(P.ws) + WS_BT);
  const float* ck = P.cache_k + (size_t)(l * 128 + s) * 128 * 256;
  const float* cv = P.cache_v + (size_t)(l * 128 + s) * 128 * 256;
  float* ok = P.out + O_WKS + (size_t)(l * 128 + s) * 128 * 256;
  float* ov = P.out + O_WVS + (size_t)(l * 128 + s) * 128 * 256;
  _Pragma("unroll 1") for (int kvh = 0; kvh < 4; ++kvh) {
    __syncthreads();
    {
      const int d4 = (tid & 15) * 4;
      f32x4 kk[4], vv[4];
      _Pragma("unroll") for (int itr = 0; itr < 4; ++itr) { const int j = (tid >> 4) + 32 * itr;
        kk[itr] = __builtin_nontemporal_load(reinterpret_cast<const f32x4*>(ck + j * 256 + kvh * 64 + d4)); vv[itr] = __builtin_nontemporal_load(reinterpret_cast<const f32x4*>(cv + j * 256 + kvh * 64 + d4)); }
      _Pragma("unroll") for (int itr = 0; itr < 4; ++itr) { const int j = (tid >> 4) + 32 * itr;
        _Pragma("unroll") for (int q = 0; q < 4; ++q) { Kc[j * 65 + d4 + q] = kk[itr][q]; Vc[j * 65 + d4 + q] = vv[itr][q]; }
        if (j >= 1) { __builtin_nontemporal_store(kk[itr], reinterpret_cast<f32x4*>(ok + (j - 1) * 256 + kvh * 64 + d4)); __builtin_nontemporal_store(vv[itr], reinterpret_cast<f32x4*>(ov + (j - 1) * 256 + kvh * 64 + d4)); } }
    }
    if (tid < 64) { const float kn = bf2f(zr[C_AK + kvh * 64 + tid]), vn = bf2f(zr[C_AV + kvh * 64 + tid]); Kc[128 * 65 + tid] = kn; Vc[128 * 65 + tid] = vn; ok[127 * 256 + kvh * 64 + tid] = kn; ov[127 * 256 + kvh * 64 + tid] = vn; }
    if (tid < 256) qv[tid] = bf2f(zr[C_AQ + kvh * 256 + tid]);
    __syncthreads();
    const int g = tid >> 7, c = 1 + (tid & 127), qh = kvh * 4 + g;
    float dot = 0.f;
    _Pragma("unroll 1") for (int d = 0; d < 64; ++d) dot += qv[g * 64 + d] * Kc[c * 65 + d];
    const float score = dot * 0.125f + bt[(128 - c) * 16 + qh];
    float mx = score;
    for (int o = 32; o >= 1; o >>= 1) mx = fmaxf(mx, shx(mx, o, lane));
    if (lane == 0) red[w] = mx;
    __syncthreads();
    const float sink = P.sinks[l * 16 + qh];
    const float m = fmaxf(fmaxf(red[2 * g], red[2 * g + 1]), sink);
    const float e = __expf(score - m);
    float sm = e;
    for (int o = 32; o >= 1; o >>= 1) sm += shx(sm, o, lane);
    if (lane == 0) red[8 + w] = sm;
    __syncthreads();
    const float den = red[8 + 2 * g] + red[8 + 2 * g + 1] + __expf(sink - m);
    sc[g * 128 + (c - 1)] = e * __builtin_amdgcn_rcpf(den);
    __syncthreads();
    if (tid < 256) {
      const int g2 = tid >> 6, d = tid & 63; float o = 0.f;
      for (int cc = 1; cc <= 128; ++cc) o += sc[g2 * 128 + cc - 1] * Vc[cc * 65 + d];
      zr[C_AQ + (kvh * 4 + g2) * 64 + d] = f2bf(o);
    }
  }
}

DI void mixer_phase(char* shm, const Params& P, int l, int hf, int ph) {
  __shared__ int s_item;
  unsigned* ctr = (unsigned*)(optr(P.ws) + WS_CTR) + ph;
  const int nitems = 128 + 64 + 512 + (hf ? 512 : 0);
  for (;;) {
    __syncthreads();
    if (threadIdx.x == 0) s_item = (int)atomicAdd(ctr, 1u);
    __syncthreads();
    int it = s_item;
    if (it >= nitems) break;
    const int nsamp = hf ? 512 : 0;
    if (it < 128) { ssd_prompt_item(shm, P, l, hf, hf * 8 + (it >> 4), it & 15); }
    else if ((it -= 128) < 64) { ret_prompt_item(shm, P, l, hf, hf * 8 + (it >> 3), it & 7); }
    else if ((it -= 64) < nsamp) {
      if (it < 256) { ssd_sample_item(shm, P, l, it >> 1, it & 1); }
      else if ((it -= 256) < 128) { ret_sample_item(shm, P, l, it); }
      else { it -= 128; att_sample_item(shm, P, l, it); }
    }
    else { it -= nsamp; att_prompt_item(shm, P, l, hf, hf * 8 + (it >> 6), (it >> 2) & 15, it & 3); }
  }
}

#define SEQ0 0x87543210ull
#define LEN0 8
#define SEQ1 0x8754321ull
#define LEN1 7
constexpr int PH_G0 = 3;
constexpr int N_PHASES = PH_G0 + 2 * (LEN0 + LEN1) + 1;
#ifndef MAXPH
#define MAXPH N_PHASES
#endif
__global__ void __launch_bounds__(NT) fwd_kernel(Params P) {
  extern __shared__ __attribute__((aligned(16))) unsigned char lds[];
  char* shm = (char*)lds;
  cg::grid_group grid = cg::this_grid();
  unsigned char* ws = P.ws;
  const float* mod = (const float*)(ws + WS_MOD);
  for (int ph = P.ph_lo; ph < P.ph_hi; ++ph) {
    if (ph > P.ph_lo) grid.sync();
    if (ph == 0) { prep_phase(shm, P); continue; }
    if (ph == N_PHASES - 1) { final_norm_phase(P); continue; }
    const int q = (ph < PH_G0) ? 0 : ph - PH_G0, hf = q / (LEN0 + LEN1), qq = q % (LEN0 + LEN1), l = (qq >= LEN0) ? 1 : 0;
    const int sub = (ph == 1) ? 9 : (ph == 2) ? 10 : l ? (int)((SEQ1 >> (4 * (qq - LEN0))) & 15ull) : (int)((SEQ0 >> (4 * qq)) & 15ull);
    const int ntm = hf ? 65 : 64, RB = hf * HALF_ROWS, NV = hf ? 16512 : 16384;
    if (sub == 0) { norm_phase(P, l, hf, 0, l == 0); continue; }
    if (sub == 2) { conv_phase(P, l, hf); continue; }
    if (sub == 3) { mixer_phase(shm, P, l, hf, ph); continue; }
    if (sub == 4) { mix_phase(P, l, hf); continue; }
    Epi E{};
    const int Gd = gridDim.x;
    const int bxr = (Gd % 8 == 0) ? (int)((blockIdx.x % 8) * (Gd / 8) + blockIdx.x / 8) : (int)blockIdx.x;
    const int cw = (bxr < 41) ? 0 : (bxr < 57) ? 1 : 2;
    const bool first_res = (sub == 5 && l == 0);
    E.kind = (sub == 9) ? 3 : (sub == 10) ? 6 : (sub == 1) ? 0 : (sub == 7) ? 1 : 2;
    E.c16 = (u16*)(ws + WS_Z); E.ldc = (sub == 1) ? ZS : (sub == 10) ? (cw == 0 ? ZS : DFF) : DFF;
    E.rb = RB; E.nv = NV; E.xout = P.out; E.mod = mod; E.goff = l * 6144 + ((sub == 5) ? 2048 : 5120);
    E.res_p = first_res ? P.x_prompt : (const float*)P.out;
    E.res_s = first_res ? P.x_sample : (const float*)(P.out + (size_t)MPROMPT * D);
    E.modout = (float*)(ws + WS_MOD); E.ada_b = P.ada_b; E.shb = (u16*)(ws + WS_SHB);
    E.cout = (float*)(ws + ((cw == 0) ? WS_C1 : WS_C2 + (size_t)(cw - 1) * 144 * DFF * 4));
    E.fuse = (sub == 5 || (sub == 8 && l == 0)) ? 1 : 0;
    E.fw = (sub == 5) ? P.n2 + l * D : P.n1 + D;
    E.fsc = (sub == 5) ? l * 6144 + 4096 : 6144 + 1024;
    E.fa = (u16*)(ws + ((sub == 5) ? WS_XBC : WS_H));
    E.fss = (float*)(ws + ((sub == 5) ? WS_SS2 : WS_SS1));
    E.cons = (sub == 7 || (sub == 1 && l == 1)) ? 1 : 0;
    E.css = (const float*)(ws + ((sub == 7) ? WS_SS2 : WS_SS1));
    E.cc = (const float*)(ws + ((sub == 7) ? WS_C2 + (size_t)l * 144 * DFF * 4 : WS_C1));
    E.ccld = (sub == 7) ? DFF : ZS;
    const bf16* A = (const bf16*)(ws + ((sub == 9) ? WS_SC : (sub == 10) ? WS_SHB + (size_t)cw * 256 * D * 2 : (sub == 8) ? WS_Z : (sub == 7) ? WS_XBC : WS_H));
    const size_t boff = (sub == 9) ? WS_AWT : (sub == 10) ? (cw == 0 ? WS_WIN + (size_t)ZS * D * 2 : WS_WUP + (size_t)(cw - 1) * DFF * D * 2)
                      : (sub == 1) ? WS_WIN + (size_t)l * ZS * D * 2 : (sub == 5) ? WS_WOUT + (size_t)l * D * D * 2
                      : (sub == 7) ? WS_WUP + (size_t)l * DFF * D * 2 : WS_WDN + (size_t)l * D * DFF * 2;
    const bf16* Bt = (const bf16*)(ws + boff);
    const int K = (sub == 8) ? DFF : D;
    const int tm = (sub == 9 || sub == 10) ? 1 : ntm;
    const int tn = (sub == 9) ? 48 : (sub == 10) ? (cw == 0 ? 41 : 16) : (sub == 1) ? 41 : (sub == 7) ? 16 : 4;
    const int toff = (sub == 10) ? (cw == 0 ? 0 : cw == 1 ? 41 : 57) : 0;
    asm volatile("" : "+s"(E.xout), "+s"(E.res_p), "+s"(E.res_s), "+s"(E.mod), "+s"(A), "+s"(Bt), "+s"(E.fa), "+s"(E.fss), "+s"(E.css), "+s"(E.cc), "+s"(E.cout));
    E.xout = gptr(E.xout); E.res_p = gptr(E.res_p); E.res_s = gptr(E.res_s); E.mod = gptr(E.mod); A = gptr(A); Bt = gptr(Bt);
    E.fa = gptr(E.fa); E.fss = gptr(E.fss); E.css = gptr(E.css); E.cc = gptr(E.cc); E.cout = gptr(E.cout);
    gemm_phase(shm, A, Bt, K, tm, tn, E, (hf == 1 && sub == 8 && l == 1) ? 1 : 0, toff, (hf == 1 && sub != 9 && sub != 10) ? 1 : 0);
  }
}

extern "C" void kernel_launch(void* const* d_in, const int* in_sizes, int n_in, void* d_out, int out_size, void* d_ws, size_t ws_size, hipStream_t stream) {
  static int grid = 0;
  if (grid == 0) {
    if (n_in != 26 || ws_size < WS_END) { fprintf(stderr, "kernel_launch: bad inputs n_in=%d ws=%zu need %zu\n", n_in, ws_size, (size_t)WS_END); grid = -1; return; }
    int dev = 0, cus = 0, per_cu = 0;
    (void)hipGetDevice(&dev);
    (void)hipDeviceGetAttribute(&cus, hipDeviceAttributeMultiprocessorCount, dev);
    if (hipFuncSetAttribute((const void*)fwd_kernel, hipFuncAttributeMaxDynamicSharedMemorySize, LDS_BYTES) != hipSuccess) { fprintf(stderr, "hipFuncSetAttribute failed\n"); grid = -1; return; }
    (void)hipOccupancyMaxActiveBlocksPerMultiprocessor(&per_cu, (const void*)fwd_kernel, NT, LDS_BYTES);
    if (per_cu < 1) { fprintf(stderr, "occupancy query returned %d\n", per_cu); per_cu = 1; }
    (void)hipGetLastError();
    grid = cus * per_cu;
  }
  if (grid < 0) return;
  (void)hipMemsetAsync((char*)d_ws + WS_CTR, 0, 256, stream);
  Params p{};
  const float** pp = (const float**)&p;
  _Pragma("unroll") for (int i = 0; i < 26; ++i) pp[i] = (const float*)d_in[i];
  p.out = (float*)d_out; p.ws = (unsigned char*)d_ws;
#if FUSED
  p.ph_lo = 0; p.ph_hi = MAXPH;
  void* args[] = {&p};
  hipError_t e = hipLaunchCooperativeKernel((const void*)fwd_kernel, dim3(grid), dim3(NT), args, LDS_BYTES, stream);
  if (e != hipSuccess) fprintf(stderr, "cooperative launch failed: %s (grid %d)\n", hipGetErrorString(e), grid);
#else
  for (int ph = 0; ph < MAXPH; ++ph) {
    p.ph_lo = ph; p.ph_hi = ph + 1;
    hipLaunchKernelGGL(fwd_kernel, dim3(grid), dim3(NT), LDS_BYTES, stream, p);
  }
#endif
}
```

```cpp
#include <hip/hip_runtime.h>
#include <hip/hip_bf16.h>
#include <hip/hip_cooperative_groups.h>
#include <cstdio>
namespace cg = cooperative_groups;

#ifndef FUSED
#define FUSED 1
#endif

typedef unsigned short u16;
using bf16 = __hip_bfloat16;
using bf16x8 = __attribute__((ext_vector_type(8))) short;
using s16x4  = __attribute__((ext_vector_type(4))) short;
using f32x4  = __attribute__((ext_vector_type(4))) float;
using f32x16 = __attribute__((ext_vector_type(16))) float;
using u32x4  = __attribute__((ext_vector_type(4))) unsigned;
using u32x2  = __attribute__((ext_vector_type(2))) unsigned;
#define DI __device__ __forceinline__

constexpr int D = 1024, DIN = 10256, ZS = 10496, DFF = 4096;
constexpr int MPROMPT = 32768, MVALID = 32896;
constexpr int HALF_ROWS = 16384, ZROWS = 16640;
constexpr int C_AQ = 0, C_AK = 1024, C_AV = 1280, C_BQ = 1536, C_BK = 2048, C_BV = 2560, C_BG = 3584, C_CZ = 4608,
              C_CX = 5632, C_DT = 7168, C_GA = 7184, C_GB = 8208, C_GC = 9232;
constexpr int MODS = 12288;
constexpr float EPS = 1e-6f;
constexpr int NT = 512;

constexpr size_t O_YP = 0, O_YS = O_YP + 33554432, O_WKP = O_YS + 131072, O_WVP = O_WKP + 1048576, O_RETP = O_WVP + 1048576,
                 O_SSMP = O_RETP + 2097152, O_CONVP = O_SSMP + 4194304, O_WKS = O_CONVP + 147456, O_WVS = O_WKS + 8388608,
                 O_RETS = O_WVS + 8388608, O_SSMS = O_RETS + 16777216, O_CONVS = O_SSMS + 33554432;
constexpr size_t WS_CTR = 0, WS_BT = 256, WS_SC = 16384, WS_MOD = WS_SC + 524288, WS_AWT = WS_MOD + 7077888,
                 WS_WIN = WS_AWT + 25165824, WS_WOUT = WS_WIN + 42991616, WS_WUP = WS_WOUT + 4194304, WS_WDN = WS_WUP + 16777216,
                 WS_H = WS_WDN + 16777216, WS_YC = WS_H + 34078720, WS_Z = WS_YC + 34078720, WS_XBC = WS_Z + 349306880,
                 WS_DT = WS_XBC + 51118080, WS_SS1 = WS_DT + 1064960, WS_SS2 = WS_SS1 + 66560, WS_C1 = WS_SS2 + 66560,
                 WS_C2 = WS_C1 + 6045696, WS_SHB = WS_C2 + 4718592, WS_END = WS_SHB + 1572864;
constexpr int LDS_BYTES = 147456;

struct Params {
  const float *x_prompt, *x_sample, *cache_k, *cache_v, *state_ret, *state_ssm, *state_conv, *c_prompt, *c_sample, *rel, *sinks,
      *n1, *n2, *ada_w, *ada_b, *w_in, *conv_w, *conv_b, *dt_bias, *A_log, *D_skip, *snw, *w_out, *w_up, *w_down, *fnw;
  float* out; unsigned char* ws; int ph_lo, ph_hi;
};

typedef float f32x2v __attribute__((ext_vector_type(2)));
typedef __bf16 bf16x2v __attribute__((ext_vector_type(2)));
DI unsigned pack2(float a, float b) { f32x2v v = {a, b}; return __builtin_bit_cast(unsigned, __builtin_convertvector(v, bf16x2v)); }
DI u16 f2bf(float x) { return (u16)(pack2(x, 0.f) & 0xffffu); }
DI float bf2f(u16 h) { return __uint_as_float(((unsigned)h) << 16); }
DI float bfs(short h) { return __uint_as_float(((unsigned)(u16)h) << 16); }
DI bf16x8 ld8(const u16* p) { return *reinterpret_cast<const bf16x8*>(p); }
DI void st8(u16* p, bf16x8 v) { *reinterpret_cast<bf16x8*>(p) = v; }
DI bf16x8 cat4(s16x4 lo, s16x4 hi) { return __builtin_shufflevector(lo, hi, 0, 1, 2, 3, 4, 5, 6, 7); }
DI f32x16 zero16() { f32x16 v; _Pragma("unroll") for (int i = 0; i < 16; ++i) v[i] = 0.f; return v; }
DI int crow(int i, int h) { return (i & 3) + 8 * (i >> 2) + 4 * h; }
#define MFMA32(a, b, c) __builtin_amdgcn_mfma_f32_32x32x16_bf16((a), (b), (c), 0, 0, 0)
template <int S> DI bf16x8 packP(const f32x16& x) {
  u32x4 p; p[0] = pack2(x[8 * S], x[8 * S + 1]); p[1] = pack2(x[8 * S + 2], x[8 * S + 3]);
  p[2] = pack2(x[8 * S + 4], x[8 * S + 5]); p[3] = pack2(x[8 * S + 6], x[8 * S + 7]);
  return __builtin_bit_cast(bf16x8, p);
}
DI bf16x8 pack8(const float* v) {
  u32x4 p; p[0] = pack2(v[0], v[1]); p[1] = pack2(v[2], v[3]); p[2] = pack2(v[4], v[5]); p[3] = pack2(v[6], v[7]);
  return __builtin_bit_cast(bf16x8, p);
}
DI void st4bf(u16* p, float a, float b, float c, float d) { u32x2 v; v[0] = pack2(a, b); v[1] = pack2(c, d); *reinterpret_cast<u32x2*>(p) = v; }
DI float siluf(float x) { return x * __builtin_amdgcn_rcpf(1.f + __expf(-x)); }
DI float sigmf(float x) { return __builtin_amdgcn_rcpf(1.f + __expf(-x)); }
DI float softplusf(float x) { return x > 20.f ? x : log1pf(expf(x)); }
DI int otid() { int t = threadIdx.x; asm volatile("" : "+v"(t)); return t; }
#define GAS __attribute__((address_space(1)))
template <class T> DI T* gptr(T* p) { return (T*)(GAS T*)(unsigned long long)p; }
template <class T> DI T* optr(T* p) { unsigned long long v = (unsigned long long)p; asm volatile("" : "+s"(v)); return (T*)(GAS T*)v; }
DI float shx(float v, int m, int lane) { return __int_as_float(__builtin_amdgcn_ds_bpermute((lane ^ m) << 2, __float_as_int(v))); }
DI float shup(float v, int o, int lane) { return __int_as_float(__builtin_amdgcn_ds_bpermute((lane - o) << 2, __float_as_int(v))); }
DI int modrow(int r) { return r < MPROMPT ? (r >> 11) : 16 + (r - MPROMPT); }
DI void sincos_rev(float ang, float& s, float& c) {
  float k = rintf(ang * 0.15915494309189535f);
  float red = fmaf(-k, 6.28318548202514648f, ang);
  red = fmaf(-k, -1.7484555e-7f, red);
  float fr = red * 0.15915494309189535f;
  s = __builtin_amdgcn_sinf(fr); c = __builtin_amdgcn_cosf(fr);
}

constexpr int BM = 256, BK = 64, HALFT = 128, HT = HALFT * BK;
DI int lds_byte(int r, int c) { int st = (r >> 4) * 2 + (c >> 5), rr = r & 15, cc = c & 31, ob = rr * 64 + cc * 2; return st * 1024 + (ob ^ (((ob >> 9) & 1) << 5)); }
DI void stage_rc(int b, int& R, int& C) { int st = b / 1024, sb = b % 1024, swz = sb ^ (((sb >> 9) & 1) << 5); R = (st >> 1) * 16 + swz / 64; C = (st & 1) * 32 + (swz % 64) / 2; }

struct Epi {
  int kind;
  u16* c16; int ldc;
  int rb, nv;
  const float* res_p; const float* res_s;
  float* xout;
  const float* mod; int goff;
  float* modout; const float* ada_b;
  u16* shb;
  float* cout;
  int fuse;
  const float* fw; int fsc; u16* fa; float* fss;
  int cons;
  const float* css; const float* cc; int ccld;
};

#define LAS __attribute__((address_space(3)))
constexpr int HTB = HALFT * BK * 2;
DI void epilogue(const f32x4 (&acc)[2][2][4][2], const Epi& E, int brow, int bcol, int wr, int wc, int fr, int fq, int at) {
  const int col0 = bcol + wc * 32 + fq * 8;
  const int row0 = brow + wr * 64 + fr;
  const int lane = (fq << 4) | fr;
  const bool ptile = (E.rb + brow + 255) < MPROMPT;
  const int pb = (E.rb + brow) >> 11;
#define ECOL(j) (col0 + ((j) >> 1) * HALFT + ((j) & 1) * 4)
#define EROW(g) (row0 + ((g) >> 2) * HALFT + ((g) & 3) * 16)
#define EACC(g, j) acc[(g) >> 2][(j) >> 1][(g) & 3][(j) & 1]
  if (E.kind <= 1) {
    float ssv[8]; f32x4 cv[4];
    if (E.cons) {
      _Pragma("unroll") for (int g = 0; g < 8; ++g) ssv[g] = E.css[EROW(g)];
      if (ptile) { _Pragma("unroll") for (int j = 0; j < 4; ++j) cv[j] = *reinterpret_cast<const f32x4*>(E.cc + (size_t)pb * E.ccld + ECOL(j)); }
    }
    _Pragma("unroll") for (int g = 0; g < 8; ++g) {
      const int row = EROW(g);
      float rsv = 1.f;
      if (E.cons) {
        rsv = rsqrtf(ssv[g] * (1.f / D) + EPS);
        if (!ptile) { const int mrc = min(modrow(E.rb + row), 143);
          _Pragma("unroll") for (int j = 0; j < 4; ++j) cv[j] = *reinterpret_cast<const f32x4*>(E.cc + (size_t)mrc * E.ccld + ECOL(j)); }
      }
      _Pragma("unroll") for (int jb = 0; jb < 2; ++jb) {
        float o[8];
        _Pragma("unroll") for (int n = 0; n < 2; ++n) {
          f32x4 v = EACC(g, 2 * jb + n);
          if (E.cons) v = v * rsv + cv[2 * jb + n];
          if (E.kind == 1) { _Pragma("unroll") for (int q = 0; q < 4; ++q) { const float a = fmaxf(v[q], 0.f); v[q] = a * a; } }
          _Pragma("unroll") for (int q = 0; q < 4; ++q) o[4 * n + q] = v[q];
        }
        st8(E.c16 + (size_t)row * E.ldc + ECOL(2 * jb), pack8(o));
      }
    }
  } else if (E.kind == 2) {
    if (at) {
      _Pragma("unroll") for (int g = 0; g < 8; ++g) {
        const int row = EROW(g);
        if (row < E.nv) {
          const int r = E.rb + row;
          _Pragma("unroll") for (int j = 0; j < 4; ++j) {
            const f32x4 gg = *reinterpret_cast<const f32x4*>(E.mod + (size_t)modrow(r) * MODS + E.goff + ECOL(j));
            const f32x4 v = EACC(g, j);
            float* xp = E.xout + (size_t)r * D + ECOL(j);
            _Pragma("unroll") for (int q = 0; q < 4; ++q) unsafeAtomicAdd(xp + q, gg[q] * v[q]);
          }
        }
      }
    } else {
      f32x4 g4[4], w4[4], s4[4], xc[4], xq[4];
      const float* mrow0 = E.mod + (size_t)pb * MODS;
      if (ptile) { _Pragma("unroll") for (int j = 0; j < 4; ++j) { g4[j] = *reinterpret_cast<const f32x4*>(mrow0 + E.goff + ECOL(j));
          if (E.fuse) s4[j] = *reinterpret_cast<const f32x4*>(mrow0 + E.fsc + ECOL(j)); } }
      if (E.fuse) { _Pragma("unroll") for (int j = 0; j < 4; ++j) w4[j] = *reinterpret_cast<const f32x4*>(E.fw + ECOL(j)); }
#define LOADX(g, dst) do { const int _row = EROW(g); const int _r = E.rb + _row; \
        const float* _rs = (_r < MPROMPT) ? (E.res_p + (size_t)_r * D) : (E.res_s + (size_t)(_r - MPROMPT) * D); \
        _Pragma("unroll") for (int j = 0; j < 4; ++j) dst[j] = (_row < E.nv) ? *reinterpret_cast<const f32x4*>(_rs + ECOL(j)) : (f32x4){0.f, 0.f, 0.f, 0.f}; } while (0)
      LOADX(0, xc);
      _Pragma("unroll") for (int g = 0; g < 8; ++g) {
        const int row = EROW(g); const int r = E.rb + row; const bool ok = row < E.nv;
        if (g + 1 < 8) LOADX(g + 1, xq);
        if (!ptile && ok) { const float* mr = E.mod + (size_t)modrow(r) * MODS;
          _Pragma("unroll") for (int j = 0; j < 4; ++j) { g4[j] = *reinterpret_cast<const f32x4*>(mr + E.goff + ECOL(j)); if (E.fuse) s4[j] = *reinterpret_cast<const f32x4*>(mr + E.fsc + ECOL(j)); } }
        float ssq = 0.f;
        if (ok) {
          _Pragma("unroll") for (int j = 0; j < 4; ++j) {
            const f32x4 xn = xc[j] + g4[j] * EACC(g, j);
            *reinterpret_cast<f32x4*>(E.xout + (size_t)r * D + ECOL(j)) = xn;
            if (E.fuse) {
              const f32x4 a = xn * w4[j] * (s4[j] + 1.f);
              st4bf(E.fa + (size_t)row * D + ECOL(j), a[0], a[1], a[2], a[3]);
              ssq += xn[0] * xn[0] + xn[1] * xn[1] + xn[2] * xn[2] + xn[3] * xn[3];
            }
          }
        }
        if (E.fuse) {
          ssq += shx(ssq, 16, lane); ssq += shx(ssq, 32, lane);
          if (fq == 0 && ok) unsafeAtomicAdd(E.fss + row, ssq);
        }
        _Pragma("unroll") for (int j = 0; j < 4; ++j) xc[j] = xq[j];
      }
#undef LOADX
    }
  } else if (E.kind == 3) {
    _Pragma("unroll") for (int g = 0; g < 8; ++g) {
      const int row = EROW(g);
      if (row < 144) {
        _Pragma("unroll") for (int j = 0; j < 4; ++j) {
          const int col = ECOL(j);
          const f32x4 bb = *reinterpret_cast<const f32x4*>(E.ada_b + col);
          const f32x4 o = EACC(g, j) + bb;
          *reinterpret_cast<f32x4*>(E.modout + (size_t)row * MODS + col) = o;
          const int ch = col >> 10;
          const int sl = (ch == 6) ? 0 : (ch == 3) ? 1 : (ch == 9) ? 2 : -1;
          if (sl >= 0) st4bf(E.shb + ((size_t)sl * 256 + row) * D + (col & 1023), o[0], o[1], o[2], o[3]);
        }
      }
    }
  } else {
    _Pragma("unroll") for (int g = 0; g < 8; ++g) {
      const int row = EROW(g);
      if (row < 144) { _Pragma("unroll") for (int j = 0; j < 4; ++j) *reinterpret_cast<f32x4*>(E.cout + (size_t)row * E.ldc + ECOL(j)) = EACC(g, j); }
    }
  }
#undef ECOL
#undef EROW
#undef EACC
}

DI int perm32(int rho) { const int n = rho >> 4, i = rho & 15; return 8 * (i >> 2) + 4 * n + (i & 3); }
DI void tile_of(int tile, int ntm, int ntn, int& pm, int& pn) {
  const int nig = 8 * ntn, gid = tile / nig, fm = gid * 8, gsz = min(ntm - fm, 8);
  pm = fm + ((tile % nig) % gsz); pn = (tile % nig) / gsz;
}

DI void gemm_phase(char* shm_, const bf16* __restrict__ Ag, const bf16* __restrict__ Btg, int K, int ntm, int ntn, const Epi& E, int split, int toff, int shalf) {
  LAS unsigned char* lds = (LAS unsigned char*)shm_;
  const int tid = otid(), wid = __builtin_amdgcn_readfirstlane(tid >> 6), lane = tid & 63, wr = wid >> 2, wc = wid & 3, fr = lane & 15, fq = lane >> 4;
  const int ntk = K / BK;
  const int ntmf = split ? ntm - 1 : ntm, nfull = ntmf * ntn;
  const int G = gridDim.x, ntiles = nfull + (split ? ntn * (K / 256) : 0);
  const int bxr = (G % 8 == 0) ? (int)((blockIdx.x % 8) * (G / 8) + blockIdx.x / 8) : (int)blockIdx.x;
  unsigned voffA;
  { int R, C; stage_rc(tid * 16, R, C); voffA = (unsigned)(R * K + C) * 2u; }
  const size_t istep = (size_t)64 * K * 2;
  const size_t kstep = (size_t)(BK * 2), hstep = (size_t)HALFT * K * 2, tstep = 2 * hstep;
  const unsigned ldsw = (unsigned)wid * 1024u;
  const int aoff = lds_byte(wr * 64 + fr, fq * 8), boff = lds_byte(wc * 32 + fr, fq * 8);
#define PSA(b, h) (((b) * 2 + (h)) * HTB)
#define PSB(b, h) ((4 + (b) * 2 + (h)) * HTB)
#define PSTAGE(bufoff, gbase) PSTAGEX(bufoff, gbase, voffA)
#define PSTAGEB(bufoff, gbase) PSTAGEX(bufoff, gbase, voffA)
#define PSTAGEX(bufoff, gbase, VO) do { _Pragma("unroll") for (int _i = 0; _i < 2; ++_i) \
    __builtin_amdgcn_global_load_lds((const unsigned*)((const char*)(gbase) + (size_t)_i * istep + VO), (LAS unsigned*)(lds + (bufoff) + ldsw + _i * 8192), 16, 0, 0); } while (0)
#define PLDA(dst, b, h) do { _Pragma("unroll") for (int m = 0; m < 4; ++m) _Pragma("unroll") for (int k = 0; k < 2; ++k) dst[m][k] = *(const LAS bf16x8*)(lds + PSA(b, h) + aoff + m * 2048 + k * 1024); } while (0)
#define PLDB(dst, b, h) do { _Pragma("unroll") for (int n = 0; n < 2; ++n) _Pragma("unroll") for (int k = 0; k < 2; ++k) dst[n][k] = *(const LAS bf16x8*)(lds + PSB(b, h) + boff + n * 2048 + k * 1024); } while (0)
#define PMMA(ai, bj, At, Bq) do { __builtin_amdgcn_s_setprio(1); _Pragma("unroll") for (int m = 0; m < 4; ++m) _Pragma("unroll") for (int n = 0; n < 2; ++n) _Pragma("unroll") for (int k = 0; k < 2; ++k) \
    acc[ai][bj][m][n] = __builtin_amdgcn_mfma_f32_16x16x32_bf16(Bq[n][k], At[m][k], acc[ai][bj][m][n], 0, 0, 0); __builtin_amdgcn_s_setprio(0); } while (0)
#define WAIT_V(n) asm volatile("s_waitcnt vmcnt(" #n ")" ::: "memory")
#define WAIT_L(n) asm volatile("s_waitcnt lgkmcnt(" #n ")" ::: "memory")
#define BAR __builtin_amdgcn_s_barrier()
#define SCHED __builtin_amdgcn_sched_barrier(0)
  int tile = bxr - toff;
  if (tile < 0 || tile >= ntiles) return;
#define UNIT_OF(u, PM, PN, K0, NTU, AT, HL) do { if ((u) < nfull) { tile_of((u), ntmf, ntn, PM, PN); K0 = 0; NTU = ntk; AT = 0; } \
    else { const int _s = (u) - nfull; PN = _s % ntn; PM = ntmf; K0 = (_s / ntn) * 256; NTU = 4; AT = 1; } \
    HL = (shalf && PM == ntm - 1) ? 1 : 0; } while (0)
  int pm, pn, k0, nt, at, hl; UNIT_OF(tile, pm, pn, k0, nt, at, hl);
  f32x4 acc[2][2][4][2];
  _Pragma("unroll") for (int a = 0; a < 2; ++a) _Pragma("unroll") for (int b = 0; b < 2; ++b) _Pragma("unroll") for (int m = 0; m < 4; ++m) _Pragma("unroll") for (int n = 0; n < 2; ++n) acc[a][b][m][n] = (f32x4){0.f, 0.f, 0.f, 0.f};
  bf16x8 At[4][2], B0[2][2], B1[2][2];
  const char* cA = (const char*)Ag + (size_t)pm * tstep + (size_t)k0 * 2; const char* cB = (const char*)Btg + (size_t)pn * tstep + (size_t)k0 * 2;
  PSTAGEB(PSB(0, 0), cB); PSTAGE(PSA(0, 0), cA); PSTAGEB(PSB(0, 1), cB + hstep); PSTAGE(PSA(0, 1), cA + hstep);
  if (wr == 1) BAR;
  WAIT_V(4); BAR;
  PSTAGEB(PSB(1, 0), cB + kstep); PSTAGE(PSA(1, 0), cA + kstep); PSTAGEB(PSB(1, 1), cB + hstep + kstep);
  WAIT_V(6); BAR;
  for (;;) {
    const int ntile = tile + G;
    const bool has_next = ntile < ntiles;
    int npm = pm, npn = pn, nk0 = k0, nnt = nt, nat = at, nhl = hl; if (has_next) UNIT_OF(ntile, npm, npn, nk0, nnt, nat, nhl);
    const char* nA = has_next ? (const char*)Ag + (size_t)npm * tstep + (size_t)nk0 * 2 : cA; const char* nB = has_next ? (const char*)Btg + (size_t)npn * tstep + (size_t)nk0 * 2 : cB;
#define KLOOP(SK)     for (int t = 0; t < nt; t += 2) { \
      const bool last = (t == nt - 2); \
      const char* a1 = cA + (size_t)(t + 1) * kstep; \
      const char* a2 = last ? nA : cA + (size_t)(t + 2) * kstep; const char* b2 = last ? nB : cB + (size_t)(t + 2) * kstep; \
      const char* a3 = a2 + kstep; const char* b3 = b2 + kstep; \
      PLDB(B0, 0, 0); SCHED; PLDA(At, 0, 0); PSTAGE(PSA(1, 1), a1 + hstep); \
      WAIT_L(8); BAR; WAIT_L(0); PMMA(0, 0, At, B0); BAR; SCHED; \
      PLDB(B1, 0, 1); PSTAGEB(PSB(0, 0), b2); \
      BAR; WAIT_L(0); PMMA(0, 1, At, B1); BAR; \
      PLDA(At, 0, 1); PSTAGE(PSA(0, 0), a2); \
      BAR; WAIT_L(0); if (!(SK)) PMMA(1, 0, At, B0); BAR; SCHED; \
      PSTAGEB(PSB(0, 1), b2 + hstep); \
      WAIT_V(6); BAR; if (!(SK)) PMMA(1, 1, At, B1); BAR; \
      PLDB(B0, 1, 0); SCHED; PLDA(At, 1, 0); PSTAGE(PSA(0, 1), a2 + hstep); \
      WAIT_L(8); BAR; WAIT_L(0); PMMA(0, 0, At, B0); BAR; SCHED; \
      PLDB(B1, 1, 1); PSTAGEB(PSB(1, 0), b3); \
      BAR; WAIT_L(0); PMMA(0, 1, At, B1); BAR; \
      PLDA(At, 1, 1); PSTAGE(PSA(1, 0), a3); \
      BAR; WAIT_L(0); if (!(SK)) PMMA(1, 0, At, B0); BAR; SCHED; \
      PSTAGEB(PSB(1, 1), b3 + hstep); \
      WAIT_V(6); BAR; if (!(SK)) PMMA(1, 1, At, B1); BAR; \
    }
    if (hl) { KLOOP(1) } else { KLOOP(0) }
#undef KLOOP
    epilogue(acc, E, pm * BM, pn * BM, wr, wc, fr, fq, at);
    if (!has_next) break;
    _Pragma("unroll") for (int a = 0; a < 2; ++a) _Pragma("unroll") for (int b = 0; b < 2; ++b) _Pragma("unroll") for (int m = 0; m < 4; ++m) _Pragma("unroll") for (int n = 0; n < 2; ++n) acc[a][b][m][n] = (f32x4){0.f, 0.f, 0.f, 0.f};
    tile = ntile; pm = npm; pn = npn; k0 = nk0; nt = nnt; at = nat; hl = nhl; cA = nA; cB = nB;
  }
  WAIT_V(0);
  if (wr == 0) BAR;
  BAR;
}

struct TJob { const float* src; u16* dst; int K, N, tk, tn; };
DI TJob tjob_of(const Params& P, unsigned char* ws, int job) {
  TJob J; const int l = job / 6464; int j = job % 6464;
  if (j < 2624) { J.src = P.w_in + (size_t)l * D * DIN; J.dst = (u16*)(ws + WS_WIN) + (size_t)l * ZS * D; J.K = D; J.N = DIN; J.tk = j / 164; J.tn = j % 164; }
  else if ((j -= 2624) < 256) { J.src = P.w_out + (size_t)l * D * D; J.dst = (u16*)(ws + WS_WOUT) + (size_t)l * D * D; J.K = D; J.N = D; J.tk = j / 16; J.tn = j % 16; }
  else if ((j -= 256) < 1024) { J.src = P.w_up + (size_t)l * D * DFF; J.dst = (u16*)(ws + WS_WUP) + (size_t)l * DFF * D; J.K = D; J.N = DFF; J.tk = j / 64; J.tn = j % 64; }
  else if ((j -= 1024) < 1024) { J.src = P.w_down + (size_t)l * DFF * D; J.dst = (u16*)(ws + WS_WDN) + (size_t)l * D * DFF; J.K = DFF; J.N = D; J.tk = j / 16; J.tn = j % 16; }
  else { j -= 1024; J.src = P.ada_w + (size_t)l * D * 6144; J.dst = (u16*)(ws + WS_AWT) + (size_t)l * 6144 * D; J.K = D; J.N = 6144; J.tk = j / 96; J.tn = j % 96; }
  return J;
}
DI void tjob_load(const TJob& J, int tid, f32x4 (&v)[2]) {
  const int nn = (tid & 15) * 4, n = J.tn * 64 + nn;
  _Pragma("unroll") for (int i = 0; i < 2; ++i) { const int kk = (tid >> 4) + 32 * i;
    v[i] = (n < J.N) ? *reinterpret_cast<const f32x4*>(J.src + (size_t)(J.tk * 64 + kk) * J.N + n) : (f32x4){0.f, 0.f, 0.f, 0.f}; }
}

DI void prep_phase(char* shm, const Params& P) {
  float* tl = (float*)shm;
  unsigned char* ws = optr(P.ws);
  int bx_ = blockIdx.x; asm volatile("" : "+s"(bx_));
  int G_ = gridDim.x; asm volatile("" : "+s"(G_));
  const int G = G_, bx = bx_, tid = otid();
  const int njobs = 2 * 6464;
  if (bx < njobs) {
    f32x4 v[2];
    { const TJob J0 = tjob_of(P, ws, bx); tjob_load(J0, tid, v); }
    _Pragma("unroll 1") for (int job = bx; job < njobs; job += G) {
      __syncthreads();
      { const int nn = (tid & 15) * 4; _Pragma("unroll") for (int i = 0; i < 2; ++i) { const int kk = (tid >> 4) + 32 * i;
          _Pragma("unroll") for (int q = 0; q < 4; ++q) tl[kk * 65 + nn + q] = v[i][q]; } }
      if (job + G < njobs) { const TJob Jn = tjob_of(P, ws, job + G); tjob_load(Jn, tid, v); }
      __syncthreads();
      { const TJob Jc = tjob_of(P, ws, job);
        const int nn = tid >> 3, kp = tid & 7; float o[8]; _Pragma("unroll") for (int j = 0; j < 8; ++j) o[j] = tl[(kp * 8 + j) * 65 + nn];
        const int ncol = Jc.tn * 64 + nn, c5 = ncol & 31, slot = (ncol & ~31) + 16 * ((c5 >> 2) & 1) + 4 * (c5 >> 3) + (c5 & 3);
        st8(Jc.dst + (size_t)slot * Jc.K + Jc.tk * 64 + kp * 8, pack8(o)); }
    }
  }
  { unsigned* shb = (unsigned*)(ws + WS_SHB); _Pragma("unroll 1") for (int e = bx * NT + tid; e < 3 * 256 * 1024 / 2; e += G * NT) shb[e] = 0u; }
  u16* sc = (u16*)(ws + WS_SC);
  _Pragma("unroll 1") for (int e = bx * NT + tid; e < 256 * 1024; e += G * NT) {
    int row = e >> 10, c = e & 1023; float v = 0.f;
    if (row < 16) v = siluf(P.c_prompt[row * D + c]); else if (row < 144) v = siluf(P.c_sample[(row - 16) * D + c]);
    sc[e] = f2bf(v);
  }
  if (bx == 0) {
    float* bt = (float*)(ws + WS_BT);
    for (int e = tid; e < 128 * 16; e += NT) {
      int n = e >> 4, hd = e & 15; int bk;
      if (n < 16) bk = n; else { float nf = (float)n; int lg = 16 + (int)(logf(nf / 16.f) / 2.0794415416798357f * 16.f); bk = lg < 31 ? lg : 31; }
      bt[e] = P.rel[bk * 16 + hd];
    }
  }
}

DI void norm_phase(const Params& P, int l, int hf, int which  , bool from_input) {
  const int RB = hf * HALF_ROWS, NV = hf ? 16512 : 16384, NR = hf ? 16640 : 16384;
  const int tid = otid(); const int w = tid >> 6, lane = tid & 63;
  u16* H = (u16*)(optr(P.ws) + WS_H);
  const float* mod = (const float*)(optr(P.ws) + WS_MOD);
  const float* nw = (which ? P.n2 : P.n1) + l * D;
  const int stride = gridDim.x * 8;
  f32x4 nx[4];
#define NORM_SRC(lrow) (from_input ? ((RB + (lrow)) < MPROMPT ? P.x_prompt + (size_t)(RB + (lrow)) * D : P.x_sample + (size_t)(RB + (lrow) - MPROMPT) * D) : P.out + (size_t)(RB + (lrow)) * D)
  f32x4 nsh[4], nsc[4], nw4[4];
  _Pragma("unroll") for (int k = 0; k < 4; ++k) nw4[k] = *reinterpret_cast<const f32x4*>(nw + lane * 4 + 256 * k);
#define NORM_LOAD(lrow) do { const float* _xr = NORM_SRC(lrow); const float* _mr = mod + (size_t)modrow(RB + (lrow)) * MODS + l * 6144 + which * 3072; \
    _Pragma("unroll") for (int k = 0; k < 4; ++k) { nx[k] = *reinterpret_cast<const f32x4*>(_xr + lane * 4 + 256 * k); nsh[k] = *reinterpret_cast<const f32x4*>(_mr + lane * 4 + 256 * k); nsc[k] = *reinterpret_cast<const f32x4*>(_mr + 1024 + lane * 4 + 256 * k); } } while (0)
  int lr = blockIdx.x * 8 + w;
  if (lr < NV) NORM_LOAD(lr);
  _Pragma("unroll 1") for (; lr < NR; lr += stride) {
    u16* hrow = H + (size_t)lr * D;
    if (lr >= NV) { _Pragma("unroll") for (int k = 0; k < 4; ++k) st4bf(hrow + lane * 4 + 256 * k, 0.f, 0.f, 0.f, 0.f); continue; }
    const int r = RB + lr;
    f32x4 x[4], csh[4], csc[4]; float ss = 0.f;
    _Pragma("unroll") for (int k = 0; k < 4; ++k) { x[k] = nx[k]; csh[k] = nsh[k]; csc[k] = nsc[k]; ss += x[k][0] * x[k][0] + x[k][1] * x[k][1] + x[k][2] * x[k][2] + x[k][3] * x[k][3]; }
    if (lr + stride < NV) NORM_LOAD(lr + stride);
    for (int o = 32; o >= 1; o >>= 1) ss += shx(ss, o, lane);
    const float rs = rsqrtf(ss * (1.f / D) + EPS);
    if (from_input && r >= MPROMPT) { _Pragma("unroll") for (int k = 0; k < 4; ++k) *reinterpret_cast<f32x4*>(P.out + (size_t)r * D + lane * 4 + 256 * k) = x[k]; }
    _Pragma("unroll") for (int k = 0; k < 4; ++k) {
      const int c = lane * 4 + 256 * k;
      f32x4 y = x[k] * rs * nw4[k] * (csc[k] + 1.f) + csh[k];
      st4bf(hrow + c, y[0], y[1], y[2], y[3]);
    }
  }
}

DI void final_norm_phase(const Params& P) {
  const int tid = otid(); const int w = tid >> 6, lane = tid & 63;
  const int stride = gridDim.x * 8;
  f32x4 nx[4], fw4[4];
  _Pragma("unroll") for (int k = 0; k < 4; ++k) fw4[k] = *reinterpret_cast<const f32x4*>(P.fnw + lane * 4 + 256 * k);
  int r = blockIdx.x * 8 + w;
  if (r < MVALID) { _Pragma("unroll") for (int k = 0; k < 4; ++k) nx[k] = *reinterpret_cast<const f32x4*>(P.out + (size_t)r * D + lane * 4 + 256 * k); }
  _Pragma("unroll 1") for (; r < MVALID; r += stride) {
    float* xr = P.out + (size_t)r * D;
    f32x4 x[4]; float ss = 0.f;
    _Pragma("unroll") for (int k = 0; k < 4; ++k) { x[k] = nx[k]; ss += x[k][0] * x[k][0] + x[k][1] * x[k][1] + x[k][2] * x[k][2] + x[k][3] * x[k][3]; }
    if (r + stride < MVALID) { _Pragma("unroll") for (int k = 0; k < 4; ++k) nx[k] = *reinterpret_cast<const f32x4*>(P.out + (size_t)(r + stride) * D + lane * 4 + 256 * k); }
    for (int o = 32; o >= 1; o >>= 1) ss += shx(ss, o, lane);
    const float rs = rsqrtf(ss * (1.f / D) + EPS);
    _Pragma("unroll") for (int k = 0; k < 4; ++k) { const int c = lane * 4 + 256 * k; *reinterpret_cast<f32x4*>(xr + c) = x[k] * rs * fw4[k]; }
  }
}

DI void conv_phase(const Params& P, int l, int hf) {
  const int tid = otid();
  const u16* Z = (const u16*)(optr(P.ws) + WS_Z);
  u16* XBC = (u16*)(optr(P.ws) + WS_XBC);
  float* DT = (float*)(optr(P.ws) + WS_DT);
  const float* cw = P.conv_w + (size_t)l * 4 * 1536;
  const float* cb = P.conv_b + (size_t)l * 1536;
  const int nstrips = 16384 / 32;
  for (int sp = blockIdx.x * 2; sp < nstrips; sp += gridDim.x * 2) {
    if (tid < 384) {
      const int part = tid % 192, strip = sp + tid / 192, ch0 = part * 8;
      const int lr0 = strip * 32;
      float w[4][8], bias[8];
      _Pragma("unroll") for (int i = 0; i < 4; ++i) { const f32x4 a = *reinterpret_cast<const f32x4*>(cw + i * 1536 + ch0), b = *reinterpret_cast<const f32x4*>(cw + i * 1536 + ch0 + 4);
        _Pragma("unroll") for (int j = 0; j < 4; ++j) { w[i][j] = a[j]; w[i][4 + j] = b[j]; } }
      { const f32x4 a = *reinterpret_cast<const f32x4*>(cb + ch0), b = *reinterpret_cast<const f32x4*>(cb + ch0 + 4);
        _Pragma("unroll") for (int j = 0; j < 4; ++j) { bias[j] = a[j]; bias[4 + j] = b[j]; } }
      bf16x8 h0, h1, h2;
      const u16* zp = Z + (size_t)lr0 * ZS + C_CX + ch0;
      if ((lr0 & 2047) == 0) { _Pragma("unroll") for (int j = 0; j < 8; ++j) { h0[j] = 0; h1[j] = 0; h2[j] = 0; } }
      else { h0 = ld8(zp - 3 * (size_t)ZS); h1 = ld8(zp - 2 * (size_t)ZS); h2 = ld8(zp - (size_t)ZS); }
      u16* xo = XBC + (size_t)lr0 * 1536 + ch0;
      _Pragma("unroll 1") for (int rb = 0; rb < 32; rb += 8) {
        bf16x8 cur[8];
        _Pragma("unroll") for (int k = 0; k < 8; ++k) cur[k] = ld8(zp + (size_t)(rb + k) * ZS);
        _Pragma("unroll") for (int k = 0; k < 8; ++k) {
          float a[8];
          _Pragma("unroll") for (int j = 0; j < 8; ++j) a[j] = siluf(bias[j] + w[0][j] * bfs(h0[j]) + w[1][j] * bfs(h1[j]) + w[2][j] * bfs(h2[j]) + w[3][j] * bfs(cur[k][j]));
          st8(xo + (size_t)(rb + k) * 1536, pack8(a));
          h0 = h1; h1 = h2; h2 = cur[k];
        }
      }
    } else {
      const int t = tid - 384;
      u16 zv[8];
      _Pragma("unroll") for (int k = 0; k < 8; ++k) { const int u = t + 128 * k; zv[k] = Z[(size_t)(sp * 32 + (u >> 4)) * ZS + C_DT + (u & 15)]; }
      const float dtb = P.dt_bias[l * 16 + (t & 15)];
      _Pragma("unroll") for (int k = 0; k < 8; ++k) { const int u = t + 128 * k; DT[(size_t)(sp * 32 + (u >> 4)) * 16 + (u & 15)] = softplusf(bf2f(zv[k]) + dtb); }
    }
  }
}

DI void mix_phase(const Params& P, int l, int hf) {
  const int NV = hf ? 16512 : 16384, NR = hf ? 16640 : 16384;
  const int tid = otid(); const int w = tid >> 6, lane = tid & 63;
  u16* H = (u16*)(optr(P.ws) + WS_H);
  const u16* Z = (const u16*)(optr(P.ws) + WS_Z);
  const u16* YC = (const u16*)(optr(P.ws) + WS_YC);
  const float* snw = P.snw + l * D;
  bf16x8 nob[2], ny[2], ncz[2], noa[2], nbg[2], nga[2], ngb[2], ngc[2];
#define MIX_LOAD(row) do { const u16* zr = Z + (size_t)(row) * ZS + lane * 8; const u16* yr = YC + (size_t)(row) * D + lane * 8; \
    _Pragma("unroll") for (int k = 0; k < 2; ++k) { \
      nob[k] = ld8(zr + C_BV + 512 * k); ny[k] = ld8(yr + 512 * k); ncz[k] = ld8(zr + C_CZ + 512 * k); noa[k] = ld8(zr + C_AQ + 512 * k); \
      nbg[k] = ld8(zr + C_BG + 512 * k); nga[k] = ld8(zr + C_GA + 512 * k); ngb[k] = ld8(zr + C_GB + 512 * k); ngc[k] = ld8(zr + C_GC + 512 * k); } } while (0)
  const int stride = gridDim.x * 8;
  f32x4 snv[2][2];
  _Pragma("unroll") for (int k = 0; k < 2; ++k) { snv[k][0] = *reinterpret_cast<const f32x4*>(snw + lane * 8 + 512 * k); snv[k][1] = *reinterpret_cast<const f32x4*>(snw + lane * 8 + 512 * k + 4); }
  int lr = blockIdx.x * 8 + w;
  if (lr < NV) MIX_LOAD(lr);
  float* SS1 = (float*)(optr(P.ws) + WS_SS1); float* SS2 = (float*)(optr(P.ws) + WS_SS2);
  _Pragma("unroll 1") for (; lr < NR; lr += stride) {
    u16* hrow = H + (size_t)lr * D + lane * 8;
    if (lane == 0) { SS1[lr] = 0.f; SS2[lr] = 0.f; }
    if (lr >= NV) { _Pragma("unroll") for (int k = 0; k < 2; ++k) { st4bf(hrow + 512 * k, 0.f, 0.f, 0.f, 0.f); st4bf(hrow + 512 * k + 4, 0.f, 0.f, 0.f, 0.f); } continue; }
    bf16x8 vob[2], vy[2], vcz[2], voa[2], vbg[2], vga[2], vgb[2], vgc[2];
    _Pragma("unroll") for (int k = 0; k < 2; ++k) { vob[k] = nob[k]; vy[k] = ny[k]; vcz[k] = ncz[k]; voa[k] = noa[k]; vbg[k] = nbg[k]; vga[k] = nga[k]; vgb[k] = ngb[k]; vgc[k] = ngc[k]; }
    if (lr + stride < NV) MIX_LOAD(lr + stride);
    _Pragma("unroll") for (int k = 0; k < 2; ++k) {
      float ob[8], yg[8], so = 0.f, sy = 0.f;
      _Pragma("unroll") for (int j = 0; j < 8; ++j) { float o = bfs(vob[k][j]); ob[j] = o; so += o * o; float t = bfs(vy[k][j]) * siluf(bfs(vcz[k][j])); yg[j] = t; sy += t * t; }
      so += shx(so, 1, lane); so += shx(so, 2, lane); so += shx(so, 4, lane); so += shx(so, 8, lane);
      for (int o = 32; o >= 1; o >>= 1) sy += shx(sy, o, lane);
      const float ro = rsqrtf(so * (1.f / 128.f) + EPS), ry = rsqrtf(sy * (1.f / 512.f) + EPS);
      float m[8];
      const f32x4 s0 = snv[k][0], s1 = snv[k][1];
      _Pragma("unroll") for (int j = 0; j < 8; ++j) {
        const float bgv = bfs(vbg[k][j]);
        const float pb = bgv * __builtin_amdgcn_rcpf((1.f + __expf(-bfs(vgb[k][j]))) * (1.f + __expf(-bgv)));
        const float ocn = yg[j] * ry * (j < 4 ? s0[j & 3] : s1[j & 3]);
        m[j] = sigmf(bfs(vga[k][j])) * bfs(voa[k][j]) + pb * (ob[j] * ro) + sigmf(bfs(vgc[k][j])) * ocn;
      }
      st8(hrow + 512 * k, pack8(m));
    }
  }
}

DI void att_prompt_item(char* shm, const Params& P, int l, int hf, int b, int blk, int kvh) {
  u16* Ks = (u16*)shm;
  u16* Vt = Ks + 256 * 72;
  float* bias = (float*)(Vt + 64 * 268);
  u16* Z = (u16*)(optr(P.ws) + WS_Z);
  const float* bt = (const float*)(optr(P.ws) + WS_BT);
  const int tid = otid(), lane = tid & 63, w = tid >> 6;
  const int lr0 = b * 2048 + blk * 128 - hf * HALF_ROWS;
  const int g = w >> 1, qh = kvh * 4 + g, r = lane & 31, h = lane >> 5;
  bf16x8 qall[2][4];
  _Pragma("unroll") for (int qq = 0; qq < 2; ++qq) { const u16* qp = Z + (size_t)(lr0 + ((w & 1) * 2 + qq) * 32 + r) * ZS + C_AQ + qh * 64;
    _Pragma("unroll") for (int s = 0; s < 4; ++s) qall[qq][s] = ld8(qp + 16 * s + 8 * h); }
  const float sink = P.sinks[l * 16 + qh];
  const float btv = bt[(tid & 127) * 16 + kvh * 4 + (tid >> 7)];
  __syncthreads();
  {
    bf16x8 kr[4], vr[4];
    _Pragma("unroll") for (int it = 0; it < 4; ++it) { const int c = tid + it * NT, key = c >> 3, part = c & 7;
      if (blk > 0 || key >= 128) { const u16* src = Z + (size_t)(lr0 - 128 + key) * ZS; kr[it] = ld8(src + C_AK + kvh * 64 + part * 8); vr[it] = ld8(src + C_AV + kvh * 64 + part * 8); }
      else { _Pragma("unroll") for (int j = 0; j < 8; ++j) { kr[it][j] = 0; vr[it][j] = 0; } } }
    _Pragma("unroll") for (int it = 0; it < 4; ++it) { const int c = tid + it * NT, key = c >> 3, part = c & 7;
      st8(Ks + key * 72 + part * 8, kr[it]);
      _Pragma("unroll") for (int jj = 0; jj < 8; ++jj) Vt[(part * 8 + jj) * 268 + key] = (u16)vr[it][jj]; }
  }
  { const int g3 = tid >> 7, dist = tid & 127; bias[g3 * 192 + 32 + dist] = btv * 1.4426950408889634f;
    if (tid < 256) { const int g2 = tid >> 6, k = tid & 63; bias[g2 * 192 + (k < 32 ? k : 128 + k)] = 0.f; } }
  __syncthreads();
  _Pragma("unroll") for (int qq = 0; qq < 2; ++qq) {
    const int qt = (w & 1) * 2 + qq, qi = qt * 32 + r;
    u16* qrow = Z + (size_t)(lr0 + qi) * ZS + C_AQ + qh * 64;
    bf16x8 qf[4];
    _Pragma("unroll") for (int s = 0; s < 4; ++s) qf[s] = qall[qq][s];
    f32x16 O0 = zero16(), O1 = zero16();
    float m = sink * 1.4426950408889634f, lsum = 1.f;
    const int kt0 = (blk == 0) ? 4 : qt;
    _Pragma("unroll 1") for (int kt = kt0; kt <= qt + 4; ++kt) {
      f32x16 S = zero16();
      _Pragma("unroll") for (int s = 0; s < 4; ++s) { const bf16x8 kf = ld8(Ks + (kt * 32 + r) * 72 + 16 * s + 8 * h); S = MFMA32(kf, qf[s], S); }
      const float* bp = bias + g * 192 + 32 + (qi - 32 * kt + 128 - 4 * h);
      float mloc = -INFINITY;
      _Pragma("unroll") for (int i = 0; i < 16; ++i) S[i] = fmaf(S[i], 0.125f * 1.4426950408889634f, bp[-((i & 3) + 8 * (i >> 2))]);
      if (kt == qt) { _Pragma("unroll") for (int i = 0; i < 16; ++i) S[i] = (crow(i, h) > r) ? S[i] : -INFINITY; }
      if (kt == qt + 4) { _Pragma("unroll") for (int i = 0; i < 16; ++i) S[i] = (crow(i, h) <= r) ? S[i] : -INFINITY; }
      _Pragma("unroll") for (int i = 0; i < 16; ++i) mloc = fmaxf(mloc, S[i]);
      mloc = fmaxf(mloc, shx(mloc, 32, lane));
      const float mnew = fmaxf(m, mloc), alpha = __builtin_amdgcn_exp2f(m - mnew);
      float ps = 0.f;
      _Pragma("unroll") for (int i = 0; i < 16; ++i) { const float p = __builtin_amdgcn_exp2f(S[i] - mnew); S[i] = p; ps += p; }
      ps += shx(ps, 32, lane);
      lsum = lsum * alpha + ps; m = mnew;
      _Pragma("unroll") for (int i = 0; i < 16; ++i) { O0[i] *= alpha; O1[i] *= alpha; }
      const bf16x8 p0 = packP<0>(S), p1 = packP<1>(S);
      { const u16* vp = Vt + (r) * 268 + kt * 32 + 4 * h;
        O0 = MFMA32(cat4(*(const s16x4*)vp, *(const s16x4*)(vp + 8)), p0, O0);
        O0 = MFMA32(cat4(*(const s16x4*)(vp + 16), *(const s16x4*)(vp + 24)), p1, O0); }
      { const u16* vp = Vt + (32 + r) * 268 + kt * 32 + 4 * h;
        O1 = MFMA32(cat4(*(const s16x4*)vp, *(const s16x4*)(vp + 8)), p0, O1);
        O1 = MFMA32(cat4(*(const s16x4*)(vp + 16), *(const s16x4*)(vp + 24)), p1, O1); }
    }
    const float inv = __builtin_amdgcn_rcpf(lsum);
    _Pragma("unroll") for (int gq = 0; gq < 4; ++gq) {
      st4bf(qrow + 8 * gq + 4 * h, O0[4 * gq] * inv, O0[4 * gq + 1] * inv, O0[4 * gq + 2] * inv, O0[4 * gq + 3] * inv);
      st4bf(qrow + 32 + 8 * gq + 4 * h, O1[4 * gq] * inv, O1[4 * gq + 1] * inv, O1[4 * gq + 2] * inv, O1[4 * gq + 3] * inv);
    }
  }
  if (blk == 15) {
    float* wk = P.out + O_WKP + (size_t)(l * 16 + b) * 128 * 256 + kvh * 64;
    float* wv = P.out + O_WVP + (size_t)(l * 16 + b) * 128 * 256 + kvh * 64;
    for (int idx = tid; idx < 128 * 64; idx += NT) { const int j = idx >> 6, d = idx & 63; wk[j * 256 + d] = bf2f(Ks[(128 + j) * 72 + d]); wv[j * 256 + d] = bf2f(Vt[d * 268 + 128 + j]); }
  }
}

DI void ret_prompt_item(char* shm, const Params& P, int l, int hf, int b, int hd) {
  u16* QQ = (u16*)shm;
  u16* KK = QQ + 128 * 72;
  u16* KKt = KK + 128 * 72;
  u16* Vt = KKt + 64 * 136;
  u16* St = Vt + 128 * 136;
  float* th = (float*)(St + 128 * 72);
  u16* Z = (u16*)(optr(P.ws) + WS_Z);
  const int tid = otid(), lane = tid & 63, w = tid >> 6, r = lane & 31, hh = lane >> 5;
  const float log2g = log2f(1.f - exp2f(-5.f - (float)hd));
  const float g128 = exp2f(log2g * 128.f);
  __syncthreads();
  for (int e = tid; e < 128 * 72; e += NT) St[e] = 0;
  if (tid < 32) th[tid] = 1.f / powf(10000.f, (float)tid / 31.f);
  f32x16 Sacc = zero16();
  const int lt = w & 3, eh = w >> 2;
  bf16x8 qv[2], kv[2], vv[4];
#define RET_ISSUE(cc) do { const int _lr = b * 2048 + (cc) * 128 - hf * HALF_ROWS; \
    _Pragma("unroll") for (int it = 0; it < 2; ++it) { const int idx = tid + it * NT, row = idx & 127, part = idx >> 7; \
      const u16* zr = Z + (size_t)(_lr + row) * ZS; qv[it] = ld8(zr + C_BQ + hd * 64 + part * 8); kv[it] = ld8(zr + C_BK + hd * 64 + part * 8); } \
    _Pragma("unroll") for (int it = 0; it < 4; ++it) { const int idx = tid + it * NT, row = idx & 127, part = idx >> 7; \
      vv[it] = ld8(Z + (size_t)(_lr + row) * ZS + C_BV + hd * 128 + part * 8); } } while (0)
  RET_ISSUE(0);
  _Pragma("unroll 1") for (int c = 0; c < 16; ++c) {
    const int tok0 = c * 128;
    const int lrow0 = b * 2048 + tok0 - hf * HALF_ROWS;
    __syncthreads();
    {
      _Pragma("unroll") for (int it = 0; it < 2; ++it) {
        const int idx = tid + it * NT, row = idx & 127, part = idx >> 7;
        const float pos = (float)(tok0 + row);
        const float gq = exp2f(log2g * (float)(row + 1)), gk = 0.125f * exp2f(-log2g * (float)(row + 1));
        float qo[8], ko[8];
        _Pragma("unroll") for (int pr = 0; pr < 4; ++pr) {
          float sn, cs; sincos_rev(pos * th[part * 4 + pr], sn, cs);
          const float q1 = bfs(qv[it][2 * pr]), q2 = bfs(qv[it][2 * pr + 1]), k1 = bfs(kv[it][2 * pr]), k2 = bfs(kv[it][2 * pr + 1]);
          qo[2 * pr] = (q1 * cs - q2 * sn) * gq; qo[2 * pr + 1] = (q1 * sn + q2 * cs) * gq;
          ko[2 * pr] = (k1 * cs - k2 * sn) * gk; ko[2 * pr + 1] = (k1 * sn + k2 * cs) * gk;
        }
        st8(QQ + row * 72 + part * 8, pack8(qo));
        st8(KK + row * 72 + part * 8, pack8(ko));
        _Pragma("unroll") for (int jj = 0; jj < 8; ++jj) KKt[(part * 8 + jj) * 136 + row] = f2bf(ko[jj]);
      }
      _Pragma("unroll") for (int it = 0; it < 4; ++it) { const int idx = tid + it * NT, row = idx & 127, part = idx >> 7;
        _Pragma("unroll") for (int jj = 0; jj < 8; ++jj) Vt[(part * 8 + jj) * 136 + row] = (u16)vv[it][jj]; }
    }
    if (c + 1 < 16) RET_ISSUE(c + 1);
    __syncthreads();
    bf16x8 qf[4];
    _Pragma("unroll") for (int s = 0; s < 4; ++s) qf[s] = ld8(QQ + (lt * 32 + r) * 72 + 16 * s + 8 * hh);
    f32x16 O0 = zero16(), O1 = zero16();
    _Pragma("unroll") for (int s = 0; s < 4; ++s) {
      O0 = MFMA32(ld8(St + ((2 * eh) * 32 + r) * 72 + 16 * s + 8 * hh), qf[s], O0);
      O1 = MFMA32(ld8(St + ((2 * eh + 1) * 32 + r) * 72 + 16 * s + 8 * hh), qf[s], O1);
    }
    _Pragma("unroll 1") for (int mk = 0; mk <= lt; ++mk) {
      f32x16 Aa = zero16();
      _Pragma("unroll") for (int s = 0; s < 4; ++s) Aa = MFMA32(ld8(KK + (mk * 32 + r) * 72 + 16 * s + 8 * hh), qf[s], Aa);
      if (mk == lt) _Pragma("unroll") for (int i = 0; i < 16; ++i) if (crow(i, hh) > r) Aa[i] = 0.f;
      const bf16x8 p0 = packP<0>(Aa), p1 = packP<1>(Aa);
      { const u16* vp = Vt + ((2 * eh) * 32 + r) * 136 + mk * 32 + 4 * hh;
        O0 = MFMA32(cat4(*(const s16x4*)vp, *(const s16x4*)(vp + 8)), p0, O0);
        O0 = MFMA32(cat4(*(const s16x4*)(vp + 16), *(const s16x4*)(vp + 24)), p1, O0); }
      { const u16* vp = Vt + ((2 * eh + 1) * 32 + r) * 136 + mk * 32 + 4 * hh;
        O1 = MFMA32(cat4(*(const s16x4*)vp, *(const s16x4*)(vp + 8)), p0, O1);
        O1 = MFMA32(cat4(*(const s16x4*)(vp + 16), *(const s16x4*)(vp + 24)), p1, O1); }
    }
    { u16* orow = Z + (size_t)(lrow0 + lt * 32 + r) * ZS + C_BV + hd * 128 + (2 * eh) * 32;
      _Pragma("unroll") for (int gq = 0; gq < 4; ++gq) {
        st4bf(orow + 8 * gq + 4 * hh, O0[4 * gq], O0[4 * gq + 1], O0[4 * gq + 2], O0[4 * gq + 3]);
        st4bf(orow + 32 + 8 * gq + 4 * hh, O1[4 * gq], O1[4 * gq + 1], O1[4 * gq + 2], O1[4 * gq + 3]);
      } }
    _Pragma("unroll") for (int s = 0; s < 8; ++s)
      Sacc = MFMA32(ld8(Vt + (lt * 32 + r) * 136 + 16 * s + 8 * hh), ld8(KKt + (eh * 32 + r) * 136 + 16 * s + 8 * hh), Sacc);
    _Pragma("unroll") for (int i = 0; i < 16; ++i) Sacc[i] *= g128;
    __syncthreads();
    _Pragma("unroll") for (int i = 0; i < 16; ++i) St[(lt * 32 + crow(i, hh)) * 72 + eh * 32 + r] = f2bf(Sacc[i]);
  }
  float* so = P.out + O_RETP + (size_t)((l * 16 + b) * 8 + hd) * 8192 + (size_t)(eh * 32 + r) * 128 + lt * 32;
  _Pragma("unroll") for (int gq = 0; gq < 4; ++gq) *reinterpret_cast<f32x4*>(so + 8 * gq + 4 * hh) = (f32x4){Sacc[4 * gq], Sacc[4 * gq + 1], Sacc[4 * gq + 2], Sacc[4 * gq + 3]};
}

DI void ssd_prompt_item(char* shm, const Params& P, int l, int hf, int b, int hc) {
  u16* Bm = (u16*)shm;
  u16* Cm = Bm + 128 * 136;
  u16* Xs = Cm + 128 * 136;
  u16* XwT = Xs + 64 * 136;
  u16* Hs = XwT + 64 * 136;
  float* acum = (float*)(Hs + 64 * 136);
  float* dtv = acum + 128;
  float* tot = dtv + 128;
  const u16* Z = (const u16*)(optr(P.ws) + WS_Z);
  u16* YC = (u16*)(optr(P.ws) + WS_YC);
  const u16* XBC = (const u16*)(optr(P.ws) + WS_XBC);
  const float* DT = (const float*)(optr(P.ws) + WS_DT);
  const int tid = otid(), lane = tid & 63, w = tid >> 6, r = lane & 31, hh = lane >> 5;
  const int g = hc >> 3;
  const float Aneg = -expf(P.A_log[l * 16 + hc]), dtb = P.dt_bias[l * 16 + hc], dsk = P.D_skip[l * 16 + hc];
  const float* cw = P.conv_w + (size_t)l * 4 * 1536;
  const float* cb = P.conv_b + (size_t)l * 1536;
  const int lrowb = b * 2048 - hf * HALF_ROWS;
  __syncthreads();
  for (int e = tid; e < 64 * 136; e += NT) Hs[e] = 0;
  f32x16 Hacc = zero16();
  const int pt = w >> 2, it = w & 3;
  bf16x8 pB[4], pC[4], pX[2]; float pdt = 0.f;
#define SSD_ISSUE(cc) do { const int _t0 = (cc) * 128; \
    _Pragma("unroll") for (int itr = 0; itr < 4; ++itr) { const int idx = tid + itr * NT, row = idx >> 4, part = idx & 15; \
      const u16* _p = XBC + (size_t)(lrowb + _t0 + row) * 1536 + g * 128 + part * 8; pB[itr] = ld8(_p + 1024); pC[itr] = ld8(_p + 1280); } \
    _Pragma("unroll") for (int itr = 0; itr < 2; ++itr) { const int idx = tid + itr * NT, row = idx & 127, part = idx >> 7; \
      pX[itr] = ld8(XBC + (size_t)(lrowb + _t0 + row) * 1536 + hc * 64 + part * 8); } \
    if (tid < 128) pdt = DT[(size_t)(lrowb + _t0 + tid) * 16 + hc]; } while (0)
  SSD_ISSUE(0);
  _Pragma("unroll 1") for (int c = 0; c < 16; ++c) {
    const int tok0 = c * 128;
    bf16x8 xr[2]; xr[0] = pX[0]; xr[1] = pX[1];
    if (tid < 128) {
      const float dt = pdt;
      float v = dt * Aneg;
      for (int o = 1; o < 64; o <<= 1) { const float t = shup(v, o, lane); if (lane >= o) v += t; }
      dtv[tid] = dt; acum[tid] = v;
      if (tid == 63) tot[0] = v;
    }
    _Pragma("unroll") for (int itr = 0; itr < 4; ++itr) { const int idx = tid + itr * NT, row = idx >> 4, part = idx & 15;
      st8(Bm + row * 136 + part * 8, pB[itr]); st8(Cm + row * 136 + part * 8, pC[itr]); }
    __syncthreads();
    if (tid >= 64 && tid < 128) acum[tid] += tot[0];
    __syncthreads();
    const float alast = acum[127];
    _Pragma("unroll") for (int itr = 0; itr < 2; ++itr) {
      const int idx = tid + itr * NT, row = idx & 127, part = idx >> 7;
      const float wj = __expf(alast - acum[row]) * dtv[row];
      _Pragma("unroll") for (int j = 0; j < 8; ++j) { const float xs = bfs(xr[itr][j]); Xs[(part * 8 + j) * 136 + row] = (u16)xr[itr][j]; XwT[(part * 8 + j) * 136 + row] = f2bf(xs * wj); }
    }
    if (c + 1 < 16) SSD_ISSUE(c + 1);
    __syncthreads();
    const u16* cfp = Cm + (it * 32 + r) * 136 + 8 * hh;
    f32x16 Y = zero16();
    _Pragma("unroll") for (int s = 0; s < 8; ++s) Y = MFMA32(ld8(Hs + (pt * 32 + r) * 136 + 16 * s + 8 * hh), ld8(cfp + 16 * s), Y);
    const float ai = acum[it * 32 + r];
    { const float ea = __expf(ai); _Pragma("unroll") for (int i = 0; i < 16; ++i) Y[i] *= ea; }
    _Pragma("unroll 1") for (int jt = 0; jt <= it; ++jt) {
      f32x16 Gm = zero16();
      _Pragma("unroll") for (int s = 0; s < 8; ++s) Gm = MFMA32(ld8(Bm + (jt * 32 + r) * 136 + 16 * s + 8 * hh), ld8(cfp + 16 * s), Gm);
      _Pragma("unroll") for (int i = 0; i < 16; ++i) {
        const int jl = crow(i, hh), j = jt * 32 + jl;
        const float v = Gm[i] * __expf(ai - acum[j]) * dtv[j];
        Gm[i] = (jt == it && jl > r) ? 0.f : v;
      }
      const bf16x8 p0 = packP<0>(Gm), p1 = packP<1>(Gm);
      const u16* xp = Xs + (pt * 32 + r) * 136 + jt * 32 + 4 * hh;
      Y = MFMA32(cat4(*(const s16x4*)xp, *(const s16x4*)(xp + 8)), p0, Y);
      Y = MFMA32(cat4(*(const s16x4*)(xp + 16), *(const s16x4*)(xp + 24)), p1, Y);
    }
    _Pragma("unroll") for (int i = 0; i < 16; ++i) Y[i] += dsk * bf2f(Xs[(pt * 32 + crow(i, hh)) * 136 + it * 32 + r]);
    { u16* yrow = YC + (size_t)(lrowb + tok0 + it * 32 + r) * D + hc * 64 + pt * 32;
      _Pragma("unroll") for (int gq = 0; gq < 4; ++gq) st4bf(yrow + 8 * gq + 4 * hh, Y[4 * gq], Y[4 * gq + 1], Y[4 * gq + 2], Y[4 * gq + 3]); }
    { const float dl = __expf(alast); _Pragma("unroll") for (int i = 0; i < 16; ++i) Hacc[i] *= dl; }
    _Pragma("unroll") for (int s = 0; s < 8; ++s) {
      const bf16x8 xf = ld8(XwT + (pt * 32 + r) * 136 + 16 * s + 8 * hh);
      const u16* bp = Bm + (16 * s + 8 * hh) * 136 + it * 32 + r;
      u32x4 pb;
      _Pragma("unroll") for (int q = 0; q < 4; ++q) pb[q] = (unsigned)bp[(2 * q) * 136] | ((unsigned)bp[(2 * q + 1) * 136] << 16);
      Hacc = MFMA32(xf, __builtin_bit_cast(bf16x8, pb), Hacc);
    }
    __syncthreads();
    _Pragma("unroll") for (int i = 0; i < 16; ++i) Hs[(pt * 32 + crow(i, hh)) * 136 + it * 32 + r] = f2bf(Hacc[i]);
  }
  { float* ho = P.out + O_SSMP + (size_t)((l * 16 + b) * 16 + hc) * 8192;
    _Pragma("unroll") for (int i = 0; i < 16; ++i) ho[(pt * 32 + crow(i, hh)) * 128 + it * 32 + r] = Hacc[i]; }
  { float* co = P.out + O_CONVP + (size_t)(l * 16 + b) * 3 * 1536;
    for (int e = tid; e < 3 * 64; e += NT) { const int i = e >> 6, ch = hc * 64 + (e & 63); co[i * 1536 + ch] = bf2f(Z[(size_t)(lrowb + 2045 + i) * ZS + C_CX + ch]); }
    if ((hc & 7) == 0) for (int e = tid; e < 3 * 256; e += NT) { const int i = e >> 8, q = e & 255; const int ch = (q < 128 ? 1024 : 1280 - 128) + g * 128 + q; co[i * 1536 + ch] = bf2f(Z[(size_t)(lrowb + 2045 + i) * ZS + C_CX + ch]); } }
}

DI void ssd_sample_item(char* shm, const Params& P, int l, int s, int g) {
  float* xs = (float*)shm;
  float* Bs = xs + 512;
  float* Cs = Bs + 128;
  float* dts = Cs + 128;
  const int tid = otid(), lane = tid & 63, w = tid >> 6;
  const int lr = MPROMPT + s - HALF_ROWS;
  const u16* zr = (const u16*)(optr(P.ws) + WS_Z) + (size_t)lr * ZS;
  u16* YC = (u16*)(optr(P.ws) + WS_YC) + (size_t)lr * D;
  const float* cw = P.conv_w + (size_t)l * 4 * 1536;
  const float* cb = P.conv_b + (size_t)l * 1536;
  const float* hist = P.state_conv + (size_t)(l * 128 + s) * 3 * 1536;
  float* cso = P.out + O_CONVS + (size_t)(l * 128 + s) * 3 * 1536;
  __syncthreads();
  for (int u = tid; u < 768; u += NT) {
    int ch; float* dst;
    if (u < 512) { ch = g * 512 + u; dst = xs + u; } else if (u < 640) { ch = 1024 + g * 128 + (u - 512); dst = Bs + (u - 512); } else { ch = 1280 + g * 128 + (u - 640); dst = Cs + (u - 640); }
    const float h0 = hist[ch], h1 = hist[1536 + ch], h2 = hist[2 * 1536 + ch], nw = bf2f(zr[C_CX + ch]);
    const float a = cb[ch] + cw[ch] * h0 + cw[1536 + ch] * h1 + cw[2 * 1536 + ch] * h2 + cw[3 * 1536 + ch] * nw;
    *dst = siluf(a);
    cso[ch] = h1; cso[1536 + ch] = h2; cso[2 * 1536 + ch] = nw;
  }
  if (tid < 8) { const int hc = g * 8 + tid; const float dt = softplusf(bf2f(zr[C_DT + hc]) + P.dt_bias[l * 16 + hc]); dts[tid] = dt; dts[8 + tid] = expf(dt * -expf(P.A_log[l * 16 + hc])); }
  __syncthreads();
  const int hc = g * 8 + w;
  const float dt = dts[w], dA = dts[8 + w], dsk = P.D_skip[l * 16 + hc];
  const float* hin = P.state_ssm + (size_t)((l * 128 + s) * 16 + hc) * 8192;
  float* hout = P.out + O_SSMS + (size_t)((l * 128 + s) * 16 + hc) * 8192;
  const int n4 = (lane & 31) * 4, psub = lane >> 5;
  const f32x4 Bv = *reinterpret_cast<const f32x4*>(Bs + n4), Cv = *reinterpret_cast<const f32x4*>(Cs + n4);
  {
    const int ib = 0;
    f32x4 hv[32];
    _Pragma("unroll") for (int k = 0; k < 32; ++k) hv[k] = __builtin_nontemporal_load(reinterpret_cast<const f32x4*>(hin + (k * 2 + psub) * 128 + n4));
    _Pragma("unroll") for (int k = 0; k < 32; ++k) {
      const int p = (ib * 16 + k) * 2 + psub;
      const float xv = xs[w * 64 + p];
      const f32x4 hn = hv[k] * dA + Bv * (dt * xv);
      __builtin_nontemporal_store(hn, reinterpret_cast<f32x4*>(hout + p * 128 + n4));
      float y = hn[0] * Cv[0] + hn[1] * Cv[1] + hn[2] * Cv[2] + hn[3] * Cv[3];
      for (int o = 16; o >= 1; o >>= 1) y += shx(y, o, lane);
      if ((lane & 31) == 0) YC[hc * 64 + p] = f2bf(y + dsk * xv);
    }
  }
}

DI void ret_sample_item(char* shm, const Params& P, int l, int s) {
  float* qk = (float*)shm;
  const int tid = otid(), lane = tid & 63, w = tid >> 6;
  const int lr = MPROMPT + s - HALF_ROWS;
  u16* zr = (u16*)(optr(P.ws) + WS_Z) + (size_t)lr * ZS;
  __syncthreads();
  const float gamma = 1.f - exp2f(-5.f - (float)w);
  if (lane < 32) {
    const float th = 1.f / powf(10000.f, (float)lane / 31.f);
    float sn, cs; sincos_rev(16384.f * th, sn, cs);
    const float q1 = bf2f(zr[C_BQ + w * 64 + 2 * lane]), q2 = bf2f(zr[C_BQ + w * 64 + 2 * lane + 1]);
    const float k1 = bf2f(zr[C_BK + w * 64 + 2 * lane]) * 0.125f, k2 = bf2f(zr[C_BK + w * 64 + 2 * lane + 1]) * 0.125f;
    qk[w * 128 + 2 * lane] = q1 * cs - q2 * sn; qk[w * 128 + 2 * lane + 1] = q1 * sn + q2 * cs;
    qk[w * 128 + 64 + 2 * lane] = k1 * cs - k2 * sn; qk[w * 128 + 64 + 2 * lane + 1] = k1 * sn + k2 * cs;
  }
  const int e4 = (lane & 31) * 4, dsub = lane >> 5;
  f32x4 v4;
  _Pragma("unroll") for (int j = 0; j < 4; ++j) v4[j] = bf2f(zr[C_BV + w * 128 + e4 + j]);
  __syncthreads();
  const float* Sin = P.state_ret + (size_t)((l * 128 + s) * 8 + w) * 8192;
  float* Sout = P.out + O_RETS + (size_t)((l * 128 + s) * 8 + w) * 8192;
  f32x4 o4 = (f32x4){0.f, 0.f, 0.f, 0.f};
  {
    const int ib = 0;
    f32x4 sv[32];
    _Pragma("unroll") for (int k = 0; k < 32; ++k) sv[k] = __builtin_nontemporal_load(reinterpret_cast<const f32x4*>(Sin + (k * 2 + dsub) * 128 + e4));
    _Pragma("unroll") for (int k = 0; k < 32; ++k) {
      const int d = (ib * 16 + k) * 2 + dsub;
      const f32x4 sn = sv[k] * gamma + v4 * qk[w * 128 + 64 + d];
      __builtin_nontemporal_store(sn, reinterpret_cast<f32x4*>(Sout + d * 128 + e4));
      o4 += sn * qk[w * 128 + d];
    }
  }
  _Pragma("unroll") for (int j = 0; j < 4; ++j) o4[j] += shx(o4[j], 32, lane);
  if (dsub == 0) st4bf(zr + C_BV + w * 128 + e4, o4[0], o4[1], o4[2], o4[3]);
}

DI void att_sample_item(char* shm, const Params& P, int l, int s) {
  float* Kc = (float*)shm;
  float* Vc = Kc + 129 * 65;
  float* qv = Vc + 129 * 65;
  float* sc = qv + 256;
  float* red = sc + 512;
  const int tid = otid(), lane = tid & 63, w = tid >> 6;
  const int lr = MPROMPT + s - HALF_ROWS;
  u16* zr = (u16*)(optr(P.ws) + WS_Z) + (size_t)lr * ZS;
  const float* bt = (const float*)(optr(P.ws) + WS_BT);
  const float* ck = P.cache_k + (size_t)(l * 128 + s) * 128 * 256;
  const float* cv = P.cache_v + (size_t)(l * 128 + s) * 128 * 256;
  float* ok = P.out + O_WKS + (size_t)(l * 128 + s) * 128 * 256;
  float* ov = P.out + O_WVS + (size_t)(l * 128 + s) * 128 * 256;
  _Pragma("unroll 1") for (int kvh = 0; kvh < 4; ++kvh) {
    __syncthreads();
    {
      const int d4 = (tid & 15) * 4;
      f32x4 kk[4], vv[4];
      _Pragma("unroll") for (int itr = 0; itr < 4; ++itr) { const int j = (tid >> 4) + 32 * itr;
        kk[itr] = __builtin_nontemporal_load(reinterpret_cast<const f32x4*>(ck + j * 256 + kvh * 64 + d4)); vv[itr] = __builtin_nontemporal_load(reinterpret_cast<const f32x4*>(cv + j * 256 + kvh * 64 + d4)); }
      _Pragma("unroll") for (int itr = 0; itr < 4; ++itr) { const int j = (tid >> 4) + 32 * itr;
        _Pragma("unroll") for (int q = 0; q < 4; ++q) { Kc[j * 65 + d4 + q] = kk[itr][q]; Vc[j * 65 + d4 + q] = vv[itr][q]; }
        if (j >= 1) { __builtin_nontemporal_store(kk[itr], reinterpret_cast<f32x4*>(ok + (j - 1) * 256 + kvh * 64 + d4)); __builtin_nontemporal_store(vv[itr], reinterpret_cast<f32x4*>(ov + (j - 1) * 256 + kvh * 64 + d4)); } }
    }
    if (tid < 64) { const float kn = bf2f(zr[C_AK + kvh * 64 + tid]), vn = bf2f(zr[C_AV + kvh * 64 + tid]); Kc[128 * 65 + tid] = kn; Vc[128 * 65 + tid] = vn; ok[127 * 256 + kvh * 64 + tid] = kn; ov[127 * 256 + kvh * 64 + tid] = vn; }
    if (tid < 256) qv[tid] = bf2f(zr[C_AQ + kvh * 256 + tid]);
    __syncthreads();
    const int g = tid >> 7, c = 1 + (tid & 127), qh = kvh * 4 + g;
    float dot = 0.f;
    _Pragma("unroll 1") for (int d = 0; d < 64; ++d) dot += qv[g * 64 + d] * Kc[c * 65 + d];
    const float score = dot * 0.125f + bt[(128 - c) * 16 + qh];
    float mx = score;
    for (int o = 32; o >= 1; o >>= 1) mx = fmaxf(mx, shx(mx, o, lane));
    if (lane == 0) red[w] = mx;
    __syncthreads();
    const float sink = P.sinks[l * 16 + qh];
    const float m = fmaxf(fmaxf(red[2 * g], red[2 * g + 1]), sink);
    const float e = __expf(score - m);
    float sm = e;
    for (int o = 32; o >= 1; o >>= 1) sm += shx(sm, o, lane);
    if (lane == 0) red[8 + w] = sm;
    __syncthreads();
    const float den = red[8 + 2 * g] + red[8 + 2 * g + 1] + __expf(sink - m);
    sc[g * 128 + (c - 1)] = e * __builtin_amdgcn_rcpf(den);
    __syncthreads();
    if (tid < 256) {
      const int g2 = tid >> 6, d = tid & 63; float o = 0.f;
      for (int cc = 1; cc <= 128; ++cc) o += sc[g2 * 128 + cc - 1] * Vc[cc * 65 + d];
      zr[C_AQ + (kvh * 4 + g2) * 64 + d] = f2bf(o);
    }
  }
}

DI void mixer_phase(char* shm, const Params& P, int l, int hf, int ph) {
  __shared__ int s_item;
  unsigned* ctr = (unsigned*)(optr(P.ws) + WS_CTR) + ph;
  const int nitems = 128 + 64 + 512 + (hf ? 512 : 0);
  for (;;) {
    __syncthreads();
    if (threadIdx.x == 0) s_item = (int)atomicAdd(ctr, 1u);
    __syncthreads();
    int it = s_item;
    if (it >= nitems) break;
    const int nsamp = hf ? 512 : 0;
    if (it < 128) { ssd_prompt_item(shm, P, l, hf, hf * 8 + (it >> 4), it & 15); }
    else if ((it -= 128) < 64) { ret_prompt_item(shm, P, l, hf, hf * 8 + (it >> 3), it & 7); }
    else if ((it -= 64) < nsamp) {
      if (it < 256) { ssd_sample_item(shm, P, l, it >> 1, it & 1); }
      else if ((it -= 256) < 128) { ret_sample_item(shm, P, l, it); }
      else { it -= 128; att_sample_item(shm, P, l, it); }
    }
    else { it -= nsamp; att_prompt_item(shm, P, l, hf, hf * 8 + (it >> 6), (it >> 2) & 15, it & 3); }
  }
}

#define SEQ0 0x87543210ull
#define LEN0 8
#define SEQ1 0x8754321ull
#define LEN1 7
constexpr int PH_G0 = 3;
constexpr int N_PHASES = PH_G0 + 2 * (LEN0 + LEN1) + 1;
#ifndef MAXPH
#define MAXPH N_PHASES
#endif
__global__ void __launch_bounds__(NT) fwd_kernel(Params P) {
  extern __shared__ __attribute__((aligned(16))) unsigned char lds[];
  char* shm = (char*)lds;
  cg::grid_group grid = cg::this_grid();
  unsigned char* ws = P.ws;
  const float* mod = (const float*)(ws + WS_MOD);
  for (int ph = P.ph_lo; ph < P.ph_hi; ++ph) {
    if (ph > P.ph_lo) grid.sync();
    if (ph == 0) { prep_phase(shm, P); continue; }
    if (ph == N_PHASES - 1) { final_norm_phase(P); continue; }
    const int q = (ph < PH_G0) ? 0 : ph - PH_G0, hf = q / (LEN0 + LEN1), qq = q % (LEN0 + LEN1), l = (qq >= LEN0) ? 1 : 0;
    const int sub = (ph == 1) ? 9 : (ph == 2) ? 10 : l ? (int)((SEQ1 >> (4 * (qq - LEN0))) & 15ull) : (int)((SEQ0 >> (4 * qq)) & 15ull);
    const int ntm = hf ? 65 : 64, RB = hf * HALF_ROWS, NV = hf ? 16512 : 16384;
    if (sub == 0) { norm_phase(P, l, hf, 0, l == 0); continue; }
    if (sub == 2) { conv_phase(P, l, hf); continue; }
    if (sub == 3) { mixer_phase(shm, P, l, hf, ph); continue; }
    if (sub == 4) { mix_phase(P, l, hf); continue; }
    Epi E{};
    const int Gd = gridDim.x;
    const int bxr = (Gd % 8 == 0) ? (int)((blockIdx.x % 8) * (Gd / 8) + blockIdx.x / 8) : (int)blockIdx.x;
    const int cw = (bxr < 41) ? 0 : (bxr < 57) ? 1 : 2;
    const bool first_res = (sub == 5 && l == 0);
    E.kind = (sub == 9) ? 3 : (sub == 10) ? 6 : (sub == 1) ? 0 : (sub == 7) ? 1 : 2;
    E.c16 = (u16*)(ws + WS_Z); E.ldc = (sub == 1) ? ZS : (sub == 10) ? (cw == 0 ? ZS : DFF) : DFF;
    E.rb = RB; E.nv = NV; E.xout = P.out; E.mod = mod; E.goff = l * 6144 + ((sub == 5) ? 2048 : 5120);
    E.res_p = first_res ? P.x_prompt : (const float*)P.out;
    E.res_s = first_res ? P.x_sample : (const float*)(P.out + (size_t)MPROMPT * D);
    E.modout = (float*)(ws + WS_MOD); E.ada_b = P.ada_b; E.shb = (u16*)(ws + WS_SHB);
    E.cout = (float*)(ws + ((cw == 0) ? WS_C1 : WS_C2 + (size_t)(cw - 1) * 144 * DFF * 4));
    E.fuse = (sub == 5 || (sub == 8 && l == 0)) ? 1 : 0;
    E.fw = (sub == 5) ? P.n2 + l * D : P.n1 + D;
    E.fsc = (sub == 5) ? l * 6144 + 4096 : 6144 + 1024;
    E.fa = (u16*)(ws + ((sub == 5) ? WS_XBC : WS_H));
    E.fss = (float*)(ws + ((sub == 5) ? WS_SS2 : WS_SS1));
    E.cons = (sub == 7 || (sub == 1 && l == 1)) ? 1 : 0;
    E.css = (const float*)(ws + ((sub == 7) ? WS_SS2 : WS_SS1));
    E.cc = (const float*)(ws + ((sub == 7) ? WS_C2 + (size_t)l * 144 * DFF * 4 : WS_C1));
    E.ccld = (sub == 7) ? DFF : ZS;
    const bf16* A = (const bf16*)(ws + ((sub == 9) ? WS_SC : (sub == 10) ? WS_SHB + (size_t)cw * 256 * D * 2 : (sub == 8) ? WS_Z : (sub == 7) ? WS_XBC : WS_H));
    const size_t boff = (sub == 9) ? WS_AWT : (sub == 10) ? (cw == 0 ? WS_WIN + (size_t)ZS * D * 2 : WS_WUP + (size_t)(cw - 1) * DFF * D * 2)
                      : (sub == 1) ? WS_WIN + (size_t)l * ZS * D * 2 : (sub == 5) ? WS_WOUT + (size_t)l * D * D * 2
                      : (sub == 7) ? WS_WUP + (size_t)l * DFF * D * 2 : WS_WDN + (size_t)l * D * DFF * 2;
    const bf16* Bt = (const bf16*)(ws + boff);
    const int K = (sub == 8) ? DFF : D;
    const int tm = (sub == 9 || sub == 10) ? 1 : ntm;
    const int tn = (sub == 9) ? 48 : (sub == 10) ? (cw == 0 ? 41 : 16) : (sub == 1) ? 41 : (sub == 7) ? 16 : 4;
    const int toff = (sub == 10) ? (cw == 0 ? 0 : cw == 1 ? 41 : 57) : 0;
    asm volatile("" : "+s"(E.xout), "+s"(E.res_p), "+s"(E.res_s), "+s"(E.mod), "+s"(A), "+s"(Bt), "+s"(E.fa), "+s"(E.fss), "+s"(E.css), "+s"(E.cc), "+s"(E.cout));
    E.xout = gptr(E.xout); E.res_p = gptr(E.res_p); E.res_s = gptr(E.res_s); E.mod = gptr(E.mod); A = gptr(A); Bt = gptr(Bt);
    E.fa = gptr(E.fa); E.fss = gptr(E.fss); E.css = gptr(E.css); E.cc = gptr(E.cc); E.cout = gptr(E.cout);
    gemm_phase(shm, A, Bt, K, tm, tn, E, (hf == 1 && sub == 8 && l == 1) ? 1 : 0, toff, (hf == 1 && sub != 9 && sub != 10) ? 1 : 0);
  }
}

extern "C" void kernel_launch(void* const* d_in, const int* in_sizes, int n_in, void* d_out, int out_size, void* d_ws, size_t ws_size, hipStream_t stream) {
  static int grid = 0;
  if (grid == 0) {
    if (n_in != 26 || ws_size < WS_END) { fprintf(stderr, "kernel_launch: bad inputs n_in=%d ws=%zu need %zu\n", n_in, ws_size, (size_t)WS_END); grid = -1; return; }
    int dev = 0, cus = 0, per_cu = 0;
    (void)hipGetDevice(&dev);
    (void)hipDeviceGetAttribute(&cus, hipDeviceAttributeMultiprocessorCount, dev);
    if (hipFuncSetAttribute((const void*)fwd_kernel, hipFuncAttributeMaxDynamicSharedMemorySize, LDS_BYTES) != hipSuccess) { fprintf(stderr, "hipFuncSetAttribute failed\n"); grid = -1; return; }
    (void)hipOccupancyMaxActiveBlocksPerMultiprocessor(&per_cu, (const void*)fwd_kernel, NT, LDS_BYTES);
    if (per_cu < 1) { fprintf(stderr, "occupancy query returned %d\n", per_cu); per_cu = 1; }
    (void)hipGetLastError();
    grid = cus * per_cu;
  }
  if (grid < 0) return;
  (void)hipMemsetAsync((char*)d_ws + WS_CTR, 0, 256, stream);
  Params p{};
  const float** pp = (const float**)&p;
  _Pragma("unroll") for (int i = 0; i < 26; ++i) pp[i] = (const float*)d_in[i];
  p.out = (float*)d_out; p.ws = (unsigned char*)d_ws;
#if FUSED
  p.ph_lo = 0; p.ph_hi = MAXPH;
  void* args[] = {&p};
  hipError_t e = hipLaunchCooperativeKernel((const void*)fwd_kernel, dim3(grid), dim3(NT), args, LDS_BYTES, stream);
  if (e != hipSuccess) fprintf(stderr, "cooperative launch failed: %s (grid %d)\n", hipGetErrorString(e), grid);
#else
  for (int ph = 0; ph < MAXPH; ++ph) {
    p.ph_lo = ph; p.ph_hi = ph + 1;
    hipLaunchKernelGGL(fwd_kernel, dim3(grid), dim3(NT), LDS_BYTES, stream, p);
  }
#endif
}
```
